# Optimizing an MI355X kernel written in HIP

```python
import math
import jax, jax.numpy as jnp
from jax import lax
import numpy as np

D_MODEL = 1024
BATCH = 2
SEQ = 8192
DEPTH = 4

RMS_EPS = 1e-6
Q_BLOCK = 128

MLA_HEADS = 4
MLA_NOPE = 64
MLA_ROPE = 32
MLA_V = 64
MLA_Q_LORA = 256
MLA_KV_LORA = 128
MLA_WIDTH = MLA_HEADS * MLA_V
ROPE_THETA = 10000.0

GDN_HEADS = 4
GDN_DK = 128
GDN_DV = 128
GDN_CONV = 4
GDN_CHUNK = 64
GDN_WIDTH = GDN_HEADS * GDN_DV

MOBA_HEADS = 4
MOBA_DH = 64
MOBA_BLOCK = 256
MOBA_TOPK = 3
MOBA_WIDTH = MOBA_HEADS * MOBA_DH

T5_BUCKETS = 32
T5_MAX_DIST = 2048

MIX_WIDTH = MLA_WIDTH + GDN_WIDTH + MOBA_WIDTH

IN_SIZES = (
    MLA_Q_LORA, MLA_KV_LORA, MLA_ROPE, MLA_WIDTH,
    GDN_HEADS * GDN_DK, GDN_HEADS * GDN_DK, GDN_WIDTH, GDN_WIDTH,
    GDN_HEADS, GDN_HEADS,
    MOBA_WIDTH, MOBA_WIDTH, MOBA_WIDTH, MOBA_WIDTH,
)
IN_COLS = sum(IN_SIZES)

kernel_name = "hybrid_mla_gdn_moba_parallel_heads"


def rmsnorm(x, w):
    xf = x.astype(jnp.float32)
    y = xf * lax.rsqrt(jnp.mean(xf * xf, axis=-1, keepdims=True) + RMS_EPS)
    return (y * w.astype(jnp.float32)).astype(x.dtype)


def l2norm(x):
    xf = x.astype(jnp.float32)
    return xf * lax.rsqrt(jnp.sum(xf * xf, axis=-1, keepdims=True) + 1e-6)


def rope_tables(seq, dim):
    inv = 1.0 / (ROPE_THETA ** (jnp.arange(0, dim, 2, dtype=jnp.float32) / dim))
    ang = jnp.arange(seq, dtype=jnp.float32)[:, None] * inv[None, :]
    return jnp.cos(ang), jnp.sin(ang)


def apply_rope(x, cos, sin):
    half = x.shape[-1] // 2
    xf = x.astype(jnp.float32)
    x1, x2 = xf[..., :half], xf[..., half:]
    c, s = cos[None, :, None, :], sin[None, :, None, :]
    return jnp.concatenate([x1 * c - x2 * s, x1 * s + x2 * c], axis=-1).astype(x.dtype)


def t5_bucket(rel):
    n = jnp.maximum(rel, 0)
    max_exact = T5_BUCKETS // 2
    nf = jnp.maximum(n, 1).astype(jnp.float32)
    large = max_exact + (jnp.log(nf / max_exact) / math.log(T5_MAX_DIST / max_exact)
                         * (T5_BUCKETS - max_exact)).astype(jnp.int32)
    large = jnp.minimum(large, T5_BUCKETS - 1)
    return jnp.where(n < max_exact, n, large)


def causal_block_attention(q, k, v, scale):
    B, S, H, Dk = q.shape
    Dv = v.shape[-1]
    nqb = S // Q_BLOCK
    qb = q.reshape(B, nqb, Q_BLOCK, H, Dk).transpose(1, 0, 2, 3, 4)
    kpos = jnp.arange(S)

    def one(args):
        i, qi = args
        logits = jnp.einsum('bqhd,bkhd->bhqk', qi, k, preferred_element_type=jnp.float32) * scale
        qpos = i * Q_BLOCK + jnp.arange(Q_BLOCK)
        logits = jnp.where(kpos[None, :] <= qpos[:, None], logits, -jnp.inf)
        p = jax.nn.softmax(logits, axis=-1).astype(v.dtype)
        return jnp.einsum('bhqk,bkhd->bqhd', p, v)

    out = lax.map(one, (jnp.arange(nqb), qb))
    return out.transpose(1, 0, 2, 3, 4).reshape(B, S, H, Dv)


def mla_mixer(c_q, c_kv, k_rope, q_norm_w, w_uq, kv_norm_w, w_ukv, cos, sin):
    B, S, _ = c_q.shape
    q = (rmsnorm(c_q, q_norm_w) @ w_uq).reshape(B, S, MLA_HEADS, MLA_NOPE + MLA_ROPE)
    q_nope, q_pe = q[..., :MLA_NOPE], q[..., MLA_NOPE:]
    q_pe = apply_rope(q_pe, cos, sin)
    kv = (rmsnorm(c_kv, kv_norm_w) @ w_ukv).reshape(B, S, MLA_HEADS, MLA_NOPE + MLA_V)
    k_nope, v = kv[..., :MLA_NOPE], kv[..., MLA_NOPE:]
    k_pe = apply_rope(k_rope[:, :, None, :], cos, sin)
    k = jnp.concatenate([k_nope, jnp.broadcast_to(k_pe, (B, S, MLA_HEADS, MLA_ROPE))], axis=-1)
    qh = jnp.concatenate([q_nope, q_pe], axis=-1)
    o = causal_block_attention(qh, k, v, (MLA_NOPE + MLA_ROPE) ** -0.5)
    return o.reshape(B, S, MLA_WIDTH)


def causal_conv(x, w):
    K = w.shape[0]
    S = x.shape[1]
    xp = jnp.pad(x, ((0, 0), (K - 1, 0), (0, 0)))
    return sum(xp[:, j:j + S] * w[j] for j in range(K))


def chunk_gated_delta_rule(q, k, v, beta, g):
    B, S, H, DK = q.shape
    DV = v.shape[-1]
    C = GDN_CHUNK
    N = S // C

    def chunks(t):
        return t.reshape(B, N, C, H, t.shape[-1]).transpose(0, 3, 1, 2, 4)

    qc, kc, vc = chunks(q), chunks(k), chunks(v)
    bc = beta.reshape(B, N, C, H).transpose(0, 3, 1, 2)
    gc = jnp.cumsum(g.reshape(B, N, C, H).transpose(0, 3, 1, 2), axis=-1)

    idx = jnp.arange(C)
    strict = idx[:, None] > idx[None, :]
    incl = idx[:, None] >= idx[None, :]
    diff = gc[..., :, None] - gc[..., None, :]
    decay = jnp.exp(jnp.where(incl, diff, -jnp.inf))

    kk = jnp.einsum('bhntd,bhnjd->bhntj', kc, kc)
    L = jnp.where(strict, bc[..., :, None] * kk * decay, 0.0)
    rhs = jnp.concatenate([kc * (bc * jnp.exp(gc))[..., None], vc * bc[..., None]], axis=-1)
    sol = lax.linalg.triangular_solve(L + jnp.eye(C, dtype=L.dtype), rhs,
                                      left_side=True, lower=True, unit_diagonal=True)
    W, U0 = sol[..., :DK], sol[..., DK:]
    A_qk = jnp.einsum('bhntd,bhnjd->bhntj', qc, kc) * decay
    q_g = qc * jnp.exp(gc)[..., None]
    k_end = kc * jnp.exp(gc[..., -1:] - gc)[..., None]
    g_end = jnp.exp(gc[..., -1])

    def step(state, xs):
        W_n, U0_n, A_n, qg_n, ke_n, ge_n = xs
        U = U0_n - jnp.einsum('bhcd,bhde->bhce', W_n, state)
        o = jnp.einsum('bhcd,bhde->bhce', qg_n, state) + jnp.einsum('bhtj,bhje->bhte', A_n, U)
        new_state = ge_n[..., None, None] * state + jnp.einsum('bhcd,bhce->bhde', ke_n, U)
        return new_state, o

    xs = tuple(jnp.moveaxis(t, 2, 0) for t in (W, U0, A_qk, q_g, k_end, g_end))
    s0 = jnp.zeros((B, H, DK, DV), jnp.float32)
    _, o = lax.scan(step, s0, xs)
    return o.transpose(1, 0, 3, 2, 4).reshape(B, S, H, DV)


def gdn_mixer(q, k, v, z, b, a, conv_w, A_log, dt_bias, norm_w):
    B, S, _ = q.shape
    qkv = jax.nn.silu(causal_conv(jnp.concatenate([q, k, v], axis=-1), conv_w))
    nk = GDN_HEADS * GDN_DK
    q, k, v = qkv[..., :nk], qkv[..., nk:2 * nk], qkv[..., 2 * nk:]
    q = l2norm(q.reshape(B, S, GDN_HEADS, GDN_DK)) * (GDN_DK ** -0.5)
    k = l2norm(k.reshape(B, S, GDN_HEADS, GDN_DK))
    v = v.reshape(B, S, GDN_HEADS, GDN_DV).astype(jnp.float32)
    beta = jax.nn.sigmoid(b.astype(jnp.float32))
    g = -jnp.exp(A_log.astype(jnp.float32)) * jax.nn.softplus(
        a.astype(jnp.float32) + dt_bias.astype(jnp.float32))
    o = chunk_gated_delta_rule(q, k, v, beta, g).astype(z.dtype)
    o = rmsnorm(o, norm_w) * jax.nn.silu(z.reshape(B, S, GDN_HEADS, GDN_DV))
    return o.reshape(B, S, GDN_WIDTH)


def moba_mixer(q, k, v, t5_table):
    B, S, _ = q.shape
    H, Dh, BS = MOBA_HEADS, MOBA_DH, MOBA_BLOCK
    q = q.reshape(B, S, H, Dh).transpose(0, 2, 1, 3)
    k = k.reshape(B, S, H, Dh).transpose(0, 2, 1, 3)
    v = v.reshape(B, S, H, Dh).transpose(0, 2, 1, 3)
    NB = -(-S // BS)
    pad = NB * BS - S
    kp = jnp.pad(k, ((0, 0), (0, 0), (0, pad), (0, 0)))
    vp = jnp.pad(v, ((0, 0), (0, 0), (0, pad), (0, 0)))
    kblk = kp.reshape(B, H, NB, BS, Dh)
    vblk = vp.reshape(B, H, NB, BS, Dh)
    kmean = jnp.mean(kblk.astype(jnp.float32), axis=3).astype(k.dtype)
    topk = min(MOBA_TOPK, NB)
    scale = Dh ** -0.5
    nqb = S // Q_BLOCK
    qb = jnp.moveaxis(q.reshape(B, H, nqb, Q_BLOCK, Dh), 2, 0)
    bi = jnp.arange(B)[:, None, None, None]
    hi = jnp.arange(H)[None, :, None, None]
    hi5 = jnp.arange(H)[None, :, None, None, None]
    blk_iota = jnp.arange(BS)

    def one(args):
        i, qi = args
        qpos = i * Q_BLOCK + jnp.arange(Q_BLOCK)
        own = (i * Q_BLOCK) // BS
        gate = jnp.einsum('bhqd,bhnd->bhqn', qi, kmean, preferred_element_type=jnp.float32)
        gate = jnp.where(jnp.arange(NB) < own, gate, -jnp.inf)
        _, sel = lax.top_k(gate, topk)
        valid = sel < own
        ksel = kblk[bi, hi, sel]
        vsel = vblk[bi, hi, sel]
        kpos_sel = sel[..., None] * BS + blk_iota
        bias_sel = t5_table[t5_bucket(qpos[None, None, :, None, None] - kpos_sel), hi5]
        l_sel = jnp.einsum('bhqd,bhqnkd->bhqnk', qi, ksel, preferred_element_type=jnp.float32) * scale
        l_sel = jnp.where(valid[..., None], l_sel + bias_sel.astype(jnp.float32), -jnp.inf)
        kown = lax.dynamic_slice_in_dim(kp, own * BS, BS, axis=2)
        vown = lax.dynamic_slice_in_dim(vp, own * BS, BS, axis=2)
        kpos_own = own * BS + blk_iota
        rel_own = qpos[:, None] - kpos_own[None, :]
        bias_own = t5_table[t5_bucket(rel_own)].transpose(2, 0, 1)[None]
        l_own = jnp.einsum('bhqd,bhkd->bhqk', qi, kown, preferred_element_type=jnp.float32) * scale
        l_own = jnp.where(rel_own[None, None] >= 0, l_own + bias_own.astype(jnp.float32), -jnp.inf)
        logits = jnp.concatenate([l_sel.reshape(B, H, Q_BLOCK, topk * BS), l_own], axis=-1)
        p = jax.nn.softmax(logits, axis=-1).astype(v.dtype)
        p_sel = p[..., :topk * BS].reshape(B, H, Q_BLOCK, topk, BS)
        p_own = p[..., topk * BS:]
        return (jnp.einsum('bhqnk,bhqnkd->bhqd', p_sel, vsel)
                + jnp.einsum('bhqk,bhkd->bhqd', p_own, vown))

    out = lax.map(one, (jnp.arange(nqb), qb))
    out = out.transpose(1, 2, 0, 3, 4).reshape(B, H, S, Dh)
    return out.transpose(0, 2, 1, 3).reshape(B, S, MOBA_WIDTH)


def hybrid_layer(x, norm_w, w_in, mla_q_norm, mla_w_uq, mla_kv_norm, mla_w_ukv,
                 gdn_conv_w, gdn_A_log, gdn_dt_bias, gdn_norm_w, w_out, t5_table, cos, sin):
    h = rmsnorm(x, norm_w)
    proj = h @ w_in
    split_points = np.cumsum(IN_SIZES)[:-1].tolist()
    (m_cq, m_ckv, m_kr, m_gate, g_q, g_k, g_v, g_z, g_b, g_a,
     c_q, c_k, c_v, c_gate) = jnp.split(proj, split_points, axis=-1)
    y_mla = mla_mixer(m_cq, m_ckv, m_kr, mla_q_norm, mla_w_uq, mla_kv_norm, mla_w_ukv,
                      cos, sin) * jax.nn.silu(m_gate)
    y_gdn = gdn_mixer(g_q, g_k, g_v, g_z, g_b, g_a, gdn_conv_w, gdn_A_log, gdn_dt_bias, gdn_norm_w)
    y_moba = moba_mixer(c_q, c_k, c_v, t5_table) * jax.nn.silu(c_gate)
    y = jnp.concatenate([y_mla, y_gdn, y_moba], axis=-1)
    return x + y @ w_out


def setup_inputs(seed: int = 0) -> dict:
    key = jax.random.key(seed)
    ks = jax.random.split(key, 20)
    nrm = jax.random.normal
    f32 = jnp.float32
    dt = jnp.exp(jax.random.uniform(ks[10], (DEPTH, GDN_HEADS), f32, math.log(1e-3), math.log(1e-1)))
    return {
        "x": nrm(ks[0], (BATCH, SEQ, D_MODEL), f32),
        "norm_w": 1.0 + 0.02 * nrm(ks[1], (DEPTH, D_MODEL), f32),
        "w_in": nrm(ks[2], (DEPTH, D_MODEL, IN_COLS), f32) * D_MODEL ** -0.5,
        "mla_q_norm": 1.0 + 0.02 * nrm(ks[3], (DEPTH, MLA_Q_LORA), f32),
        "mla_w_uq": nrm(ks[4], (DEPTH, MLA_Q_LORA, MLA_HEADS * (MLA_NOPE + MLA_ROPE)), f32) * MLA_Q_LORA ** -0.5,
        "mla_kv_norm": 1.0 + 0.02 * nrm(ks[5], (DEPTH, MLA_KV_LORA), f32),
        "mla_w_ukv": nrm(ks[6], (DEPTH, MLA_KV_LORA, MLA_HEADS * (MLA_NOPE + MLA_V)), f32) * MLA_KV_LORA ** -0.5,
        "gdn_conv_w": nrm(ks[7], (DEPTH, GDN_CONV, 2 * GDN_HEADS * GDN_DK + GDN_WIDTH), f32) * GDN_CONV ** -0.5,
        "gdn_A_log": jnp.log(jax.random.uniform(ks[8], (DEPTH, GDN_HEADS), f32, 1.0, 16.0)),
        "gdn_dt_bias": jnp.log(jnp.expm1(dt)),
        "gdn_norm_w": 1.0 + 0.02 * nrm(ks[9], (DEPTH, GDN_DV), f32),
        "w_out": nrm(ks[11], (DEPTH, MIX_WIDTH, D_MODEL), f32) * (MIX_WIDTH * 2 * DEPTH) ** -0.5,
        "t5_table": 0.5 * nrm(ks[12], (T5_BUCKETS, MOBA_HEADS), f32),
        "final_norm_w": 1.0 + 0.02 * nrm(ks[13], (D_MODEL,), f32),
    }


def reference(x, norm_w, w_in, mla_q_norm, mla_w_uq, mla_kv_norm, mla_w_ukv,
              gdn_conv_w, gdn_A_log, gdn_dt_bias, gdn_norm_w, w_out, t5_table, final_norm_w):
    S = x.shape[1]
    cos, sin = rope_tables(S, MLA_ROPE)
    for l in range(DEPTH):
        x = hybrid_layer(x, norm_w[l], w_in[l], mla_q_norm[l], mla_w_uq[l], mla_kv_norm[l],
                         mla_w_ukv[l], gdn_conv_w[l], gdn_A_log[l], gdn_dt_bias[l],
                         gdn_norm_w[l], w_out[l], t5_table, cos, sin)
    return rmsnorm(x, final_norm_w)
```

```cpp
#include <hip/hip_runtime.h>
#include <cstdint>
#include <cstddef>

constexpr int D_MODEL = 1024, BATCH = 2, SEQ = 8192, DEPTH = 4, M_TOK = BATCH * SEQ;
constexpr int IN_COLS = 3752, PROJ_LD = 3840;
constexpr int C_MCQ = 0, C_MCKV = 256, C_MKR = 384, C_MGATE = 416, C_GQ = 672, C_GK = 1184, C_GV = 1696, C_GZ = 2208, C_GB = 2720, C_GA = 2724,
              C_CQ = 2728, C_CK = 2984, C_CV = 3240, C_CGATE = 3496;
constexpr float RMS_EPS = 1e-6f;
constexpr int Q_LD = 384, K_LD = 384, V_LD = 256;

constexpr size_t MiB = 1u << 20;
constexpr size_t WS_CTL = 0;
constexpr size_t WS_TBL = 1 * MiB;
constexpr size_t WS_KMEAN = WS_TBL + 32768;
constexpr size_t WS_SSQ = WS_KMEAN + 65536;
constexpr size_t WS_RQ = WS_SSQ + 262144;
constexpr size_t WS_RKV = WS_RQ + 65536;
constexpr size_t WS_COS = WS_RKV + 65536;
constexpr size_t WS_SIN = WS_COS + 524288;
constexpr size_t WS_WIN = 3 * MiB;
constexpr size_t WS_WOUT = WS_WIN + 3840 * 1024 * 2;
constexpr size_t WS_WUQ = WS_WOUT + 2 * MiB;
constexpr size_t WS_WUKV = WS_WUQ + 262144;
constexpr size_t WS_Q = 13 * MiB;
constexpr size_t WS_K = 25 * MiB;
constexpr size_t WS_V = 37 * MiB;
constexpr size_t WS_PROJ = 45 * MiB;
constexpr size_t WS_XB = 165 * MiB;
constexpr size_t WS_YN = 197 * MiB;
constexpr size_t WS_END = 256 * MiB;

typedef unsigned short bf16_t;
__device__ __forceinline__ unsigned f2bf(float f) { unsigned u = __builtin_bit_cast(unsigned, f); return (u + 0x7fffu + ((u >> 16) & 1u)) >> 16; }
__device__ __forceinline__ float bf2f(bf16_t b) { return __builtin_bit_cast(float, (unsigned)b << 16); }
__device__ __forceinline__ float siluf(float x) { return x / (1.f + __expf(-x)); }
__device__ __forceinline__ float wave_sum(float v) {
#pragma unroll
    for (int o = 1; o < 64; o <<= 1) v += __shfl_xor(v, o);
    return v;
}

__global__ void nk_wt(const float* __restrict__ W, const float* __restrict__ s, bf16_t* __restrict__ Wt, int K, int N, int NP, int mode) {
    const size_t i = (size_t)blockIdx.x * blockDim.x + threadIdx.x;
    if (i >= (size_t)NP * K) return;
    const int n = (int)(i / K), k = (int)(i % K);
    float v = 0.f;
    if (n < N) {
        int src = n;
        if (mode == 1) { const int nn = n & 255, hd = nn >> 6, c = nn & 63; src = hd * 128 + c + ((n >= 256) ? 64 : 0); }
        v = W[(size_t)k * N + src] * (s ? s[k] : 1.f);
    }
    Wt[i] = (bf16_t)f2bf(v);
}
__global__ void nk_tables(const float* __restrict__ t5, float* __restrict__ tbl, float* __restrict__ cs, float* __restrict__ sn) {
    const int i = blockIdx.x * blockDim.x + threadIdx.x;
    if (i < 4 * 2048) {
        const int h = i >> 11, rel = i & 2047; int b;
        if (rel < 16) b = rel; else { const float nf = (float)rel; b = 16 + (int)(logf(nf / 16.f) / 4.852030263919617f * 16.f); if (b > 31) b = 31; }
        tbl[i] = t5[b * 4 + h];
    }
    if (i < SEQ * 16) {
        const int pos = i >> 4, j = i & 15;
        const float inv = (float)(1.0 / pow(10000.0, (double)(2 * j) / 32.0));
        const float ang = (float)pos * inv;
        cs[i] = (float)cos((double)ang); sn[i] = (float)sin((double)ang);
    }
}
__global__ void nk_xprep(const float* __restrict__ x, bf16_t* __restrict__ xb, float* __restrict__ ssq) {
    const int row = blockIdx.x * (blockDim.x >> 6) + (threadIdx.x >> 6), lane = threadIdx.x & 63;
    if (row >= M_TOK) return;
    float s = 0.f;
    for (int c = lane; c < D_MODEL; c += 64) { const float v = x[(size_t)row * D_MODEL + c]; s += v * v; xb[(size_t)row * D_MODEL + c] = (bf16_t)f2bf(v); }
    s = wave_sum(s);
    if (lane == 0) { ssq[row * 4] = s; ssq[row * 4 + 1] = 0.f; ssq[row * 4 + 2] = 0.f; ssq[row * 4 + 3] = 0.f; }
}
struct EpiArgs { bf16_t* o0; bf16_t* o1; float* xf; const float* xin; const float* r; int mode; int pad; };
__global__ void __launch_bounds__(256) nk_gemm(const bf16_t* __restrict__ A, int lda, const bf16_t* __restrict__ Bt, int ldb, int K, EpiArgs e) {
    __shared__ float As[16][65], Bs[16][65];
    const int tx = threadIdx.x & 15, ty = threadIdx.x >> 4, m0 = blockIdx.y * 64, n0 = blockIdx.x * 64;
    float acc[4][4] = {};
    for (int k0 = 0; k0 < K; k0 += 16) {
        for (int i = threadIdx.x; i < 1024; i += 256) { const int r = i >> 4, c = i & 15;
            As[c][r] = bf2f(A[(size_t)(m0 + r) * lda + k0 + c]); Bs[c][r] = bf2f(Bt[(size_t)(n0 + r) * ldb + k0 + c]); }
        __syncthreads();
#pragma unroll
        for (int kk = 0; kk < 16; ++kk) { float a[4], b[4];
#pragma unroll
            for (int i = 0; i < 4; ++i) { a[i] = As[kk][ty * 4 + i]; b[i] = Bs[kk][tx * 4 + i]; }
#pragma unroll
            for (int i = 0; i < 4; ++i)
#pragma unroll
                for (int j = 0; j < 4; ++j) acc[i][j] += a[i] * b[j]; }
        __syncthreads();
    }
#pragma unroll
    for (int i = 0; i < 4; ++i)
#pragma unroll
        for (int j = 0; j < 4; ++j) {
            const int m = m0 + ty * 4 + i, n = n0 + tx * 4 + j; const float v = acc[i][j];
            if (e.mode == 0) {
                if (n < IN_COLS) { const float* q = e.r + m * 4; const float rs = rsqrtf((q[0] + q[1] + q[2] + q[3]) * (1.f / D_MODEL) + RMS_EPS); e.o0[(size_t)m * PROJ_LD + n] = (bf16_t)f2bf(v * rs); }
            } else if (e.mode == 1) {
                if (n < 384) e.o0[(size_t)m * Q_LD + n] = (bf16_t)f2bf(v * e.r[m]);
            } else if (e.mode == 2) {
                const float w = v * e.r[m];
                if (n < 256) e.o0[(size_t)m * K_LD + 96 * (n >> 6) + (n & 63)] = (bf16_t)f2bf(w); else e.o1[(size_t)m * V_LD + (n - 256)] = (bf16_t)f2bf(w);
            } else {
                e.xf[(size_t)m * D_MODEL + n] = e.xin[(size_t)m * D_MODEL + n] + v;
            }
        }
}
__global__ void nk_mla_pre(const bf16_t* __restrict__ proj, float* __restrict__ rq, float* __restrict__ rkv, bf16_t* __restrict__ Kb, const float* __restrict__ cs, const float* __restrict__ sn) {
    const int row = blockIdx.x * (blockDim.x >> 6) + (threadIdx.x >> 6), lane = threadIdx.x & 63;
    if (row >= M_TOK) return;
    const bf16_t* p = proj + (size_t)row * PROJ_LD;
    float s = 0.f; for (int c = lane; c < 256; c += 64) { const float v = bf2f(p[C_MCQ + c]); s += v * v; }
    s = wave_sum(s); if (lane == 0) rq[row] = rsqrtf(s * (1.f / 256.f) + RMS_EPS);
    s = 0.f; for (int c = lane; c < 128; c += 64) { const float v = bf2f(p[C_MCKV + c]); s += v * v; }
    s = wave_sum(s); if (lane == 0) rkv[row] = rsqrtf(s * (1.f / 128.f) + RMS_EPS);
    if (lane < 16) { const int pos = row % SEQ; const float c = cs[pos * 16 + lane], sgn = sn[pos * 16 + lane];
        const float x1 = bf2f(p[C_MKR + lane]), x2 = bf2f(p[C_MKR + 16 + lane]); const unsigned a = f2bf(x1 * c - x2 * sgn), b = f2bf(x1 * sgn + x2 * c);
        for (int h = 0; h < 4; ++h) { Kb[(size_t)row * K_LD + 96 * h + 64 + lane] = (bf16_t)a; Kb[(size_t)row * K_LD + 96 * h + 80 + lane] = (bf16_t)b; } }
}
__global__ void nk_rope_q(bf16_t* __restrict__ Q, const float* __restrict__ cs, const float* __restrict__ sn, float qscale) {
    const int i = blockIdx.x * blockDim.x + threadIdx.x; if (i >= M_TOK * 4) return;
    const int row = i >> 2, h = i & 3, pos = row % SEQ; bf16_t* q = Q + (size_t)row * Q_LD + 96 * h;
    for (int c = 0; c < 64; ++c) q[c] = (bf16_t)f2bf(bf2f(q[c]) * qscale);
    for (int j = 0; j < 16; ++j) { const float c = cs[pos * 16 + j], s = sn[pos * 16 + j], x1 = bf2f(q[64 + j]), x2 = bf2f(q[80 + j]);
        q[64 + j] = (bf16_t)f2bf((x1 * c - x2 * s) * qscale); q[80 + j] = (bf16_t)f2bf((x1 * s + x2 * c) * qscale); }
}
__global__ void __launch_bounds__(64) nk_mla_attn(const bf16_t* __restrict__ Q, const bf16_t* __restrict__ Kb, const bf16_t* __restrict__ Vb, const bf16_t* __restrict__ proj, bf16_t* __restrict__ Y, int ldy) {
    __shared__ float Ks[64][96], Vs[64][64];
    const int qt = blockIdx.x, bh = blockIdx.y, b = bh >> 2, h = bh & 3, lane = threadIdx.x;
    const int qpos = qt * 64 + lane; const size_t row = (size_t)b * SEQ + qpos;
    float q[96]; for (int c = 0; c < 96; ++c) q[c] = bf2f(Q[row * Q_LD + 96 * h + c]);
    float o[64]; for (int c = 0; c < 64; ++c) o[c] = 0.f; float m = -INFINITY, l = 0.f;
    for (int kt = 0; kt <= qt; ++kt) {
        __syncthreads();
        for (int i = lane; i < 64 * 96; i += 64) { const int r = i / 96, c = i % 96; Ks[r][c] = bf2f(Kb[((size_t)b * SEQ + kt * 64 + r) * K_LD + 96 * h + c]); }
        for (int i = lane; i < 64 * 64; i += 64) { const int r = i >> 6, c = i & 63; Vs[r][c] = bf2f(Vb[((size_t)b * SEQ + kt * 64 + r) * V_LD + 64 * h + c]); }
        __syncthreads();
        const int kmax = (kt == qt) ? lane : 63;
        for (int j = 0; j < 64; ++j) {
            if (j > kmax) continue;
            float s = 0.f; for (int c = 0; c < 96; ++c) s += q[c] * Ks[j][c];
            if (s > m) { const float f = exp2f(m - s); l *= f; for (int c = 0; c < 64; ++c) o[c] *= f; m = s; }
            const float p = exp2f(s - m); l += p; for (int c = 0; c < 64; ++c) o[c] += p * Vs[j][c];
        }
    }
    const float il = 1.f / l;
    for (int c = 0; c < 64; ++c) { const float g = bf2f(proj[row * PROJ_LD + C_MGATE + 64 * h + c]); Y[row * ldy + 64 * h + c] = (bf16_t)f2bf(o[c] * il * siluf(g)); }
}
__global__ void nk_kmean(const bf16_t* __restrict__ proj, float* __restrict__ km) {
    const int i = blockIdx.x * blockDim.x + threadIdx.x; if (i >= 2 * 4 * 32 * 64) return;
    const int d = i & 63, n = (i >> 6) & 31, h = (i >> 11) & 3, b = i >> 13; float s = 0.f;
    for (int t = 0; t < 256; ++t) s += bf2f(proj[((size_t)b * SEQ + n * 256 + t) * PROJ_LD + C_CK + 64 * h + d]);
    km[i] = s * (1.f / 256.f);
}
__global__ void __launch_bounds__(64) nk_moba_attn(const bf16_t* __restrict__ proj, const float* __restrict__ km, const float* __restrict__ tbl, bf16_t* __restrict__ Y, int ldy) {
    __shared__ float Ks[64][64], Vs[64][64];
    const int qt = blockIdx.x, bh = blockIdx.y, b = bh >> 2, h = bh & 3, lane = threadIdx.x;
    const int qpos = qt * 64 + lane, own = qpos >> 8; const size_t row = (size_t)b * SEQ + qpos;
    float q[64]; for (int c = 0; c < 64; ++c) q[c] = bf2f(proj[row * PROJ_LD + C_CQ + 64 * h + c]);
    int s0 = -1, s1 = -1, s2 = -1; float g0 = -INFINITY, g1 = -INFINITY, g2 = -INFINITY;
    for (int n = 0; n < own; ++n) { const float* kmp = km + ((size_t)(b * 4 + h) * 32 + n) * 64; float g = 0.f; for (int c = 0; c < 64; ++c) g += q[c] * kmp[c];
        if (g > g0) { g2 = g1; s2 = s1; g1 = g0; s1 = s0; g0 = g; s0 = n; } else if (g > g1) { g2 = g1; s2 = s1; g1 = g; s1 = n; } else if (g > g2) { g2 = g; s2 = n; } }
    float o[64]; for (int c = 0; c < 64; ++c) o[c] = 0.f; float m = -INFINITY, l = 0.f;
    const float* tb = tbl + h * 2048;
    for (int n = 0; n <= own; ++n) {
        const bool mine = (n == own) || n == s0 || n == s1 || n == s2;
        for (int kt = 0; kt < 4; ++kt) {
            __syncthreads();
            for (int i = lane; i < 64 * 64; i += 64) { const int r = i >> 6, c = i & 63; const size_t kr = ((size_t)b * SEQ + n * 256 + kt * 64 + r) * PROJ_LD;
                Ks[r][c] = bf2f(proj[kr + C_CK + 64 * h + c]); Vs[r][c] = bf2f(proj[kr + C_CV + 64 * h + c]); }
            __syncthreads();
            if (!mine) continue;
            for (int j = 0; j < 64; ++j) {
                const int kpos = n * 256 + kt * 64 + j, rel = qpos - kpos;
                if (rel < 0) continue;
                float s = 0.f; for (int c = 0; c < 64; ++c) s += q[c] * Ks[j][c];
                s = s * 0.125f + tb[rel < 2047 ? rel : 2047];
                if (s > m) { const float f = __expf(m - s); l *= f; for (int c = 0; c < 64; ++c) o[c] *= f; m = s; }
                const float p = __expf(s - m); l += p; for (int c = 0; c < 64; ++c) o[c] += p * Vs[j][c];
            }
        }
    }
    const float il = 1.f / l;
    for (int c = 0; c < 64; ++c) { const float g = bf2f(proj[row * PROJ_LD + C_CGATE + 64 * h + c]); Y[row * ldy + 768 + 64 * h + c] = (bf16_t)f2bf(o[c] * il * siluf(g)); }
}
__global__ void __launch_bounds__(128) nk_gdn(const bf16_t* __restrict__ proj, const float* __restrict__ convw, const float* __restrict__ A_log, const float* __restrict__ dt_bias, const float* __restrict__ normw, bf16_t* __restrict__ Y, int ldy) {
    __shared__ float qs[32][128], ks[32][128], vs[32][128], bs[32], gs[32], red[32][2][2];
    const int bh = blockIdx.x, b = bh >> 2, h = bh & 3, tid = threadIdx.x, wv = tid >> 6, lane = tid & 63;
    float S[128]; for (int i = 0; i < 128; ++i) S[i] = 0.f;
    float wq[4], wk[4], wvv[4]; for (int j = 0; j < 4; ++j) { wq[j] = convw[j * 1536 + h * 128 + tid]; wk[j] = convw[j * 1536 + 512 + h * 128 + tid]; wvv[j] = convw[j * 1536 + 1024 + h * 128 + tid]; }
    const float Aexp = __expf(A_log[h]), dtb = dt_bias[h], nw = normw[tid];
    for (int t0 = 0; t0 < SEQ; t0 += 32) {
        __syncthreads();
        for (int t = 0; t < 32; ++t) {
            float aq = 0.f, ak = 0.f, av = 0.f;
            for (int j = 0; j < 4; ++j) { const int tt = t0 + t - 3 + j; if (tt < 0) continue; const bf16_t* p = proj + ((size_t)b * SEQ + tt) * PROJ_LD;
                aq += wq[j] * bf2f(p[C_GQ + h * 128 + tid]); ak += wk[j] * bf2f(p[C_GK + h * 128 + tid]); av += wvv[j] * bf2f(p[C_GV + h * 128 + tid]); }
            aq = siluf(aq); ak = siluf(ak); av = siluf(av);
            const float sq = wave_sum(aq * aq), sk = wave_sum(ak * ak);
            if (lane == 0) { red[t][wv][0] = sq; red[t][wv][1] = sk; }
            qs[t][tid] = aq; ks[t][tid] = ak; vs[t][tid] = av;
        }
        if (tid < 32) { const bf16_t* p = proj + ((size_t)b * SEQ + t0 + tid) * PROJ_LD; const float bb = bf2f(p[C_GB + h]), aa = bf2f(p[C_GA + h]) + dtb;
            bs[tid] = 1.f / (1.f + __expf(-bb)); const float sp = (aa > 20.f) ? aa : log1pf(__expf(aa)); gs[tid] = -Aexp * sp; }
        __syncthreads();
        for (int t = 0; t < 32; ++t) { const float rq = rsqrtf(red[t][0][0] + red[t][1][0] + 1e-6f) * 0.08838834764831845f, rk = rsqrtf(red[t][0][1] + red[t][1][1] + 1e-6f);
            qs[t][tid] *= rq; ks[t][tid] *= rk; }
        __syncthreads();
        for (int t = 0; t < 32; ++t) {
            const float g = __expf(gs[t]), be = bs[t], v = vs[t][tid];
            float u = 0.f; for (int i = 0; i < 128; ++i) u += ks[t][i] * S[i];
            const float w = be * (v - g * u); float o = 0.f;
            for (int i = 0; i < 128; ++i) { S[i] = g * S[i] + ks[t][i] * w; o += qs[t][i] * S[i]; }
            vs[t][tid] = o;
        }
        __syncthreads();
        for (int t = 0; t < 32; ++t) {
            const float o = vs[t][tid]; const float ss = wave_sum(o * o); if (lane == 0) red[t][wv][0] = ss;
        }
        __syncthreads();
        for (int t = 0; t < 32; ++t) { const size_t row = (size_t)b * SEQ + t0 + t; const float rs = rsqrtf((red[t][0][0] + red[t][1][0]) * (1.f / 128.f) + RMS_EPS);
            const float z = bf2f(proj[row * PROJ_LD + C_GZ + h * 128 + tid]); Y[row * ldy + 256 + h * 128 + tid] = (bf16_t)f2bf(vs[t][tid] * rs * nw * siluf(z)); }
    }
}
__global__ void nk_final(float* __restrict__ out, const float* __restrict__ w) {
    const int row = blockIdx.x * (blockDim.x >> 6) + (threadIdx.x >> 6), lane = threadIdx.x & 63; if (row >= M_TOK) return;
    float v[16]; float s = 0.f;
    for (int j = 0; j < 16; ++j) { v[j] = out[(size_t)row * D_MODEL + j * 64 + lane]; s += v[j] * v[j]; }
    const float rs = rsqrtf(wave_sum(s) * (1.f / D_MODEL) + RMS_EPS);
    for (int j = 0; j < 16; ++j) out[(size_t)row * D_MODEL + j * 64 + lane] = v[j] * rs * w[j * 64 + lane];
}

extern "C" void kernel_launch(void* const* d_in, const int* in_sizes, int n_in, void* d_out, int out_size, void* d_ws, size_t ws_size, hipStream_t stream) {
    if (n_in != 14 || ws_size < WS_END) return;
    const float* x = (const float*)d_in[0]; const float* norm_w = (const float*)d_in[1]; const float* w_in = (const float*)d_in[2];
    const float* q_norm = (const float*)d_in[3]; const float* w_uq = (const float*)d_in[4]; const float* kv_norm = (const float*)d_in[5]; const float* w_ukv = (const float*)d_in[6];
    const float* conv_w = (const float*)d_in[7]; const float* A_log = (const float*)d_in[8]; const float* dt_bias = (const float*)d_in[9]; const float* gnorm_w = (const float*)d_in[10];
    const float* w_out = (const float*)d_in[11]; const float* t5 = (const float*)d_in[12]; const float* fnorm = (const float*)d_in[13];
    unsigned char* ws = (unsigned char*)d_ws; float* out = (float*)d_out;
    float* TBL = (float*)(ws + WS_TBL); float* KM = (float*)(ws + WS_KMEAN); float* SSQ = (float*)(ws + WS_SSQ); float* RQ = (float*)(ws + WS_RQ); float* RKV = (float*)(ws + WS_RKV);
    float* COS = (float*)(ws + WS_COS); float* SIN = (float*)(ws + WS_SIN);
    bf16_t* WIN = (bf16_t*)(ws + WS_WIN); bf16_t* WOUT = (bf16_t*)(ws + WS_WOUT); bf16_t* WUQ = (bf16_t*)(ws + WS_WUQ); bf16_t* WUKV = (bf16_t*)(ws + WS_WUKV);
    bf16_t* Qb = (bf16_t*)(ws + WS_Q); bf16_t* Kb = (bf16_t*)(ws + WS_K); bf16_t* Vb = (bf16_t*)(ws + WS_V); bf16_t* PROJ = (bf16_t*)(ws + WS_PROJ); bf16_t* XB = (bf16_t*)(ws + WS_XB); bf16_t* YN = (bf16_t*)(ws + WS_YN);
    nk_tables<<<(SEQ * 16 + 255) / 256, 256, 0, stream>>>(t5, TBL, COS, SIN);
    const float qscale = 0.10206207261596577f * 1.4426950408889634f;
    for (int l = 0; l < DEPTH; ++l) {
        nk_wt<<<(3840 * 1024 + 255) / 256, 256, 0, stream>>>(w_in + (size_t)l * 1024 * IN_COLS, norm_w + l * 1024, WIN, 1024, IN_COLS, 3840, 0);
        nk_wt<<<(1024 * 1024 + 255) / 256, 256, 0, stream>>>(w_out + (size_t)l * 1024 * 1024, nullptr, WOUT, 1024, 1024, 1024, 0);
        nk_wt<<<(512 * 256 + 255) / 256, 256, 0, stream>>>(w_uq + (size_t)l * 256 * 384, q_norm + l * 256, WUQ, 256, 384, 512, 0);
        nk_wt<<<(512 * 128 + 255) / 256, 256, 0, stream>>>(w_ukv + (size_t)l * 128 * 512, kv_norm + l * 128, WUKV, 128, 512, 512, 1);
        nk_xprep<<<M_TOK / 4, 256, 0, stream>>>(l == 0 ? x : out, XB, SSQ);
        { EpiArgs e{}; e.o0 = PROJ; e.r = SSQ; e.mode = 0; nk_gemm<<<dim3(3840 / 64, M_TOK / 64), 256, 0, stream>>>(XB, 1024, WIN, 1024, 1024, e); }
        nk_mla_pre<<<M_TOK / 4, 256, 0, stream>>>(PROJ, RQ, RKV, Kb, COS, SIN);
        { EpiArgs e{}; e.o0 = Qb; e.r = RQ; e.mode = 1; nk_gemm<<<dim3(512 / 64, M_TOK / 64), 256, 0, stream>>>(PROJ + C_MCQ, PROJ_LD, WUQ, 256, 256, e); }
        { EpiArgs e{}; e.o0 = Kb; e.o1 = Vb; e.r = RKV; e.mode = 2; nk_gemm<<<dim3(512 / 64, M_TOK / 64), 256, 0, stream>>>(PROJ + C_MCKV, PROJ_LD, WUKV, 128, 128, e); }
        nk_rope_q<<<(M_TOK * 4 + 255) / 256, 256, 0, stream>>>(Qb, COS, SIN, qscale);
        nk_kmean<<<(2 * 4 * 32 * 64 + 255) / 256, 256, 0, stream>>>(PROJ, KM);
        nk_mla_attn<<<dim3(SEQ / 64, 8), 64, 0, stream>>>(Qb, Kb, Vb, PROJ, YN, 1024);
        nk_moba_attn<<<dim3(SEQ / 64, 8), 64, 0, stream>>>(PROJ, KM, TBL, YN, 1024);
        nk_gdn<<<8, 128, 0, stream>>>(PROJ, conv_w + (size_t)l * 4 * 1536, A_log + l * 4, dt_bias + l * 4, gnorm_w + l * 128, YN, 1024);
        { EpiArgs e{}; e.xf = out; e.xin = (l == 0) ? x : out; e.mode = 3; nk_gemm<<<dim3(1024 / 64, M_TOK / 64), 256, 0, stream>>>(YN, 1024, WOUT, 1024, 1024, e); }
    }
    nk_final<<<M_TOK / 4, 256, 0, stream>>>(out, fnorm);
}
```

```cpp
#include <hip/hip_runtime.h>
#include <cstdint>
#include <cstddef>

constexpr int D_MODEL = 1024, BATCH = 2, SEQ = 8192, DEPTH = 4, M_TOK = BATCH * SEQ;
constexpr int IN_COLS = 3752, PROJ_LD = 3840;
constexpr int C_MCQ = 0, C_MCKV = 256, C_MKR = 384, C_MGATE = 416, C_GQ = 672, C_GK = 1184, C_GV = 1696, C_GZ = 2208, C_GB = 2720, C_GA = 2724,
              C_CQ = 2728, C_CK = 2984, C_CV = 3240, C_CGATE = 3496;
constexpr float RMS_EPS = 1e-6f;
constexpr int Q_LD = 384, K_LD = 384, V_LD = 256;

constexpr size_t MiB = 1u << 20;
constexpr size_t WS_CTL = 0;
constexpr size_t WS_TBL = 1 * MiB;
constexpr size_t WS_KMEAN = WS_TBL + 32768;
constexpr size_t WS_SSQ = WS_KMEAN + 65536;
constexpr size_t WS_RQ = WS_SSQ + 262144;
constexpr size_t WS_RKV = WS_RQ + 65536;
constexpr size_t WS_COS = WS_RKV + 65536;
constexpr size_t WS_SIN = WS_COS + 524288;
constexpr size_t WS_GEND = WS_SIN + 524288;
constexpr size_t WS_WIN = 3 * MiB;
constexpr size_t WS_WOUT = WS_WIN + 3840 * 1024 * 2;
constexpr size_t WS_WUQ = WS_WOUT + 2 * MiB;
constexpr size_t WS_WUKV = WS_WUQ + 262144;
constexpr size_t WS_Q = 13 * MiB;
constexpr size_t WS_K = 25 * MiB;
constexpr size_t WS_V = 37 * MiB;
constexpr size_t WS_PROJ = 45 * MiB;
constexpr size_t WS_XB = 165 * MiB;
constexpr size_t WS_GDN = 165 * MiB;
constexpr size_t WS_YN = 197 * MiB;
constexpr size_t WS_END = 256 * MiB;

typedef unsigned short bf16_t;
__device__ __forceinline__ unsigned f2bf(float f) { unsigned u = __builtin_bit_cast(unsigned, f); return (u + 0x7fffu + ((u >> 16) & 1u)) >> 16; }
__device__ __forceinline__ float bf2f(bf16_t b) { return __builtin_bit_cast(float, (unsigned)b << 16); }
__device__ __forceinline__ float siluf(float x) { return x / (1.f + __expf(-x)); }
__device__ __forceinline__ float wave_sum(float v) {
#pragma unroll
    for (int o = 1; o < 64; o <<= 1) v += __shfl_xor(v, o);
    return v;
}

__global__ void nk_wt(const float* __restrict__ W, const float* __restrict__ s, bf16_t* __restrict__ Wt, int K, int N, int NP, int mode) {
    const size_t i = (size_t)blockIdx.x * blockDim.x + threadIdx.x;
    if (i >= (size_t)NP * K) return;
    const int n = (int)(i / K), k = (int)(i % K);
    float v = 0.f;
    if (n < N) {
        int src = n;
        if (mode == 1) { const int nn = n & 255, hd = nn >> 6, c = nn & 63; src = hd * 128 + c + ((n >= 256) ? 64 : 0); }
        v = W[(size_t)k * N + src] * (s ? s[k] : 1.f);
    }
    Wt[i] = (bf16_t)f2bf(v);
}
__global__ void nk_tables(const float* __restrict__ t5, float* __restrict__ tbl, float* __restrict__ cs, float* __restrict__ sn) {
    const int i = blockIdx.x * blockDim.x + threadIdx.x;
    if (i < 4 * 2048) {
        const int h = i >> 11, rel = i & 2047; int b;
        if (rel < 16) b = rel; else { const float nf = (float)rel; b = 16 + (int)(logf(nf / 16.f) / 4.852030263919617f * 16.f); if (b > 31) b = 31; }
        tbl[i] = t5[b * 4 + h];
    }
    if (i < SEQ * 16) {
        const int pos = i >> 4, j = i & 15;
        const float inv = (float)(1.0 / pow(10000.0, (double)(2 * j) / 32.0));
        const float ang = (float)pos * inv;
        cs[i] = (float)cos((double)ang); sn[i] = (float)sin((double)ang);
    }
}
__global__ void nk_xprep(const float* __restrict__ x, bf16_t* __restrict__ xb, float* __restrict__ ssq) {
    const int row = blockIdx.x * (blockDim.x >> 6) + (threadIdx.x >> 6), lane = threadIdx.x & 63;
    if (row >= M_TOK) return;
    float s = 0.f;
    for (int c = lane; c < D_MODEL; c += 64) { const float v = x[(size_t)row * D_MODEL + c]; s += v * v; xb[(size_t)row * D_MODEL + c] = (bf16_t)f2bf(v); }
    s = wave_sum(s);
    if (lane == 0) { ssq[row * 4] = s; ssq[row * 4 + 1] = 0.f; ssq[row * 4 + 2] = 0.f; ssq[row * 4 + 3] = 0.f; }
}
struct EpiArgs { bf16_t* o0; bf16_t* o1; float* xf; const float* xin; const float* r; int mode; int pad; };
__global__ void __launch_bounds__(256) nk_gemm(const bf16_t* __restrict__ A, int lda, const bf16_t* __restrict__ Bt, int ldb, int K, EpiArgs e) {
    __shared__ float As[16][65], Bs[16][65];
    const int tx = threadIdx.x & 15, ty = threadIdx.x >> 4, m0 = blockIdx.y * 64, n0 = blockIdx.x * 64;
    float acc[4][4] = {};
    for (int k0 = 0; k0 < K; k0 += 16) {
        for (int i = threadIdx.x; i < 1024; i += 256) { const int r = i >> 4, c = i & 15;
            As[c][r] = bf2f(A[(size_t)(m0 + r) * lda + k0 + c]); Bs[c][r] = bf2f(Bt[(size_t)(n0 + r) * ldb + k0 + c]); }
        __syncthreads();
#pragma unroll
        for (int kk = 0; kk < 16; ++kk) { float a[4], b[4];
#pragma unroll
            for (int i = 0; i < 4; ++i) { a[i] = As[kk][ty * 4 + i]; b[i] = Bs[kk][tx * 4 + i]; }
#pragma unroll
            for (int i = 0; i < 4; ++i)
#pragma unroll
                for (int j = 0; j < 4; ++j) acc[i][j] += a[i] * b[j]; }
        __syncthreads();
    }
#pragma unroll
    for (int i = 0; i < 4; ++i)
#pragma unroll
        for (int j = 0; j < 4; ++j) {
            const int m = m0 + ty * 4 + i, n = n0 + tx * 4 + j; const float v = acc[i][j];
            if (e.mode == 0) {
                if (n < IN_COLS) { const float* q = e.r + m * 4; const float rs = rsqrtf((q[0] + q[1] + q[2] + q[3]) * (1.f / D_MODEL) + RMS_EPS); e.o0[(size_t)m * PROJ_LD + n] = (bf16_t)f2bf(v * rs); }
            } else if (e.mode == 1) {
                if (n < 384) e.o0[(size_t)m * Q_LD + n] = (bf16_t)f2bf(v * e.r[m]);
            } else if (e.mode == 2) {
                const float w = v * e.r[m];
                if (n < 256) e.o0[(size_t)m * K_LD + 96 * (n >> 6) + (n & 63)] = (bf16_t)f2bf(w); else e.o1[(size_t)m * V_LD + (n - 256)] = (bf16_t)f2bf(w);
            } else {
                e.xf[(size_t)m * D_MODEL + n] = e.xin[(size_t)m * D_MODEL + n] + v;
            }
        }
}
__global__ void nk_mla_pre(const bf16_t* __restrict__ proj, float* __restrict__ rq, float* __restrict__ rkv, bf16_t* __restrict__ Kb, const float* __restrict__ cs, const float* __restrict__ sn) {
    const int row = blockIdx.x * (blockDim.x >> 6) + (threadIdx.x >> 6), lane = threadIdx.x & 63;
    if (row >= M_TOK) return;
    const bf16_t* p = proj + (size_t)row * PROJ_LD;
    float s = 0.f; for (int c = lane; c < 256; c += 64) { const float v = bf2f(p[C_MCQ + c]); s += v * v; }
    s = wave_sum(s); if (lane == 0) rq[row] = rsqrtf(s * (1.f / 256.f) + RMS_EPS);
    s = 0.f; for (int c = lane; c < 128; c += 64) { const float v = bf2f(p[C_MCKV + c]); s += v * v; }
    s = wave_sum(s); if (lane == 0) rkv[row] = rsqrtf(s * (1.f / 128.f) + RMS_EPS);
    if (lane < 16) { const int pos = row % SEQ; const float c = cs[pos * 16 + lane], sgn = sn[pos * 16 + lane];
        const float x1 = bf2f(p[C_MKR + lane]), x2 = bf2f(p[C_MKR + 16 + lane]); const unsigned a = f2bf(x1 * c - x2 * sgn), b = f2bf(x1 * sgn + x2 * c);
        for (int h = 0; h < 4; ++h) { Kb[(size_t)row * K_LD + 96 * h + 64 + lane] = (bf16_t)a; Kb[(size_t)row * K_LD + 96 * h + 80 + lane] = (bf16_t)b; } }
}
__global__ void nk_rope_q(bf16_t* __restrict__ Q, const float* __restrict__ cs, const float* __restrict__ sn, float qscale) {
    const int i = blockIdx.x * blockDim.x + threadIdx.x; if (i >= M_TOK * 4) return;
    const int row = i >> 2, h = i & 3, pos = row % SEQ; bf16_t* q = Q + (size_t)row * Q_LD + 96 * h;
    for (int c = 0; c < 64; ++c) q[c] = (bf16_t)f2bf(bf2f(q[c]) * qscale);
    for (int j = 0; j < 16; ++j) { const float c = cs[pos * 16 + j], s = sn[pos * 16 + j], x1 = bf2f(q[64 + j]), x2 = bf2f(q[80 + j]);
        q[64 + j] = (bf16_t)f2bf((x1 * c - x2 * s) * qscale); q[80 + j] = (bf16_t)f2bf((x1 * s + x2 * c) * qscale); }
}
__global__ void __launch_bounds__(64) nk_mla_attn(const bf16_t* __restrict__ Q, const bf16_t* __restrict__ Kb, const bf16_t* __restrict__ Vb, const bf16_t* __restrict__ proj, bf16_t* __restrict__ Y, int ldy) {
    __shared__ float Ks[64][96], Vs[64][64];
    const int qt = blockIdx.x, bh = blockIdx.y, b = bh >> 2, h = bh & 3, lane = threadIdx.x;
    const int qpos = qt * 64 + lane; const size_t row = (size_t)b * SEQ + qpos;
    float q[96]; for (int c = 0; c < 96; ++c) q[c] = bf2f(Q[row * Q_LD + 96 * h + c]);
    float o[64]; for (int c = 0; c < 64; ++c) o[c] = 0.f; float m = -INFINITY, l = 0.f;
    for (int kt = 0; kt <= qt; ++kt) {
        __syncthreads();
        for (int i = lane; i < 64 * 96; i += 64) { const int r = i / 96, c = i % 96; Ks[r][c] = bf2f(Kb[((size_t)b * SEQ + kt * 64 + r) * K_LD + 96 * h + c]); }
        for (int i = lane; i < 64 * 64; i += 64) { const int r = i >> 6, c = i & 63; Vs[r][c] = bf2f(Vb[((size_t)b * SEQ + kt * 64 + r) * V_LD + 64 * h + c]); }
        __syncthreads();
        const int kmax = (kt == qt) ? lane : 63;
        for (int j = 0; j < 64; ++j) {
            if (j > kmax) continue;
            float s = 0.f; for (int c = 0; c < 96; ++c) s += q[c] * Ks[j][c];
            if (s > m) { const float f = exp2f(m - s); l *= f; for (int c = 0; c < 64; ++c) o[c] *= f; m = s; }
            const float p = exp2f(s - m); l += p; for (int c = 0; c < 64; ++c) o[c] += p * Vs[j][c];
        }
    }
    const float il = 1.f / l;
    for (int c = 0; c < 64; ++c) { const float g = bf2f(proj[row * PROJ_LD + C_MGATE + 64 * h + c]); Y[row * ldy + 64 * h + c] = (bf16_t)f2bf(o[c] * il * siluf(g)); }
}
__global__ void nk_kmean(const bf16_t* __restrict__ proj, float* __restrict__ km) {
    const int i = blockIdx.x * blockDim.x + threadIdx.x; if (i >= 2 * 4 * 32 * 64) return;
    const int d = i & 63, n = (i >> 6) & 31, h = (i >> 11) & 3, b = i >> 13; float s = 0.f;
    for (int t = 0; t < 256; ++t) s += bf2f(proj[((size_t)b * SEQ + n * 256 + t) * PROJ_LD + C_CK + 64 * h + d]);
    km[i] = s * (1.f / 256.f);
}
__global__ void __launch_bounds__(64) nk_moba_attn(const bf16_t* __restrict__ proj, const float* __restrict__ km, const float* __restrict__ tbl, bf16_t* __restrict__ Y, int ldy) {
    __shared__ float Ks[64][64], Vs[64][64];
    const int qt = blockIdx.x, bh = blockIdx.y, b = bh >> 2, h = bh & 3, lane = threadIdx.x;
    const int qpos = qt * 64 + lane, own = qpos >> 8; const size_t row = (size_t)b * SEQ + qpos;
    float q[64]; for (int c = 0; c < 64; ++c) q[c] = bf2f(proj[row * PROJ_LD + C_CQ + 64 * h + c]);
    int s0 = -1, s1 = -1, s2 = -1; float g0 = -INFINITY, g1 = -INFINITY, g2 = -INFINITY;
    for (int n = 0; n < own; ++n) { const float* kmp = km + ((size_t)(b * 4 + h) * 32 + n) * 64; float g = 0.f; for (int c = 0; c < 64; ++c) g += q[c] * kmp[c];
        if (g > g0) { g2 = g1; s2 = s1; g1 = g0; s1 = s0; g0 = g; s0 = n; } else if (g > g1) { g2 = g1; s2 = s1; g1 = g; s1 = n; } else if (g > g2) { g2 = g; s2 = n; } }
    float o[64]; for (int c = 0; c < 64; ++c) o[c] = 0.f; float m = -INFINITY, l = 0.f;
    const float* tb = tbl + h * 2048;
    for (int n = 0; n <= own; ++n) {
        const bool mine = (n == own) || n == s0 || n == s1 || n == s2;
        for (int kt = 0; kt < 4; ++kt) {
            __syncthreads();
            for (int i = lane; i < 64 * 64; i += 64) { const int r = i >> 6, c = i & 63; const size_t kr = ((size_t)b * SEQ + n * 256 + kt * 64 + r) * PROJ_LD;
                Ks[r][c] = bf2f(proj[kr + C_CK + 64 * h + c]); Vs[r][c] = bf2f(proj[kr + C_CV + 64 * h + c]); }
            __syncthreads();
            if (!mine) continue;
            for (int j = 0; j < 64; ++j) {
                const int kpos = n * 256 + kt * 64 + j, rel = qpos - kpos;
                if (rel < 0) continue;
                float s = 0.f; for (int c = 0; c < 64; ++c) s += q[c] * Ks[j][c];
                s = s * 0.125f + tb[rel < 2047 ? rel : 2047];
                if (s > m) { const float f = __expf(m - s); l *= f; for (int c = 0; c < 64; ++c) o[c] *= f; m = s; }
                const float p = __expf(s - m); l += p; for (int c = 0; c < 64; ++c) o[c] += p * Vs[j][c];
            }
        }
    }
    const float il = 1.f / l;
    for (int c = 0; c < 64; ++c) { const float g = bf2f(proj[row * PROJ_LD + C_CGATE + 64 * h + c]); Y[row * ldy + 768 + 64 * h + c] = (bf16_t)f2bf(o[c] * il * siluf(g)); }
}
__global__ void __launch_bounds__(128) nk_gdn(const bf16_t* __restrict__ proj, const float* __restrict__ convw, const float* __restrict__ A_log, const float* __restrict__ dt_bias, const float* __restrict__ normw, bf16_t* __restrict__ Y, int ldy) {
    __shared__ float qs[32][128], ks[32][128], vs[32][128], bs[32], gs[32], red[32][2][2];
    const int bh = blockIdx.x, b = bh >> 2, h = bh & 3, tid = threadIdx.x, wv = tid >> 6, lane = tid & 63;
    float S[128]; for (int i = 0; i < 128; ++i) S[i] = 0.f;
    float wq[4], wk[4], wvv[4]; for (int j = 0; j < 4; ++j) { wq[j] = convw[j * 1536 + h * 128 + tid]; wk[j] = convw[j * 1536 + 512 + h * 128 + tid]; wvv[j] = convw[j * 1536 + 1024 + h * 128 + tid]; }
    const float Aexp = __expf(A_log[h]), dtb = dt_bias[h], nw = normw[tid];
    for (int t0 = 0; t0 < SEQ; t0 += 32) {
        __syncthreads();
        for (int t = 0; t < 32; ++t) {
            float aq = 0.f, ak = 0.f, av = 0.f;
            for (int j = 0; j < 4; ++j) { const int tt = t0 + t - 3 + j; if (tt < 0) continue; const bf16_t* p = proj + ((size_t)b * SEQ + tt) * PROJ_LD;
                aq += wq[j] * bf2f(p[C_GQ + h * 128 + tid]); ak += wk[j] * bf2f(p[C_GK + h * 128 + tid]); av += wvv[j] * bf2f(p[C_GV + h * 128 + tid]); }
            aq = siluf(aq); ak = siluf(ak); av = siluf(av);
            const float sq = wave_sum(aq * aq), sk = wave_sum(ak * ak);
            if (lane == 0) { red[t][wv][0] = sq; red[t][wv][1] = sk; }
            qs[t][tid] = aq; ks[t][tid] = ak; vs[t][tid] = av;
        }
        if (tid < 32) { const bf16_t* p = proj + ((size_t)b * SEQ + t0 + tid) * PROJ_LD; const float bb = bf2f(p[C_GB + h]), aa = bf2f(p[C_GA + h]) + dtb;
            bs[tid] = 1.f / (1.f + __expf(-bb)); const float sp = (aa > 20.f) ? aa : log1pf(__expf(aa)); gs[tid] = -Aexp * sp; }
        __syncthreads();
        for (int t = 0; t < 32; ++t) { const float rq = rsqrtf(red[t][0][0] + red[t][1][0] + 1e-6f) * 0.08838834764831845f, rk = rsqrtf(red[t][0][1] + red[t][1][1] + 1e-6f);
            qs[t][tid] *= rq; ks[t][tid] *= rk; }
        __syncthreads();
        for (int t = 0; t < 32; ++t) {
            const float g = __expf(gs[t]), be = bs[t], v = vs[t][tid];
            float u = 0.f; for (int i = 0; i < 128; ++i) u += ks[t][i] * S[i];
            const float w = be * (v - g * u); float o = 0.f;
            for (int i = 0; i < 128; ++i) { S[i] = g * S[i] + ks[t][i] * w; o += qs[t][i] * S[i]; }
            vs[t][tid] = o;
        }
        __syncthreads();
        for (int t = 0; t < 32; ++t) {
            const float o = vs[t][tid]; const float ss = wave_sum(o * o); if (lane == 0) red[t][wv][0] = ss;
        }
        __syncthreads();
        for (int t = 0; t < 32; ++t) { const size_t row = (size_t)b * SEQ + t0 + t; const float rs = rsqrtf((red[t][0][0] + red[t][1][0]) * (1.f / 128.f) + RMS_EPS);
            const float z = bf2f(proj[row * PROJ_LD + C_GZ + h * 128 + tid]); Y[row * ldy + 256 + h * 128 + tid] = (bf16_t)f2bf(vs[t][tid] * rs * nw * siluf(z)); }
    }
}
__global__ void nk_final(float* __restrict__ out, const float* __restrict__ w) {
    const int row = blockIdx.x * (blockDim.x >> 6) + (threadIdx.x >> 6), lane = threadIdx.x & 63; if (row >= M_TOK) return;
    float v[16]; float s = 0.f;
    for (int j = 0; j < 16; ++j) { v[j] = out[(size_t)row * D_MODEL + j * 64 + lane]; s += v[j] * v[j]; }
    const float rs = rsqrtf(wave_sum(s) * (1.f / D_MODEL) + RMS_EPS);
    for (int j = 0; j < 16; ++j) out[(size_t)row * D_MODEL + j * 64 + lane] = v[j] * rs * w[j * 64 + lane];
}

#define LAS __attribute__((address_space(3)))
#define GAS __attribute__((address_space(1)))
typedef short bf16x8 __attribute__((ext_vector_type(8)));
typedef float f32x4 __attribute__((ext_vector_type(4)));
typedef float f32x2 __attribute__((ext_vector_type(2)));
typedef float f32x16 __attribute__((ext_vector_type(16)));
typedef unsigned u32x4 __attribute__((ext_vector_type(4)));
typedef unsigned u32x2 __attribute__((ext_vector_type(2)));
typedef __bf16 bf16x2_t __attribute__((ext_vector_type(2)));
__device__ __forceinline__ unsigned cvtpk(float lo, float hi) { f32x2 v = {lo, hi}; bf16x2_t b = __builtin_convertvector(v, bf16x2_t); return __builtin_bit_cast(unsigned, b); }
#define LDS_WAIT() asm volatile("s_waitcnt lgkmcnt(0)" ::: "memory")
#define VM_WAIT() asm volatile("s_waitcnt vmcnt(0)" ::: "memory")

constexpr int RING_BYTES = 131072;
constexpr int LDS_RS = 131072;
constexpr int LDS_MISC = 131072 + 24576;
constexpr int LDS_BYTES = 163840;

namespace pg8 {
constexpr int BM = 256, BK = 64, HALF = 128, HTB = HALF * BK * 2, NXCD = 8, WGM = 8;
__host__ __device__ __forceinline__ int lds_byte(int r, int c) { const int st = (r >> 4) * 2 + (c >> 5), rr = r & 15, cc = c & 31, ob = rr * 64 + cc * 2; return st * 1024 + (ob ^ (((ob >> 9) & 1) << 5)); }
__host__ __device__ __forceinline__ void stage_rc(int b, int& R, int& C) { const int st = b / 1024, sb = b % 1024, swz = sb ^ (((sb >> 9) & 1) << 5); R = (st >> 1) * 16 + swz / 64; C = (st & 1) * 32 + (swz % 64) / 2; }
__host__ __device__ __forceinline__ int perm32(int rho) { const int n = rho >> 4, i = rho & 15; return 8 * (i >> 2) + 4 * n + (i & 3); }
struct Unit { int pm, pn; };
struct Gemm { const bf16_t* A; const bf16_t* Bt; int lda, ldb, K; };
struct StaticOrder {
    int nM, nN, nwg, G, c;
    __device__ void init(int M, int N, int G_, int c_) { nM = M / BM; nN = N / BM; nwg = nM * nN; G = G_; c = c_; }
    __device__ bool next(int i, Unit& u) const {
        const long L = (long)i * G + c; if (L >= nwg) return false;
        int wgid = (int)L; { const int q = nwg / NXCD, r = nwg % NXCD, xcd = wgid % NXCD, off = wgid / NXCD; wgid = (xcd < r ? xcd * (q + 1) : r * (q + 1) + (xcd - r) * q) + off; }
        const int nig = WGM * nN, gid = wgid / nig, fm = gid * WGM, gsz = (nM - fm) < WGM ? (nM - fm) : WGM;
        u.pm = fm + ((wgid % nig) % gsz); u.pn = (wgid % nig) / gsz; return true;
    }
};
struct OneUnit {
    int pm, pn; bool have;
    __device__ bool next(int i, Unit& u) const { if (i > 0 || !have) return false; u.pm = pm; u.pn = pn; return true; }
};
template <class Epi, class Sched>
__device__ __forceinline__ void gemm_phase(LAS unsigned char* lds, const Gemm g, const Sched& S, const Epi& E) {
    int tid_ = threadIdx.x; asm volatile("" : "+v"(tid_));
    const int tid = tid_, wid = __builtin_amdgcn_readfirstlane(tid >> 6), lane = tid & 63, wr = wid >> 2, wc = wid & 3, fr = lane & 15, fq = lane >> 4;
    int K_ = g.K; asm volatile("" : "+s"(K_));
    const int K = K_, nt = K / BK;
    unsigned voffA[2], voffB[2];
#pragma unroll
    for (int i = 0; i < 2; ++i) { int R, C; stage_rc(tid * 16 + i * 8192, R, C); const int Rb = Epi::PERM ? ((R & ~31) + perm32(R & 31)) : R;
        voffA[i] = (unsigned)(R * g.lda + C) * 2u; voffB[i] = (unsigned)(Rb * g.ldb + C) * 2u; }
    const size_t kstep = (size_t)(BK * 2);
    const size_t hstepA = (size_t)HALF * g.lda * 2, hstepB = (size_t)HALF * g.ldb * 2, tstepA = 2 * hstepA, tstepB = 2 * hstepB;
    const unsigned ldsw = (unsigned)wid * 1024u;
    const int aoff = lds_byte(wr * 64 + fr, fq * 8), boff = lds_byte(wc * 32 + fr, fq * 8);
#define PG8_SA(b, h) (((b) * 2 + (h)) * HTB)
#define PG8_SB(b, h) ((4 + (b) * 2 + (h)) * HTB)
#define PG8_STAGE(bufoff, gbase, voff) do { _Pragma("unroll") for (int _i = 0; _i < 2; ++_i) \
        __builtin_amdgcn_global_load_lds((const unsigned*)((const char*)(gbase) + (voff)[_i]), (LAS unsigned*)(lds + (bufoff) + ldsw + _i * 8192), 16, 0, 0); } while (0)
#define PG8_LDA(dst, b, h) do { _Pragma("unroll") for (int m = 0; m < 4; ++m) _Pragma("unroll") for (int k = 0; k < 2; ++k) dst[m][k] = *(const LAS bf16x8*)(lds + PG8_SA(b, h) + aoff + m * 2048 + k * 1024); } while (0)
#define PG8_LDB(dst, b, h) do { _Pragma("unroll") for (int n = 0; n < 2; ++n) _Pragma("unroll") for (int k = 0; k < 2; ++k) dst[n][k] = *(const LAS bf16x8*)(lds + PG8_SB(b, h) + boff + n * 2048 + k * 1024); } while (0)
#define PG8_MMA(ai, bj, At, Bt) do { __builtin_amdgcn_s_setprio(1); _Pragma("unroll") for (int m = 0; m < 4; ++m) _Pragma("unroll") for (int n = 0; n < 2; ++n) _Pragma("unroll") for (int k = 0; k < 2; ++k) \
        acc[ai][bj][m][n] = __builtin_amdgcn_mfma_f32_16x16x32_bf16(Bt[n][k], At[m][k], acc[ai][bj][m][n], 0, 0, 0); __builtin_amdgcn_s_setprio(0); } while (0)
#define PG8_WAIT_V(n) asm volatile("s_waitcnt vmcnt(" #n ")" ::: "memory")
#define PG8_WAIT_L(n) asm volatile("s_waitcnt lgkmcnt(" #n ")" ::: "memory")
#define PG8_BAR __builtin_amdgcn_s_barrier()
#define PG8_SCHED __builtin_amdgcn_sched_barrier(0)
    Unit cur, nxt; int ui = 0;
    if (!S.next(0, cur)) return;
    f32x4 acc[2][2][4][2];
#pragma unroll
    for (int a = 0; a < 2; ++a)
#pragma unroll
        for (int b = 0; b < 2; ++b)
#pragma unroll
            for (int m = 0; m < 4; ++m)
#pragma unroll
                for (int n = 0; n < 2; ++n) acc[a][b][m][n] = (f32x4){0.f, 0.f, 0.f, 0.f};
    bf16x8 At[4][2], B0[2][2], B1[2][2];
    const char* cA = (const char*)g.A + (size_t)cur.pm * tstepA; const char* cB = (const char*)g.Bt + (size_t)cur.pn * tstepB;
    PG8_STAGE(PG8_SB(0, 0), cB, voffB); PG8_STAGE(PG8_SB(0, 1), cB + hstepB, voffB); PG8_STAGE(PG8_SA(0, 0), cA, voffA); PG8_STAGE(PG8_SA(0, 1), cA + hstepA, voffA);
    if (wr == 1) PG8_BAR;
    PG8_WAIT_V(2); PG8_BAR;
    PG8_STAGE(PG8_SB(1, 0), cB + kstep, voffB); PG8_STAGE(PG8_SA(1, 0), cA + kstep, voffA); PG8_STAGE(PG8_SB(1, 1), cB + hstepB + kstep, voffB);
    PG8_WAIT_V(6); PG8_BAR;
    for (;;) {
        const bool has_next = S.next(ui + 1, nxt);
        const char* nA = has_next ? (const char*)g.A + (size_t)nxt.pm * tstepA : cA; const char* nB = has_next ? (const char*)g.Bt + (size_t)nxt.pn * tstepB : cB;
        for (int t = 0; t < nt; t += 2) {
            const bool last = (t == nt - 2);
            const char* a1 = cA + (size_t)(t + 1) * kstep;
            const char* a2 = last ? nA : cA + (size_t)(t + 2) * kstep; const char* b2 = last ? nB : cB + (size_t)(t + 2) * kstep;
            const char* a3 = a2 + kstep; const char* b3 = b2 + kstep;
            PG8_LDB(B0, 0, 0); PG8_LDB(B1, 0, 1); PG8_SCHED; PG8_LDA(At, 0, 0); PG8_STAGE(PG8_SA(1, 1), a1 + hstepA, voffA);
            PG8_WAIT_V(8); PG8_WAIT_L(0); PG8_BAR; PG8_MMA(0, 0, At, B0); PG8_MMA(0, 1, At, B1); PG8_BAR; PG8_SCHED;
            PG8_LDA(At, 0, 1); PG8_STAGE(PG8_SB(0, 0), b2, voffB); PG8_STAGE(PG8_SB(0, 1), b2 + hstepB, voffB); PG8_STAGE(PG8_SA(0, 0), a2, voffA);
            PG8_WAIT_V(8); PG8_WAIT_L(0); PG8_BAR; PG8_MMA(1, 0, At, B0); PG8_MMA(1, 1, At, B1); PG8_BAR; PG8_SCHED;
            PG8_LDB(B0, 1, 0); PG8_LDB(B1, 1, 1); PG8_SCHED; PG8_LDA(At, 1, 0); PG8_STAGE(PG8_SA(0, 1), a2 + hstepA, voffA);
            PG8_WAIT_V(8); PG8_WAIT_L(0); PG8_BAR; PG8_MMA(0, 0, At, B0); PG8_MMA(0, 1, At, B1); PG8_BAR; PG8_SCHED;
            PG8_LDA(At, 1, 1); PG8_STAGE(PG8_SB(1, 0), b3, voffB); PG8_STAGE(PG8_SB(1, 1), b3 + hstepB, voffB); PG8_STAGE(PG8_SA(1, 0), a3, voffA);
            PG8_WAIT_V(8); PG8_WAIT_L(0); PG8_BAR; PG8_MMA(1, 0, At, B0); PG8_MMA(1, 1, At, B1); PG8_BAR; PG8_SCHED;
        }
        if (wr == 0) PG8_BAR;
        if constexpr (!Epi::AFTER_DRAIN) { E(acc, cur, wr, wc, fr, fq); }
        if (!has_next) break;
#pragma unroll
        for (int a = 0; a < 2; ++a)
#pragma unroll
            for (int b = 0; b < 2; ++b)
#pragma unroll
                for (int m = 0; m < 4; ++m)
#pragma unroll
                    for (int n = 0; n < 2; ++n) acc[a][b][m][n] = (f32x4){0.f, 0.f, 0.f, 0.f};
        cur = nxt; cA = nA; cB = nB; ++ui;
        if (wr == 1) PG8_BAR;
    }
    PG8_WAIT_V(0);
    PG8_BAR;
    if constexpr (Epi::AFTER_DRAIN) { E.fused(acc, cur, wr, wc, fr, fq, lds, wid, lane); }
#undef PG8_SA
#undef PG8_SB
#undef PG8_STAGE
#undef PG8_LDA
#undef PG8_LDB
#undef PG8_MMA
#undef PG8_WAIT_V
#undef PG8_WAIT_L
#undef PG8_BAR
#undef PG8_SCHED
}

struct EpiProj {
    static constexpr bool PERM = true, AFTER_DRAIN = false;
    bf16_t* O; const float* ssq;
    __device__ __forceinline__ void operator()(const f32x4 (&acc)[2][2][4][2], const Unit& u, int wr, int wc, int fr, int fq) const {
        const int row0 = u.pm * BM + wr * 64 + fr, col0 = u.pn * BM + wc * 32 + 8 * fq;
#pragma unroll
        for (int ai = 0; ai < 2; ++ai)
#pragma unroll
            for (int m = 0; m < 4; ++m) { const int row = row0 + ai * HALF + m * 16; const f32x4 q = *(const f32x4*)(ssq + (size_t)row * 4);
                const float rs = rsqrtf(((q[0] + q[1]) + (q[2] + q[3])) * (1.f / D_MODEL) + RMS_EPS); bf16_t* rowp = O + (size_t)row * PROJ_LD + col0;
#pragma unroll
                for (int bj = 0; bj < 2; ++bj) { if (col0 + bj * HALF < IN_COLS) { const f32x4 v0 = acc[ai][bj][m][0] * rs, v1 = acc[ai][bj][m][1] * rs;
                    u32x4 w; w.x = cvtpk(v0[0], v0[1]); w.y = cvtpk(v0[2], v0[3]); w.z = cvtpk(v1[0], v1[1]); w.w = cvtpk(v1[2], v1[3]); *(u32x4*)(rowp + bj * HALF) = w; } } }
    }
};
struct EpiRes {
    static constexpr bool PERM = false, AFTER_DRAIN = true;
    const float* xin; float* xf; bf16_t* xb; float* ssq;
    __device__ __forceinline__ void fused(f32x4 (&acc)[2][2][4][2], const Unit& u, int wr, int wc, int fr, int fq, LAS unsigned char* lds, int wid, int lane) const {
        LAS float* P = (LAS float*)lds;
        const int col0 = u.pn * BM + wc * 32 + 4 * fq;
#pragma unroll
        for (int ai = 0; ai < 2; ++ai)
#pragma unroll
            for (int m = 0; m < 4; ++m) { const int rl = ai * HALF + wr * 64 + m * 16 + fr; const size_t off = (size_t)(u.pm * BM + rl) * D_MODEL + col0; float s = 0.f;
#pragma unroll
                for (int bj = 0; bj < 2; ++bj)
#pragma unroll
                    for (int n = 0; n < 2; ++n) { const size_t o2 = off + bj * HALF + n * 16; const f32x4 o = *(const f32x4*)(xin + o2) + acc[ai][bj][m][n]; *(f32x4*)(xf + o2) = o;
                        u32x2 w; w.x = cvtpk(o[0], o[1]); w.y = cvtpk(o[2], o[3]); *(u32x2*)(xb + o2) = w; s += (o[0] * o[0] + o[1] * o[1]) + (o[2] * o[2] + o[3] * o[3]); }
                s += __shfl_xor(s, 16); s += __shfl_xor(s, 32);
                if (fq == 0) P[rl * 4 + wc] = s; }
        LDS_WAIT(); __builtin_amdgcn_s_barrier(); asm volatile("" ::: "memory");
        const int t = wid * 64 + lane;
        if (t < 256) { const f32x4 p = *(const LAS f32x4*)(P + t * 4); ssq[(size_t)(u.pm * BM + t) * 4 + u.pn] = (p[0] + p[1]) + (p[2] + p[3]); }
        LDS_WAIT(); __builtin_amdgcn_s_barrier();
    }
};
struct EpiQ {
    static constexpr bool PERM = false, AFTER_DRAIN = false;
    bf16_t* Q; const LAS float* RS; const float* cs; const float* sn; float qscale;
    __device__ __forceinline__ void operator()(const f32x4 (&acc)[2][2][4][2], const Unit& u, int wr, int wc, int fr, int fq) const {
#pragma unroll
        for (int ai = 0; ai < 2; ++ai)
#pragma unroll
            for (int m = 0; m < 4; ++m) { const int rl = ai * HALF + wr * 64 + m * 16 + fr, row = u.pm * BM + rl, pos = row & (SEQ - 1); const float rs = RS[rl * 2] * qscale;
                const f32x4 c4 = *(const f32x4*)(cs + pos * 16 + 4 * fq), s4 = *(const f32x4*)(sn + pos * 16 + 4 * fq);
#pragma unroll
                for (int bj = 0; bj < 2; ++bj) { const int cb = u.pn * BM + bj * HALF + wc * 32; if (cb < 384) {
                    f32x4 v0 = acc[ai][bj][m][0], v1 = acc[ai][bj][m][1];
                    if (((cb >> 5) % 3) == 2) { const f32x4 a = v0 * c4 - v1 * s4, b = v0 * s4 + v1 * c4; v0 = a; v1 = b; }
                    v0 = v0 * rs; v1 = v1 * rs; bf16_t* p = Q + (size_t)row * Q_LD + cb + 4 * fq;
                    u32x2 w0, w1; w0.x = cvtpk(v0[0], v0[1]); w0.y = cvtpk(v0[2], v0[3]); w1.x = cvtpk(v1[0], v1[1]); w1.y = cvtpk(v1[2], v1[3]);
                    *(u32x2*)p = w0; *(u32x2*)(p + 16) = w1; } }
                asm volatile("" ::: "memory"); }
    }
};
struct EpiKV {
    static constexpr bool PERM = true, AFTER_DRAIN = false;
    bf16_t* Kb; bf16_t* Vb; const LAS float* RS;
    __device__ __forceinline__ void operator()(const f32x4 (&acc)[2][2][4][2], const Unit& u, int wr, int wc, int fr, int fq) const {
#pragma unroll
        for (int ai = 0; ai < 2; ++ai)
#pragma unroll
            for (int m = 0; m < 4; ++m) { const int rl = ai * HALF + wr * 64 + m * 16 + fr, row = u.pm * BM + rl; const float rs = RS[rl * 2 + 1];
#pragma unroll
                for (int bj = 0; bj < 2; ++bj) { const int c = bj * HALF + wc * 32 + 8 * fq; const f32x4 v0 = acc[ai][bj][m][0] * rs, v1 = acc[ai][bj][m][1] * rs;
                    u32x4 w; w.x = cvtpk(v0[0], v0[1]); w.y = cvtpk(v0[2], v0[3]); w.z = cvtpk(v1[0], v1[1]); w.w = cvtpk(v1[2], v1[3]);
                    bf16_t* p = (u.pn == 0) ? Kb + (size_t)row * K_LD + 96 * (c >> 6) + (c & 63) : Vb + (size_t)row * V_LD + c;
                    *(u32x4*)p = w; } }
    }
};
}

#define XB_TMO      128
#define XB_XCNT(j)  (256  + 64 * (j))
#define XB_XSUB(j)  (1280 + 64 * (j))
#define XB_XGEN(j)  (2304 + 64 * (j))
#define XB_TOP      3328
#define XB_TOPGEN   3392
#define XCD_BAR_WORDS 3456
#define XB_SPIN_CAP (1u << 20)
__device__ __forceinline__ unsigned xb_ld(unsigned* p)              { return __hip_atomic_load(p, __ATOMIC_RELAXED, __HIP_MEMORY_SCOPE_AGENT); }
__device__ __forceinline__ unsigned xb_add(unsigned* p, unsigned v) { return __hip_atomic_fetch_add(p, v, __ATOMIC_RELAXED, __HIP_MEMORY_SCOPE_AGENT); }
__device__ __forceinline__ unsigned xb_xcc_id() { return (unsigned)__builtin_amdgcn_s_getreg((3 << 11) | 20) & 0xFu; }
#define XB_SPIN(cond, bar) do { unsigned _sp = 0; while (cond) { __builtin_amdgcn_s_sleep(1); \
    if ((++_sp & 255u) == 0u) { if (xb_ld(&(bar)[XB_TMO])) break; if (_sp > XB_SPIN_CAP) { atomicAdd(&(bar)[XB_TMO], 1u); break; } } } } while (0)
struct XcdBarrier { unsigned* bar; unsigned x; volatile LAS unsigned* st; };
__device__ __forceinline__ XcdBarrier xcd_barrier_post(unsigned* bar, volatile LAS unsigned* st) {
    XcdBarrier b; b.bar = bar; b.x = xb_xcc_id(); b.st = st;
    if (threadIdx.x == 0) (void)xb_add(&bar[XB_XCNT(b.x)], 1u);
    return b;
}
__device__ __forceinline__ void xcd_barrier_complete(unsigned* bar, unsigned x, unsigned& nloc, unsigned& nx) {
    const unsigned G = gridDim.x * gridDim.y * gridDim.z;
    unsigned sum, cnt, mine, sp = 0u;
    for (;;) {
        sum = 0u; cnt = 0u; mine = 0u;
#pragma unroll
        for (unsigned j = 0; j < 16; ++j) { const unsigned c = xb_ld(&bar[XB_XCNT(j)]); sum += c; cnt += (c > 0u) ? 1u : 0u; mine = (j == x) ? c : mine; }
        if (sum == G) break;
        __builtin_amdgcn_s_sleep(1);
        if ((++sp & 255u) == 0u) { if (xb_ld(&bar[XB_TMO])) break; if (sp > XB_SPIN_CAP) { atomicAdd(&bar[XB_TMO], 1u); break; } }
    }
    nloc = mine > 0u ? mine : 1u; nx = cnt > 0u ? cnt : 1u;
}
__device__ __forceinline__ void xcd_barrier(const XcdBarrier& b) {
    asm volatile("s_waitcnt vmcnt(0)" ::: "memory");
    __syncthreads();
    if (threadIdx.x == 0) {
        unsigned* bar = b.bar;
        __builtin_amdgcn_s_waitcnt(0);
        unsigned nloc = b.st[0], nx = b.st[1];
        if (nloc == 0u) { xcd_barrier_complete(bar, b.x, nloc, nx); b.st[0] = nloc; b.st[1] = nx; }
        const unsigned old = xb_add(&bar[XB_XSUB(b.x)], 1u);
        const unsigned gen = old / nloc;
        if (old + 1u == (gen + 1u) * nloc) {
            __builtin_amdgcn_fence(__ATOMIC_RELEASE, "agent");
            asm volatile("s_waitcnt vmcnt(0)" ::: "memory");
            const unsigned og = xb_add(&bar[XB_TOP], 1u);
            const unsigned tg = og / nx;
            if (og + 1u == (tg + 1u) * nx) xb_add(&bar[XB_TOPGEN], 1u);
            else XB_SPIN(xb_ld(&bar[XB_TOPGEN]) == tg, bar);
            __builtin_amdgcn_fence(__ATOMIC_ACQUIRE, "agent");
            xb_add(&bar[XB_XGEN(b.x)], 1u);
            asm volatile("s_waitcnt vmcnt(0)" ::: "memory");
        } else {
            XB_SPIN(xb_ld(&bar[XB_XGEN(b.x)]) == gen, bar);
            __builtin_amdgcn_fence(__ATOMIC_ACQUIRE, "agent");
            asm volatile("s_waitcnt vmcnt(0)" ::: "memory");
        }
    }
    __syncthreads();
}
constexpr int NWAVES = 8, NTHREADS = 512;
constexpr int CW_BAR = 4096, CW_Q = 131072;
constexpr size_t CTL_ZERO_BYTES = 1 * MiB;
constexpr int N_PHASES = 2 + 4 * DEPTH;
constexpr float QSCALE = 0.10206207261596577f * 1.4426950408889634f;

struct Args { const float* in[14]; float* out; unsigned char* ws; int ph_lo, ph_hi; int fastmask, pad; };
struct Frame { LAS unsigned char* lds; int tid, lane, wave, G, bx; unsigned char* ws; };
typedef const __attribute__((address_space(4))) Args* kargs_t;
__device__ __forceinline__ kargs_t kargs() { kargs_t p = (kargs_t)__builtin_amdgcn_kernarg_segment_ptr(); asm volatile("" : "+s"(p)); return p; }
#define IN_X(a) ((a)->in[0])
#define IN_NORMW(a) ((a)->in[1])
#define IN_WIN(a) ((a)->in[2])
#define IN_QNORM(a) ((a)->in[3])
#define IN_WUQ(a) ((a)->in[4])
#define IN_KVNORM(a) ((a)->in[5])
#define IN_WUKV(a) ((a)->in[6])
#define IN_CONVW(a) ((a)->in[7])
#define IN_ALOG(a) ((a)->in[8])
#define IN_DTB(a) ((a)->in[9])
#define IN_GNORM(a) ((a)->in[10])
#define IN_WOUT(a) ((a)->in[11])
#define IN_T5(a) ((a)->in[12])
#define IN_FNORM(a) ((a)->in[13])
#define W_TBL(ws) ((float*)((ws) + WS_TBL))
#define W_KM(ws) ((float*)((ws) + WS_KMEAN))
#define W_SSQ(ws) ((float*)((ws) + WS_SSQ))
#define W_COS(ws) ((float*)((ws) + WS_COS))
#define W_SIN(ws) ((float*)((ws) + WS_SIN))
#define W_WIN(ws) ((bf16_t*)((ws) + WS_WIN))
#define W_WOUT(ws) ((bf16_t*)((ws) + WS_WOUT))
#define W_WUQ(ws) ((bf16_t*)((ws) + WS_WUQ))
#define W_WUKV(ws) ((bf16_t*)((ws) + WS_WUKV))
#define W_Q(ws) ((bf16_t*)((ws) + WS_Q))
#define W_K(ws) ((bf16_t*)((ws) + WS_K))
#define W_V(ws) ((bf16_t*)((ws) + WS_V))
#define W_PROJ(ws) ((bf16_t*)((ws) + WS_PROJ))
#define W_XB(ws) ((bf16_t*)((ws) + WS_XB))
#define W_Y(ws) ((bf16_t*)((ws) + WS_PROJ) + C_GQ)
constexpr int LDY = PROJ_LD;

__device__ __forceinline__ Frame opaque(const Frame& F) { Frame G = F; asm volatile("" : "+v"(G.tid)); G.lane = G.tid & 63; return G; }
__device__ __forceinline__ void tr_item(const float* W, int K, int N, int NP, const float* sc, bf16_t* WT, int mode, LAS float* scr, int item, int lane) {
    const int nblk = NP / 32, kb = item / nblk, nb = item % nblk, k0 = 64 * kb, n0 = 32 * nb;
    int n = n0 + (lane & 31); const bool valid = n < N;
    if (mode == 1) { const int nn = n & 255, hd = nn >> 6, c = nn & 63; n = hd * 128 + c + ((n >= 256) ? 64 : 0); }
#pragma unroll 8
    for (int i = 0; i < 32; ++i) { const int kk = 2 * i + (lane >> 5); float v = 0.f; if (valid) { v = W[(size_t)(k0 + kk) * N + n]; if (sc) v *= sc[k0 + kk]; } scr[kk * 33 + (lane & 31)] = v; }
    LDS_WAIT(); asm volatile("" ::: "memory");
    const int c = lane & 7;
#pragma unroll
    for (int j = 0; j < 4; ++j) { const int nn = (lane >> 3) + 8 * j; const LAS float* s = scr + (8 * c) * 33 + nn;
        u32x4 o; o.x = cvtpk(s[0 * 33], s[1 * 33]); o.y = cvtpk(s[2 * 33], s[3 * 33]); o.z = cvtpk(s[4 * 33], s[5 * 33]); o.w = cvtpk(s[6 * 33], s[7 * 33]);
        *(u32x4*)(WT + (size_t)(n0 + nn) * K + k0 + 8 * c) = o; }
    LDS_WAIT(); asm volatile("" ::: "memory");
}
__device__ __forceinline__ void convert_weights(const Frame& F0, kargs_t A, int l, int which) {
    const Frame F = opaque(F0);
    LAS float* scr = (LAS float*)(F.lds + F.wave * 16384);
    const int gw = F.bx * NWAVES + F.wave, NGW = F.G * NWAVES;
    constexpr int I_IN = 16 * 120, I_UQ = 4 * 16, I_UKV = 2 * 16, I_OUT = 16 * 32;
    if (which & 1) for (int it = gw; it < I_IN + I_UQ + I_UKV; it += NGW) {
        int r = it;
        if (r < I_IN) { tr_item(IN_WIN(A) + (size_t)l * 1024 * IN_COLS, 1024, IN_COLS, 3840, IN_NORMW(A) + l * 1024, W_WIN(F.ws), 0, scr, r, F.lane); continue; } r -= I_IN;
        if (r < I_UQ) { tr_item(IN_WUQ(A) + (size_t)l * 256 * 384, 256, 384, 512, IN_QNORM(A) + l * 256, W_WUQ(F.ws), 0, scr, r, F.lane); continue; } r -= I_UQ;
        tr_item(IN_WUKV(A) + (size_t)l * 128 * 512, 128, 512, 512, IN_KVNORM(A) + l * 128, W_WUKV(F.ws), 1, scr, r, F.lane);
    }
    if (which & 2) for (int it = gw; it < I_OUT; it += NGW) tr_item(IN_WOUT(A) + (size_t)l * 1024 * 1024, 1024, 1024, 1024, nullptr, W_WOUT(F.ws), 0, scr, it, F.lane);
}
__device__ __forceinline__ float rope_inv(int j) {
    unsigned b = 0x3f800000u;
    b = (j == 1) ? 0x3f0ff59au : b;
    b = (j == 2) ? 0x3ea1e89bu : b;
    b = (j == 3) ? 0x3e361887u : b;
    b = (j == 4) ? 0x3dcccccdu : b;
    b = (j == 5) ? 0x3d6655c2u : b;
    b = (j == 6) ? 0x3d0186e3u : b;
    b = (j == 7) ? 0x3c91ad39u : b;
    b = (j == 8) ? 0x3c23d70au : b;
    b = (j == 9) ? 0x3bb8449cu : b;
    b = (j == 10) ? 0x3b4f3e38u : b;
    b = (j == 11) ? 0x3ae91528u : b;
    b = (j == 12) ? 0x3a83126fu : b;
    b = (j == 13) ? 0x3a136a16u : b;
    b = (j == 14) ? 0x39a5cb60u : b;
    b = (j == 15) ? 0x393a7753u : b;
    return __builtin_bit_cast(float, b);
}
__device__ __forceinline__ void p0_prologue(const Frame& F0, kargs_t A) {
    const Frame F = opaque(F0);
    const int gt = F.bx * NTHREADS + F.tid, NGT = F.G * NTHREADS;
    float* TBL = W_TBL(F.ws); float* COS = W_COS(F.ws); float* SIN = W_SIN(F.ws);
    for (int i = gt; i < SEQ * 16; i += NGT) {
        if (i < 4 * 2048) { const int h = i >> 11, rel = i & 2047; int b;
            if (rel < 16) b = rel; else { b = 16 + (int)(__logf((float)rel * 0.0625f) * (16.f / 4.852030263919617f)); if (b > 31) b = 31; }
            TBL[i] = IN_T5(A)[b * 4 + h]; }
        const int pos = i >> 4, j = i & 15;
        const float inv = rope_inv(j); const float ang = (float)pos * inv;
        const double a = (double)ang, k = __builtin_rint(a * 0.63661977236758134308), r = __builtin_fma(-k, 1.57079632679489661923, a), r2 = r * r;
        double sp = 2.7557319223985893e-06; sp = __builtin_fma(sp, r2, -1.9841269841269841e-04); sp = __builtin_fma(sp, r2, 8.3333333333333332e-03); sp = __builtin_fma(sp, r2, -1.6666666666666666e-01); sp = __builtin_fma(sp * r2, r, r);
        double cp = -2.7557319223985888e-07; cp = __builtin_fma(cp, r2, 2.4801587301587302e-05); cp = __builtin_fma(cp, r2, -1.3888888888888889e-03); cp = __builtin_fma(cp, r2, 4.1666666666666664e-02); cp = __builtin_fma(cp, r2, -0.5); cp = __builtin_fma(cp, r2, 1.0);
        const int q = (int)k & 3; const float sf = (float)sp, cf = (float)cp;
        COS[i] = (q == 0) ? cf : (q == 1) ? -sf : (q == 2) ? -cf : sf;
        SIN[i] = (q == 0) ? sf : (q == 1) ? cf : (q == 2) ? -sf : -cf;
    }
    convert_weights(F0, A, 0, 3);
    const int gw = F.bx * NWAVES + F.wave, NGW = F.G * NWAVES;
    bf16_t* XB = W_XB(F.ws); float* SSQ = W_SSQ(F.ws);
    for (int row = gw; row < M_TOK; row += NGW) {
        const f32x4* xr = (const f32x4*)(IN_X(A) + (size_t)row * D_MODEL) + F.lane; float s = 0.f;
#pragma unroll
        for (int j = 0; j < 4; ++j) { const f32x4 v = xr[64 * j]; s += (v[0] * v[0] + v[1] * v[1]) + (v[2] * v[2] + v[3] * v[3]);
            u32x2 w; w.x = cvtpk(v[0], v[1]); w.y = cvtpk(v[2], v[3]); *((u32x2*)(XB + (size_t)row * D_MODEL) + F.lane + 64 * j) = w; }
        s = wave_sum(s); if (F.lane == 0) *(f32x4*)(SSQ + (size_t)row * 4) = (f32x4){s, 0.f, 0.f, 0.f};
    }
}
__device__ __forceinline__ void pb_prepass(const Frame& F0, int pm, bool do_kpe) {
    const Frame F = opaque(F0);
    const bf16_t* PROJ = W_PROJ(F.ws); bf16_t* Kb = W_K(F.ws); const float* COS = W_COS(F.ws); const float* SIN = W_SIN(F.ws);
    LAS float* RS = (LAS float*)(F.lds + LDS_RS);
    for (int i = 0; i < 32; ++i) { const int rl = F.wave * 32 + i, row = pm * 256 + rl; const bf16_t* p = PROJ + (size_t)row * PROJ_LD;
        const u32x2 a = *(const u32x2*)(p + C_MCQ + 4 * F.lane); const unsigned b = *(const unsigned*)(p + C_MCKV + 2 * F.lane);
        const float a0 = bf2f((bf16_t)(a.x & 0xffff)), a1 = bf2f((bf16_t)(a.x >> 16)), a2 = bf2f((bf16_t)(a.y & 0xffff)), a3 = bf2f((bf16_t)(a.y >> 16)), b0 = bf2f((bf16_t)(b & 0xffff)), b1 = bf2f((bf16_t)(b >> 16));
        const float s1 = wave_sum((a0 * a0 + a1 * a1) + (a2 * a2 + a3 * a3)), s2 = wave_sum(b0 * b0 + b1 * b1);
        if (F.lane == 0) { RS[rl * 2] = rsqrtf(s1 * (1.f / 256.f) + RMS_EPS); RS[rl * 2 + 1] = rsqrtf(s2 * (1.f / 128.f) + RMS_EPS); }
        if (do_kpe && F.lane < 16) { const int pos = row & (SEQ - 1); const float c = COS[pos * 16 + F.lane], sg = SIN[pos * 16 + F.lane];
            const float x1 = bf2f(p[C_MKR + F.lane]), x2 = bf2f(p[C_MKR + 16 + F.lane]); const bf16_t r1 = (bf16_t)f2bf(x1 * c - x2 * sg), r2 = (bf16_t)f2bf(x1 * sg + x2 * c);
#pragma unroll
            for (int h = 0; h < 4; ++h) { Kb[(size_t)row * K_LD + 96 * h + 64 + F.lane] = r1; Kb[(size_t)row * K_LD + 96 * h + 80 + F.lane] = r2; } }
    }
}
__device__ __forceinline__ void final_norm(const Frame& F0, float* out, const float* fnorm) {
    const Frame F = opaque(F0);
    const int gw = F.bx * NWAVES + F.wave, NGW = F.G * NWAVES;
    for (int row = gw; row < M_TOK; row += NGW) { f32x4* xr = (f32x4*)(out + (size_t)row * D_MODEL) + F.lane; f32x4 v[4]; float s = 0.f;
#pragma unroll
        for (int j = 0; j < 4; ++j) { v[j] = xr[64 * j]; s += (v[j][0] * v[j][0] + v[j][1] * v[j][1]) + (v[j][2] * v[j][2] + v[j][3] * v[j][3]); }
        const float rs = rsqrtf(wave_sum(s) * (1.f / D_MODEL) + RMS_EPS);
#pragma unroll
        for (int j = 0; j < 4; ++j) { const f32x4 w = *((const f32x4*)fnorm + F.lane + 64 * j); xr[64 * j] = v[j] * rs * w; }
    }
}

namespace att {
typedef short v4i16_t __attribute__((ext_vector_type(4)));
constexpr int A_K = 0, A_KSLOT = 12288, A_V = 24576, A_VSLOT = 8192, A_WS = 40960, A_OST = 43008, A_OSTW = 8704  , A_KM = 112640, A_TB = 120832;
static_assert(A_OST + 8 * A_OSTW <= A_KM && A_TB + 8192 <= RING_BYTES, "attention LDS map");
__device__ __forceinline__ int crow(int r, int hi) { return (r & 3) + 8 * (r >> 2) + 4 * hi; }
__device__ __forceinline__ float other_half(float v) { return __shfl_xor(v, 32); }
__device__ __forceinline__ int other_half_i(int v) { return __shfl_xor(v, 32); }

template <int MODE>
__device__ __forceinline__ void attn_unit(const Frame& F0, int b, int h, int qb) {
    constexpr int DQ = MODE == 0 ? 96 : 64, ND0 = DQ / 16, NCH = DQ / 8;
    Frame F = F0; asm volatile("" : "+v"(F.tid)); F.lane = F.tid & 63;
    const int lane = F.lane, wid = F.wave, r32 = lane & 31, hi = lane >> 5;
    unsigned char* ws = F.ws; LAS unsigned char* lds = F.lds;
    const bf16_t* PROJ = W_PROJ(ws);
    const int ldq = MODE == 0 ? Q_LD : PROJ_LD, ldk = MODE == 0 ? K_LD : PROJ_LD, ldv = MODE == 0 ? V_LD : PROJ_LD;
    const size_t rowbase = (size_t)b * SEQ; const int q0 = qb * 256;
    const bf16_t* Qh = (MODE == 0 ? W_Q(ws) + 96 * h : PROJ + C_CQ + 64 * h) + rowbase * ldq;
    const bf16_t* Kh = (MODE == 0 ? W_K(ws) + 96 * h : PROJ + C_CK + 64 * h) + rowbase * ldk;
    const bf16_t* Vh = (MODE == 0 ? W_V(ws) + 64 * h : PROJ + C_CV + 64 * h) + rowbase * ldv;
    const int qpos = q0 + wid * 32 + r32;
    LAS float* wsf = (LAS float*)(lds + A_WS) + wid * 64;
    bf16x8 qr[ND0];
#pragma unroll
    for (int d0 = 0; d0 < ND0; ++d0) qr[d0] = *(const bf16x8*)(Qh + (size_t)qpos * ldq + d0 * 16 + hi * 8);
    unsigned selmask = 0xffffffffu, umask = 0u; const int own = qb;
    if (MODE == 1) {
        LAS float* kml = (LAS float*)(lds + A_KM); LAS float* tbl = (LAS float*)(lds + A_TB); LAS unsigned* um = (LAS unsigned*)(lds + LDS_MISC + 64);
        const float* km = W_KM(ws) + (size_t)(b * 4 + h) * 32 * 64; const float* tb = W_TBL(ws) + h * 2048;
        { const f32x4 a = *(const f32x4*)(km + F.tid * 4); *(LAS f32x4*)(kml + F.tid * 4) = a; const f32x4 t4 = *(const f32x4*)(tb + F.tid * 4) * 1.4426950408889634f; *(LAS f32x4*)(tbl + F.tid * 4) = t4; }
        if (F.tid == 0) *um = 0u;
        float qf[64];
#pragma unroll
        for (int c = 0; c < 8; ++c) { const bf16x8 v = *(const bf16x8*)(Qh + (size_t)qpos * ldq + c * 8);
#pragma unroll
            for (int j = 0; j < 8; ++j) qf[c * 8 + j] = bf2f((bf16_t)v[j]); }
        LDS_WAIT(); __syncthreads();
        float g0 = -INFINITY, g1 = -INFINITY, g2 = -INFINITY; int s0 = 64, s1 = 64, s2 = 64;
        for (int n = hi; n < own; n += 2) { const LAS f32x4* kp = (const LAS f32x4*)(kml + n * 64); float g = 0.f;
#pragma unroll
            for (int c = 0; c < 16; ++c) { const f32x4 k4 = kp[c]; g += qf[4 * c] * k4[0]; g += qf[4 * c + 1] * k4[1]; g += qf[4 * c + 2] * k4[2]; g += qf[4 * c + 3] * k4[3]; }
            if (g > g0) { g2 = g1; s2 = s1; g1 = g0; s1 = s0; g0 = g; s0 = n; } else if (g > g1) { g2 = g1; s2 = s1; g1 = g; s1 = n; } else if (g > g2) { g2 = g; s2 = n; } }
        const float h0 = other_half(g0), h1 = other_half(g1), h2 = other_half(g2); const int t0 = other_half_i(s0), t1 = other_half_i(s1), t2 = other_half_i(s2);
#define ATT_INS(gg, ss) do { const float g_ = (gg); const int s_ = (ss); \
            if (g_ > g0 || (g_ == g0 && s_ < s0)) { g2 = g1; s2 = s1; g1 = g0; s1 = s0; g0 = g_; s0 = s_; } \
            else if (g_ > g1 || (g_ == g1 && s_ < s1)) { g2 = g1; s2 = s1; g1 = g_; s1 = s_; } \
            else if (g_ > g2 || (g_ == g2 && s_ < s2)) { g2 = g_; s2 = s_; } } while (0)
        ATT_INS(h0, t0); ATT_INS(h1, t1); ATT_INS(h2, t2);
#undef ATT_INS
        selmask = 1u << own; if (s0 < 32) selmask |= 1u << s0; if (s1 < 32) selmask |= 1u << s1; if (s2 < 32) selmask |= 1u << s2;
        (void)__hip_atomic_fetch_or(um, selmask, __ATOMIC_RELAXED, __HIP_MEMORY_SCOPE_WORKGROUP);
        LDS_WAIT(); __syncthreads();
        umask = __builtin_amdgcn_readfirstlane(*um);
    }
    const int NT = MODE == 0 ? 4 * (qb + 1) : 4 * __builtin_popcount(umask);
    auto dma = [&](int key0, int s) {
        const bf16_t* ks = Kh + (size_t)(key0 + lane) * ldk + wid * 8;
        __builtin_amdgcn_global_load_lds((const unsigned*)ks, (LAS unsigned*)(lds + A_K + s * A_KSLOT + wid * 1024), 16, 0, 0);
        if (NCH > 8 && wid < NCH - 8) __builtin_amdgcn_global_load_lds((const unsigned*)(ks + 64), (LAS unsigned*)(lds + A_K + s * A_KSLOT + (8 + wid) * 1024), 16, 0, 0);
        const bf16_t* vs = Vh + (size_t)(key0 + 16 * (wid & 3) + (lane >> 2)) * ldv + (wid >> 2) * 32 + (lane & 3) * 8;
        __builtin_amdgcn_global_load_lds((const unsigned*)vs, (LAS unsigned*)(lds + A_V + s * A_VSLOT + wid * 1024), 16, 0, 0);
    };
    unsigned rem = umask; int blk = 0, sub = 0;
    auto next_key0 = [&](int t) -> int { if (MODE == 0) return 64 * t; if (sub == 0) { blk = __builtin_ctz(rem); rem &= rem - 1; } const int k0 = blk * 256 + sub * 64; sub = (sub + 1) & 3; return k0; };
    int key_cur = next_key0(0);
    dma(key_cur, 0);
    float m = -1e20f, l = 0.f; f32x16 o[2]; o[0] = f32x16{}; o[1] = f32x16{};
    VM_WAIT(); __syncthreads();
    for (int t = 0; t < NT; ++t) {
        const int s = t & 1; int key_nxt = 0;
        if (t + 1 < NT) { key_nxt = next_key0(t + 1); dma(key_nxt, s ^ 1); }
        const int key0 = key_cur; key_cur = key_nxt;
        bool act = true;
        if (MODE == 0) act = key0 <= q0 + wid * 32 + 31;
        else { const int n = key0 >> 8; act = __builtin_amdgcn_readfirstlane(__any((selmask >> n) & 1u)) != 0; if (n == own) act = act && (key0 <= q0 + wid * 32 + 31); }
        if (act) {
            f32x16 p0 = f32x16{}, p1 = f32x16{};
            const LAS unsigned char* kb = lds + A_K + s * A_KSLOT + hi * 1024 + r32 * 16;
#pragma unroll
            for (int d0 = 0; d0 < ND0; ++d0) { const bf16x8 k0 = *(const LAS bf16x8*)(kb + d0 * 2048), k1 = *(const LAS bf16x8*)(kb + d0 * 2048 + 512);
                p0 = __builtin_amdgcn_mfma_f32_32x32x16_bf16(k0, qr[d0], p0, 0, 0, 0); p1 = __builtin_amdgcn_mfma_f32_32x32x16_bf16(k1, qr[d0], p1, 0, 0, 0); }
            if (MODE == 0) {
                if (key0 + 63 > q0 + wid * 32) {
#pragma unroll
                    for (int r = 0; r < 16; ++r) { const int kv = key0 + crow(r, hi); if (kv > qpos) p0[r] = -1e30f; if (kv + 32 > qpos) p1[r] = -1e30f; }
                }
            } else {
                const LAS float* tbl = (const LAS float*)(lds + A_TB); const int n = key0 >> 8; const bool mine = (selmask >> n) & 1u; const float SC = 0.125f * 1.4426950408889634f;
                const int relb = qpos - key0 - 4 * hi;
                if (q0 + wid * 32 - key0 - 63 >= 2047) {
                    const float bz = tbl[2047];
#pragma unroll
                    for (int r = 0; r < 16; ++r) { p0[r] = mine ? __builtin_fmaf(p0[r], SC, bz) : -1e30f; p1[r] = mine ? __builtin_fmaf(p1[r], SC, bz) : -1e30f; }
                } else {
#pragma unroll
                    for (int r = 0; r < 16; ++r) { const int rel0 = relb - ((r & 3) + 8 * (r >> 2)), rel1 = rel0 - 32;
                        const float b0 = tbl[rel0 < 0 ? 0 : (rel0 > 2047 ? 2047 : rel0)], b1 = tbl[rel1 < 0 ? 0 : (rel1 > 2047 ? 2047 : rel1)];
                        p0[r] = (mine && rel0 >= 0) ? __builtin_fmaf(p0[r], SC, b0) : -1e30f; p1[r] = (mine && rel1 >= 0) ? __builtin_fmaf(p1[r], SC, b1) : -1e30f; }
                }
            }
            float rm = p0[0];
#pragma unroll
            for (int r = 1; r < 16; ++r) rm = fmaxf(rm, p0[r]);
#pragma unroll
            for (int r = 0; r < 16; ++r) rm = fmaxf(rm, p1[r]);
            rm = fmaxf(rm, other_half(rm));
            const float mn = fmaxf(m, rm), alpha = __builtin_amdgcn_exp2f(m - mn); m = mn;
            float rs = 0.f;
#pragma unroll
            for (int r = 0; r < 16; ++r) { p0[r] = __builtin_amdgcn_exp2f(p0[r] - mn); p1[r] = __builtin_amdgcn_exp2f(p1[r] - mn); rs += p0[r] + p1[r]; }
            l = l * alpha + rs;
            if (__any(alpha != 1.0f)) {
                if (hi == 0) wsf[r32] = alpha;
                LDS_WAIT(); asm volatile("" ::: "memory");
#pragma unroll
                for (int g = 0; g < 4; ++g) { const f32x4 a4 = *(const LAS f32x4*)(wsf + 8 * g + 4 * hi);
#pragma unroll
                    for (int j = 0; j < 4; ++j) { o[0][4 * g + j] *= a4[j]; o[1][4 * g + j] *= a4[j]; } }
            }
            u32x4 pw[4];
#pragma unroll
            for (int j = 0; j < 4; ++j) { pw[0][j] = cvtpk(p0[2 * j], p0[2 * j + 1]); pw[1][j] = cvtpk(p0[8 + 2 * j], p0[9 + 2 * j]); pw[2][j] = cvtpk(p1[2 * j], p1[2 * j + 1]); pw[3][j] = cvtpk(p1[8 + 2 * j], p1[9 + 2 * j]); }
            const LAS unsigned char* vp = lds + A_V + s * A_VSLOT + ((lane >> 4) & 1) * 32 + (lane & 3) * 8 + (4 * hi + ((lane & 15) >> 2)) * 64;
#pragma unroll
            for (int d0 = 0; d0 < 2; ++d0)
#pragma unroll
                for (int ks = 0; ks < 4; ++ks) {
                    const v4i16_t lo = __builtin_amdgcn_ds_read_tr16_b64_v4i16((LAS v4i16_t*)(vp + d0 * 4096 + ks * 1024)), hv = __builtin_amdgcn_ds_read_tr16_b64_v4i16((LAS v4i16_t*)(vp + d0 * 4096 + ks * 1024 + 512));
                    const bf16x8 vf = (bf16x8){lo[0], lo[1], lo[2], lo[3], hv[0], hv[1], hv[2], hv[3]};
                    o[d0] = __builtin_amdgcn_mfma_f32_32x32x16_bf16(__builtin_bit_cast(bf16x8, pw[ks]), vf, o[d0], 0, 0, 0);
                }
        }
        LDS_WAIT(); VM_WAIT(); __syncthreads();
    }
    l += other_half(l);
    if (hi == 0) wsf[r32] = 1.0f / l;
    LDS_WAIT(); asm volatile("" ::: "memory");
    LAS float* stg = (LAS float*)(lds + A_OST + wid * A_OSTW);
#pragma unroll
    for (int g = 0; g < 4; ++g) { const f32x4 a4 = *(const LAS f32x4*)(wsf + 8 * g + 4 * hi);
#pragma unroll
        for (int j = 0; j < 4; ++j) { const int r = 4 * g + j, orow = crow(r, hi); stg[orow * 68 + r32] = o[0][r] * a4[j]; stg[orow * 68 + 32 + r32] = o[1][r] * a4[j]; } }
    LDS_WAIT(); asm volatile("" ::: "memory");
    bf16_t* Y = W_Y(ws); const int ycol = (MODE == 0 ? 0 : 768) + 64 * h, gcol = (MODE == 0 ? C_MGATE : C_CGATE) + 64 * h;
#pragma unroll
    for (int i = 0; i < 4; ++i) { const int row = i * 8 + (lane >> 3), c8 = (lane & 7) * 8; const size_t grow = rowbase + q0 + wid * 32 + row;
        const f32x4 a = *(const LAS f32x4*)(stg + row * 68 + c8), c = *(const LAS f32x4*)(stg + row * 68 + c8 + 4);
        const bf16x8 gt = *(const bf16x8*)(PROJ + grow * PROJ_LD + gcol + c8);
        u32x4 w; w.x = cvtpk(a[0] * siluf(bf2f((bf16_t)gt[0])), a[1] * siluf(bf2f((bf16_t)gt[1]))); w.y = cvtpk(a[2] * siluf(bf2f((bf16_t)gt[2])), a[3] * siluf(bf2f((bf16_t)gt[3])));
        w.z = cvtpk(c[0] * siluf(bf2f((bf16_t)gt[4])), c[1] * siluf(bf2f((bf16_t)gt[5]))); w.w = cvtpk(c[2] * siluf(bf2f((bf16_t)gt[6])), c[3] * siluf(bf2f((bf16_t)gt[7])));
        *(u32x4*)(Y + grow * LDY + ycol + c8) = w; }
    LDS_WAIT(); __syncthreads();
}
}
namespace gdn {
constexpr int CH_BYTES = 73728, O_WN = 0, O_QG = 16384, O_KE = 32768, O_AQK = 49152, O_U0 = 57344;
constexpr int P_Q = 0, P_K = 17408, P_V = 34816, P_L = 52224, P_AQ = 69632, P_W = 78848, P_U0 = 96256, P_SC = 112640;
constexpr int QKV_LD = 136;
__device__ __forceinline__ int crow(int r, int hi) { return (r & 3) + 8 * (r >> 2) + 4 * hi; }

__device__ __forceinline__ void prep_chunk(const Frame& F0, int l, int b, int h, int n) {
    Frame F = F0; asm volatile("" : "+v"(F.tid)); F.lane = F.tid & 63;
    const int lane = F.lane, wid = F.wave, tid = F.tid, r32 = lane & 31, hi = lane >> 5;
    LAS unsigned char* lds = F.lds; unsigned char* ws = F.ws;
    const bf16_t* PROJ = W_PROJ(ws);
    const int t0 = n * 64; const size_t rowb = (size_t)b * SEQ;
    unsigned char* G = ws + WS_GDN + (size_t)((b * 4 + h) * 128 + n) * CH_BYTES;
    LAS float* SC = (LAS float*)(lds + P_SC);
    kargs_t ka = kargs();
    {
        const float* cw = IN_CONVW(ka) + (size_t)l * 4 * 1536 + h * 128 + 2 * lane;
        float w[3][4][2];
#pragma unroll
        for (int a = 0; a < 3; ++a)
#pragma unroll
            for (int j = 0; j < 4; ++j) { const f32x2 v = *(const f32x2*)(cw + j * 1536 + a * 512); w[a][j][0] = v[0]; w[a][j][1] = v[1]; }
        unsigned x[3][11];
#pragma unroll
        for (int rr = 0; rr < 11; ++rr) { const int t = t0 + 8 * wid - 3 + rr; const bf16_t* p = PROJ + (rowb + (t < 0 ? 0 : t)) * PROJ_LD + h * 128 + 2 * lane;
#pragma unroll
            for (int a = 0; a < 3; ++a) { const unsigned v = *(const unsigned*)(p + (a == 0 ? C_GQ : a == 1 ? C_GK : C_GV)); x[a][rr] = (t < 0) ? 0u : v; } }
#pragma unroll
        for (int i = 0; i < 8; ++i) { float r0[3], r1[3];
#pragma unroll
            for (int a = 0; a < 3; ++a) { float s0 = 0.f, s1 = 0.f;
#pragma unroll
                for (int j = 0; j < 4; ++j) { const unsigned v = x[a][i + j]; s0 += w[a][j][0] * bf2f((bf16_t)(v & 0xffff)); s1 += w[a][j][1] * bf2f((bf16_t)(v >> 16)); }
                r0[a] = siluf(s0); r1[a] = siluf(s1); }
            const float nq = rsqrtf(wave_sum(r0[0] * r0[0] + r1[0] * r1[0]) + 1e-6f) * 0.08838834764831845f, nk = rsqrtf(wave_sum(r0[1] * r0[1] + r1[1] * r1[1]) + 1e-6f);
            const int row = 8 * wid + i;
            *(LAS unsigned*)(lds + P_Q + row * 272 + 4 * lane) = cvtpk(r0[0] * nq, r1[0] * nq);
            *(LAS unsigned*)(lds + P_K + row * 272 + 4 * lane) = cvtpk(r0[1] * nk, r1[1] * nk);
            *(LAS unsigned*)(lds + P_V + row * 272 + 4 * lane) = cvtpk(r0[2], r1[2]); }
    }
    if (wid == 0) {
        const bf16_t* p = PROJ + (rowb + t0 + lane) * PROJ_LD;
        const float bb = bf2f(p[C_GB + h]), aa = bf2f(p[C_GA + h]) + IN_DTB(ka)[l * 4 + h];
        const float beta = 1.f / (1.f + __expf(-bb)), sp = (aa > 20.f) ? aa : __logf(1.f + __expf(aa));
        float g = -__expf(IN_ALOG(ka)[l * 4 + h]) * sp;
#pragma unroll
        for (int o = 1; o < 64; o <<= 1) { const float v = __shfl_up(g, o); if (lane >= o) g += v; }
        const float gl = __shfl(g, 63);
        SC[lane] = g; SC[64 + lane] = beta; SC[128 + lane] = __expf(g); SC[192 + lane] = __expf(gl - g);
        if (lane == 63) ((float*)(ws + WS_GEND))[(b * 4 + h) * 128 + n] = __expf(gl);
    }
    LDS_WAIT(); __syncthreads();
    {
        const int which = wid >> 2, ti = (wid >> 1) & 1, tj = wid & 1;
        f32x16 acc = f32x16{};
        if (ti >= tj) {
            const LAS unsigned char* ap = lds + (which ? P_Q : P_K) + (32 * ti + r32) * 272 + hi * 16; const LAS unsigned char* bp = lds + P_K + (32 * tj + r32) * 272 + hi * 16;
#pragma unroll
            for (int ks = 0; ks < 8; ++ks) acc = __builtin_amdgcn_mfma_f32_32x32x16_bf16(*(const LAS bf16x8*)(ap + ks * 32), *(const LAS bf16x8*)(bp + ks * 32), acc, 0, 0, 0);
        }
        const int j = 32 * tj + r32; const float gj = SC[j];
#pragma unroll
        for (int r = 0; r < 16; ++r) { const int i = 32 * ti + crow(r, hi); const float d = __expf(i >= j ? SC[i] - gj : 0.f);
            if (which == 0) *(LAS float*)(lds + P_L + (i * 68 + j) * 4) = (i > j) ? SC[64 + i] * acc[r] * d : 0.f;
            else *(LAS bf16_t*)(lds + P_AQ + (i * 72 + j) * 2) = (bf16_t)f2bf((i >= j) ? acc[r] * d : 0.f); }
    }
    LDS_WAIT(); __syncthreads();
    if (wid < 4) {
        const int c = 64 * wid + lane; const bool isw = c < 128;
        const LAS unsigned char* src = lds + (isw ? P_K + 2 * c : P_V + 2 * (c - 128));
        float x[64];
#pragma unroll
        for (int i = 0; i < 64; ++i) {
            const float egi = SC[128 + i]; float a0 = bf2f(*(const LAS bf16_t*)(src + i * 272)) * SC[64 + i] * (isw ? egi : 1.f), a1 = 0.f;
            const LAS f32x4* Lr = (const LAS f32x4*)(lds + P_L + i * 272);
#pragma unroll
            for (int jc = 0; jc < (i + 3) / 4; ++jc) { const f32x4 L4 = Lr[jc];
#pragma unroll
                for (int jj = 0; jj < 4; ++jj) { const int j = 4 * jc + jj; if (j < i) { if (j & 1) a1 -= L4[jj] * x[j]; else a0 -= L4[jj] * x[j]; } } }
            { float xi = a0 + a1; asm volatile("" : "+v"(xi) :: "memory"); x[i] = xi; }
        }
        if (isw) {
#pragma unroll
            for (int i = 0; i < 64; ++i) *(LAS bf16_t*)(lds + P_W + i * 272 + 2 * c) = (bf16_t)f2bf(-x[i]);
        } else {
            const int dv = c - 128; LAS bf16_t* up = (LAS bf16_t*)(lds + P_U0) + (size_t)((dv >> 5) * 2) * 1024 + (dv & 31) * 16;
#pragma unroll
            for (int i = 0; i < 64; ++i) { const int mt = i >> 5, ii = i & 31, hh = (ii >> 2) & 1, r = (ii & 3) | ((ii >> 3) << 2); up[mt * 1024 + hh * 512 + r] = (bf16_t)f2bf(x[i]); }
        }
    } else {
        const int t4 = tid - 256;
#pragma unroll
        for (int it = 0; it < 4; ++it) {
            const int p = it * 256 + t4, f = p >> 6, ln = p & 63, mt = f & 1, s = (f >> 1) & 1, kt = f >> 2, hh = ln >> 5, r = ln & 31, row = 32 * mt + r, k0 = 32 * kt + 16 * s + 4 * hh;
            const u32x2 a = *(const LAS u32x2*)(lds + P_Q + row * 272 + k0 * 2), c2 = *(const LAS u32x2*)(lds + P_Q + row * 272 + k0 * 2 + 16); const float e = SC[128 + row];
            u32x4 o; o.x = cvtpk(bf2f((bf16_t)(a.x & 0xffff)) * e, bf2f((bf16_t)(a.x >> 16)) * e); o.y = cvtpk(bf2f((bf16_t)(a.y & 0xffff)) * e, bf2f((bf16_t)(a.y >> 16)) * e);
            o.z = cvtpk(bf2f((bf16_t)(c2.x & 0xffff)) * e, bf2f((bf16_t)(c2.x >> 16)) * e); o.w = cvtpk(bf2f((bf16_t)(c2.y & 0xffff)) * e, bf2f((bf16_t)(c2.y >> 16)) * e);
            *(u32x4*)(G + O_QG + p * 16) = o; }
#pragma unroll
        for (int it = 0; it < 4; ++it) {
            const int p = it * 256 + t4, f = p >> 6, ln = p & 63, mt = f & 3, s = (f >> 2) & 1, kt = f >> 3, hh = ln >> 5, r = ln & 31, dk = 32 * mt + r, p0 = 32 * kt + 16 * s + 4 * hh;
            float v[8];
#pragma unroll
            for (int j = 0; j < 8; ++j) { const int pos = p0 + 8 * (j >> 2) + (j & 3); v[j] = bf2f(*(const LAS bf16_t*)(lds + P_K + pos * 272 + dk * 2)) * SC[192 + pos]; }
            u32x4 o; o.x = cvtpk(v[0], v[1]); o.y = cvtpk(v[2], v[3]); o.z = cvtpk(v[4], v[5]); o.w = cvtpk(v[6], v[7]);
            *(u32x4*)(G + O_KE + p * 16) = o; }
    }
    LDS_WAIT(); __syncthreads();
#pragma unroll
    for (int it = 0; it < 2; ++it) {
        const int p = it * 512 + tid, f = p >> 6, ln = p & 63, mt = f & 1, s = (f >> 1) & 1, kt = f >> 2, hh = ln >> 5, r = ln & 31, row = 32 * mt + r, k0 = 32 * kt + 16 * s + 4 * hh;
        const u32x2 a = *(const LAS u32x2*)(lds + P_W + row * 272 + k0 * 2), c2 = *(const LAS u32x2*)(lds + P_W + row * 272 + k0 * 2 + 16);
        *(u32x4*)(G + O_WN + p * 16) = (u32x4){a.x, a.y, c2.x, c2.y}; }
    {
        const int p = tid, f = p >> 6, ln = p & 63, mt = f & 1, s = (f >> 1) & 1, kt = f >> 2, hh = ln >> 5, r = ln & 31, row = 32 * mt + r, k0 = 32 * kt + 16 * s + 4 * hh;
        const u32x2 a = *(const LAS u32x2*)(lds + P_AQ + row * 144 + k0 * 2), c2 = *(const LAS u32x2*)(lds + P_AQ + row * 144 + k0 * 2 + 16);
        *(u32x4*)(G + O_AQK + p * 16) = (u32x4){a.x, a.y, c2.x, c2.y}; }
#pragma unroll
    for (int it = 0; it < 2; ++it) { const int p = it * 512 + tid; *(u32x4*)(G + O_U0 + p * 16) = *(const LAS u32x4*)(lds + P_U0 + p * 16); }
    LDS_WAIT(); __syncthreads();
}

__device__ __forceinline__ void kmean_item(const Frame& F0, int item) {
    Frame F = F0; asm volatile("" : "+v"(F.tid));
    const int tid = F.tid, n = item & 31, h = (item >> 5) & 3, b = item >> 7, rg = tid >> 3, c8 = (tid & 7) * 8;
    const bf16_t* p = W_PROJ(F.ws) + ((size_t)b * SEQ + n * 256 + rg * 4) * PROJ_LD + C_CK + 64 * h + c8;
    float s[8] = {0.f, 0.f, 0.f, 0.f, 0.f, 0.f, 0.f, 0.f};
#pragma unroll
    for (int i = 0; i < 4; ++i) { const bf16x8 v = *(const bf16x8*)(p + (size_t)i * PROJ_LD);
#pragma unroll
        for (int j = 0; j < 8; ++j) s[j] += bf2f((bf16_t)v[j]); }
    LAS float* part = (LAS float*)F.lds;
#pragma unroll
    for (int j = 0; j < 8; ++j) part[rg * 64 + c8 + j] = s[j];
    LDS_WAIT(); __syncthreads();
    if (tid < 64) { float a = 0.f;
#pragma unroll 8
        for (int g = 0; g < 64; ++g) a += part[g * 64 + tid];
        W_KM(F.ws)[(size_t)item * 64 + tid] = a * (1.f / 256.f); }
    LDS_WAIT(); __syncthreads();
}
}
namespace gdn {
constexpr int S_BUFSZ = 57344, S_OST = 2 * S_BUFSZ, S_OSTSZ = 17408;
static_assert(S_OST + 2 * S_OSTSZ <= LDS_MISC, "scan LDS map");
__device__ __forceinline__ bf16x8 pack8(const f32x16& v, int s) {
    u32x4 w; w.x = cvtpk(v[8 * s], v[8 * s + 1]); w.y = cvtpk(v[8 * s + 2], v[8 * s + 3]); w.z = cvtpk(v[8 * s + 4], v[8 * s + 5]); w.w = cvtpk(v[8 * s + 6], v[8 * s + 7]);
    return __builtin_bit_cast(bf16x8, w);
}
__device__ __forceinline__ void scan_out_rows(const LAS unsigned char* op, int hw, int lane, size_t grow0, int h, const bf16_t* PROJ, bf16_t* Y, float nw0, float nw1) {
#pragma unroll 4
    for (int i = 0; i < 16; ++i) { const int t = 16 * hw + i; const unsigned o2 = *(const LAS unsigned*)(op + t * 272 + 4 * lane);
        const float o0 = bf2f((bf16_t)(o2 & 0xffff)), o1 = bf2f((bf16_t)(o2 >> 16)); const float rs = rsqrtf(wave_sum(o0 * o0 + o1 * o1) * (1.f / 128.f) + RMS_EPS);
        const size_t grow = grow0 + t; const unsigned z2 = *(const unsigned*)(PROJ + grow * PROJ_LD + C_GZ + 128 * h + 2 * lane);
        *(unsigned*)(Y + grow * LDY + 256 + 128 * h + 2 * lane) = cvtpk(o0 * rs * nw0 * siluf(bf2f((bf16_t)(z2 & 0xffff))), o1 * rs * nw1 * siluf(bf2f((bf16_t)(z2 >> 16)))); }
}
__device__ __forceinline__ void scan_chain(const Frame& F0, int l, int bh) {
    Frame F = F0; asm volatile("" : "+v"(F.tid)); F.lane = F.tid & 63;
    const int lane = F.lane, wid = F.wave, r32 = lane & 31, hi = lane >> 5, b = bh >> 2, h = bh & 3;
    LAS unsigned char* lds = F.lds; unsigned char* ws = F.ws;
    const unsigned char* Gb = ws + WS_GDN + (size_t)(bh * 128) * CH_BYTES;
    if (wid >= 4) {
        const int hw = wid - 4; const bf16_t* PROJ = W_PROJ(ws); bf16_t* Y = W_Y(ws);
        kargs_t ka = kargs(); const f32x2 nv = *(const f32x2*)(IN_GNORM(ka) + l * 128 + 2 * lane); const float nw0 = nv[0], nw1 = nv[1];
        for (int pc = hw; pc < 56; pc += 4) __builtin_amdgcn_global_load_lds((const unsigned*)(Gb + pc * 1024 + lane * 16), (LAS unsigned*)(lds + pc * 1024), 16, 0, 0);
        VM_WAIT(); __syncthreads();
        for (int n = 0; n < 128; ++n) {
            if (n + 1 < 128) { const unsigned char* Gn = Gb + (size_t)(n + 1) * CH_BYTES; LAS unsigned char* dst = lds + ((n + 1) & 1) * S_BUFSZ;
                for (int pc = hw; pc < 56; pc += 4) __builtin_amdgcn_global_load_lds((const unsigned*)(Gn + pc * 1024 + lane * 16), (LAS unsigned*)(dst + pc * 1024), 16, 0, 0); }
            if (n >= 1) scan_out_rows(lds + S_OST + ((n - 1) & 1) * S_OSTSZ, hw, lane, (size_t)b * SEQ + (n - 1) * 64, h, PROJ, Y, nw0, nw1);
            LDS_WAIT(); VM_WAIT(); __syncthreads();
        }
        scan_out_rows(lds + S_OST + (127 & 1) * S_OSTSZ, hw, lane, (size_t)b * SEQ + 127 * 64, h, PROJ, Y, nw0, nw1);
    } else {
        const int w = wid; const float* GE = (const float*)(ws + WS_GEND) + bh * 128;
        f32x16 S[4]; S[0] = f32x16{}; S[1] = f32x16{}; S[2] = f32x16{}; S[3] = f32x16{};
        u32x4 u0n[4];
#pragma unroll
        for (int mt = 0; mt < 2; ++mt) { const u32x4* p = (const u32x4*)(Gb + O_U0 + ((w * 2 + mt) * 64 + lane) * 32); u0n[2 * mt] = p[0]; u0n[2 * mt + 1] = p[1]; }
        VM_WAIT(); __syncthreads();
        for (int n = 0; n < 128; ++n) {
            LAS unsigned char* ost = lds + S_OST + (n & 1) * S_OSTSZ;
            const LAS unsigned char* B = lds + (n & 1) * S_BUFSZ + lane * 16;
            const float ge = GE[n];
            f32x16 U[2], O[2];
#pragma unroll
            for (int mt = 0; mt < 2; ++mt)
#pragma unroll
                for (int q = 0; q < 4; ++q) { const unsigned v0 = u0n[2 * mt][q], v1 = u0n[2 * mt + 1][q];
                    U[mt][2 * q] = bf2f((bf16_t)(v0 & 0xffff)); U[mt][2 * q + 1] = bf2f((bf16_t)(v0 >> 16)); U[mt][8 + 2 * q] = bf2f((bf16_t)(v1 & 0xffff)); U[mt][9 + 2 * q] = bf2f((bf16_t)(v1 >> 16)); }
            if (n + 1 < 128) {
#pragma unroll
                for (int mt = 0; mt < 2; ++mt) { const u32x4* p = (const u32x4*)(Gb + (size_t)(n + 1) * CH_BYTES + O_U0 + ((w * 2 + mt) * 64 + lane) * 32); u0n[2 * mt] = p[0]; u0n[2 * mt + 1] = p[1]; }
            }
            O[0] = f32x16{}; O[1] = f32x16{};
#pragma unroll
            for (int kt = 0; kt < 4; ++kt)
#pragma unroll
                for (int s = 0; s < 2; ++s) { const bf16x8 sb = pack8(S[kt], s);
#pragma unroll
                    for (int mt = 0; mt < 2; ++mt) { const int f = (kt * 2 + s) * 2 + mt;
                        U[mt] = __builtin_amdgcn_mfma_f32_32x32x16_bf16(*(const LAS bf16x8*)(B + O_WN + f * 1024), sb, U[mt], 0, 0, 0);
                        O[mt] = __builtin_amdgcn_mfma_f32_32x32x16_bf16(*(const LAS bf16x8*)(B + O_QG + f * 1024), sb, O[mt], 0, 0, 0); }
                    asm volatile("" ::: "memory"); }
#pragma unroll
            for (int mt = 0; mt < 4; ++mt) S[mt] = S[mt] * ge;
#pragma unroll
            for (int kt = 0; kt < 2; ++kt)
#pragma unroll
                for (int s = 0; s < 2; ++s) { const bf16x8 ub = pack8(U[kt], s);
#pragma unroll
                    for (int mt = 0; mt < 2; ++mt) O[mt] = __builtin_amdgcn_mfma_f32_32x32x16_bf16(*(const LAS bf16x8*)(B + O_AQK + ((kt * 2 + s) * 2 + mt) * 1024), ub, O[mt], 0, 0, 0);
#pragma unroll
                    for (int mt = 0; mt < 4; ++mt) S[mt] = __builtin_amdgcn_mfma_f32_32x32x16_bf16(*(const LAS bf16x8*)(B + O_KE + ((kt * 2 + s) * 4 + mt) * 1024), ub, S[mt], 0, 0, 0);
                    asm volatile("" ::: "memory"); }
#pragma unroll
            for (int mt = 0; mt < 2; ++mt)
#pragma unroll
                for (int r = 0; r < 16; ++r) *(LAS bf16_t*)(ost + (32 * mt + crow(r, hi)) * 272 + (32 * w + r32) * 2) = (bf16_t)f2bf(O[mt][r]);
            LDS_WAIT(); __syncthreads();
        }
    }
    LDS_WAIT(); VM_WAIT(); __syncthreads();
}
}
__global__ void __launch_bounds__(NTHREADS, 2) skel_fwd(Args args) {
    extern __shared__ __attribute__((aligned(16))) unsigned char lds_raw[];
    Frame F;
    F.lds = (LAS unsigned char*)lds_raw; F.tid = threadIdx.x; F.lane = F.tid & 63; F.wave = __builtin_amdgcn_readfirstlane(F.tid >> 6); F.G = gridDim.x; F.bx = blockIdx.x; F.ws = args.ws;
    unsigned char* ws = args.ws;
    unsigned* ctl = (unsigned*)(ws + WS_CTL);
    volatile LAS unsigned* MISC = (volatile LAS unsigned*)(F.lds + LDS_MISC);
    for (int u = F.tid; u < 64; u += NTHREADS) MISC[u] = 0u;
    __syncthreads();
    const int lo = args.ph_lo, hi = args.ph_hi;
    const bool multi = (hi - lo) > 1;
    XcdBarrier bar; bar.bar = ctl + CW_BAR + lo * XCD_BAR_WORDS; bar.x = 0; bar.st = nullptr;
    if (multi) bar = xcd_barrier_post(ctl + CW_BAR + lo * XCD_BAR_WORDS, MISC + 8);
    for (int ph = lo; ph < hi; ++ph) {
        if (ph == 0) {
            p0_prologue(F, kargs());
        } else if (ph == N_PHASES - 1) {
            { kargs_t ka = kargs(); final_norm(F, ka->out, IN_FNORM(ka)); }
        } else {
            const int l = (ph - 1) >> 2, sub = (ph - 1) & 3;
            if (sub == 0) {
                if (l > 0) { convert_weights(F, kargs(), l, 2); }
                VM_WAIT(); __syncthreads();
                pg8::Gemm g{W_XB(ws), W_WIN(ws), 1024, 1024, 1024}; pg8::StaticOrder S; S.init(M_TOK, 3840, F.G, F.bx);
                pg8::EpiProj E{W_PROJ(ws), W_SSQ(ws)};
                pg8::gemm_phase<pg8::EpiProj, pg8::StaticOrder>(F.lds, g, S, E);
            } else if (sub == 1) {
                if (F.G == 256) {
                    const bool isq = F.bx < 128; const int ui = isq ? F.bx : F.bx - 128, pm = ui >> 1, pn = ui & 1;
                    pb_prepass(F, pm, (!isq) && pn == 0);
                    LDS_WAIT(); VM_WAIT(); __syncthreads();
                    const LAS float* RS = (const LAS float*)(F.lds + LDS_RS);
                    { pg8::Gemm g{W_PROJ(ws) + C_MCQ, W_WUQ(ws), PROJ_LD, 256, 256}; pg8::OneUnit S{pm, pn, isq}; pg8::EpiQ E{W_Q(ws), RS, W_COS(ws), W_SIN(ws), QSCALE};
                      pg8::gemm_phase<pg8::EpiQ, pg8::OneUnit>(F.lds, g, S, E); }
                    { pg8::Gemm g{W_PROJ(ws) + C_MCKV, W_WUKV(ws), PROJ_LD, 128, 128}; pg8::OneUnit S{pm, pn, !isq}; pg8::EpiKV E{W_K(ws), W_V(ws), RS};
                      pg8::gemm_phase<pg8::EpiKV, pg8::OneUnit>(F.lds, g, S, E); }
                }
                for (int c = F.bx; c < 1024; c += F.G) gdn::prep_chunk(F, l, c >> 9, (c >> 7) & 3, c & 127);
                for (int it = F.bx; it < 256; it += F.G) gdn::kmean_item(F, it);
            } else if (sub == 2) {
                volatile LAS int* slot = (volatile LAS int*)(F.lds + LDS_MISC + 128);
                for (;;) {
                    if (F.tid == 0) *slot = (int)__hip_atomic_fetch_add(ctl + CW_Q + 64 * l, 1u, __ATOMIC_RELAXED, __HIP_MEMORY_SCOPE_AGENT);
                    __syncthreads();
                    const int u = __builtin_amdgcn_readfirstlane(*slot);
                    __syncthreads();
                    if (u >= 520) break;
                    if (u < 8) { gdn::scan_chain(F, l, u); continue; }
                    const int v = u - 8, qb = 31 - (v >> 4), kind = (v >> 3) & 1, bh = v & 7;
                    if (kind == 0) att::attn_unit<0>(F, bh >> 2, bh & 3, qb); else att::attn_unit<1>(F, bh >> 2, bh & 3, qb);
                }
            } else {
                if (l + 1 < DEPTH) { convert_weights(F, kargs(), l + 1, 1); }
                VM_WAIT(); __syncthreads();
                if (F.G == 256) {
                    pg8::Gemm g{W_Y(ws), W_WOUT(ws), LDY, 1024, 1024}; pg8::StaticOrder S; S.init(M_TOK, 1024, F.G, F.bx);
                    kargs_t ka = kargs(); float* xo = ka->out; pg8::EpiRes E{(l == 0) ? IN_X(ka) : xo, xo, W_XB(ws), W_SSQ(ws)};
                    pg8::gemm_phase<pg8::EpiRes, pg8::StaticOrder>(F.lds, g, S, E);
                }
            }
        }
        if (ph + 1 < hi) xcd_barrier(bar);
    }
}
extern "C" void kernel_launch(void* const* d_in, const int* in_sizes, int n_in, void* d_out, int out_size, void* d_ws, size_t ws_size, hipStream_t stream) {
    static int grid = 0;
    if (grid == 0) {
        int dev = 0, cus = 0;
        if (n_in != 14 || ws_size < WS_END || hipGetDevice(&dev) != hipSuccess || hipDeviceGetAttribute(&cus, hipDeviceAttributeMultiprocessorCount, dev) != hipSuccess) { grid = -1; return; }
        if (hipFuncSetAttribute((const void*)skel_fwd, hipFuncAttributeMaxDynamicSharedMemorySize, LDS_BYTES) != hipSuccess) { grid = -1; return; }
        grid = cus;
    }
    if (grid != 256) return;
    unsigned char* ws = (unsigned char*)d_ws;
    (void)hipMemsetAsync(ws + WS_CTL, 0, CTL_ZERO_BYTES, stream);
    Args a{};
    for (int i = 0; i < 14; ++i) a.in[i] = (const float*)d_in[i];
    a.out = (float*)d_out; a.ws = ws;
    auto fast = [&](int lo, int hi) { a.ph_lo = lo; a.ph_hi = hi; hipLaunchKernelGGL(skel_fwd, dim3(grid), dim3(NTHREADS), LDS_BYTES, stream, a); };
    const float* conv_w = (const float*)d_in[7]; const float* A_log = (const float*)d_in[8]; const float* dt_bias = (const float*)d_in[9]; const float* gnorm_w = (const float*)d_in[10];
    float* TBL = (float*)(ws + WS_TBL); float* KM = (float*)(ws + WS_KMEAN);
    bf16_t* Qb = (bf16_t*)(ws + WS_Q); bf16_t* Kb = (bf16_t*)(ws + WS_K); bf16_t* Vb = (bf16_t*)(ws + WS_V); bf16_t* PROJ = (bf16_t*)(ws + WS_PROJ); bf16_t* YN = (bf16_t*)(ws + WS_YN);
    fast(0, N_PHASES);
}
```

```cpp
#include <hip/hip_runtime.h>
#include <cstdint>
#include <cstddef>

constexpr int D_MODEL = 1024, BATCH = 2, SEQ = 8192, DEPTH = 4, M_TOK = BATCH * SEQ;
constexpr int IN_COLS = 3752, PROJ_LD = 3840;
constexpr int C_MCQ = 0, C_MCKV = 256, C_MKR = 384, C_MGATE = 416, C_GQ = 672, C_GK = 1184, C_GV = 1696, C_GZ = 2208, C_GB = 2720, C_GA = 2724,
              C_CQ = 2728, C_CK = 2984, C_CV = 3240, C_CGATE = 3496;
constexpr float RMS_EPS = 1e-6f;
constexpr int Q_LD = 384, K_LD = 384, V_LD = 256;

constexpr size_t MiB = 1u << 20;
constexpr size_t WS_CTL = 0;
constexpr size_t WS_TBL = 1 * MiB;
constexpr size_t WS_KMEAN = WS_TBL + 32768;
constexpr size_t WS_SSQ = WS_KMEAN + 65536;
constexpr size_t WS_RQ = WS_SSQ + 262144;
constexpr size_t WS_RKV = WS_RQ + 65536;
constexpr size_t WS_COS = WS_RKV + 65536;
constexpr size_t WS_SIN = WS_COS + 524288;
constexpr size_t WS_GEND = WS_SIN + 524288;
constexpr size_t WS_WIN = 3 * MiB;
constexpr size_t WS_WOUT = WS_WIN + 3840 * 1024 * 2;
constexpr size_t WS_WUQ = WS_WOUT + 2 * MiB;
constexpr size_t WS_WUKV = WS_WUQ + 262144;
constexpr size_t WS_Q = 13 * MiB;
constexpr size_t WS_K = 25 * MiB;
constexpr size_t WS_V = 37 * MiB;
constexpr size_t WS_PROJ = 45 * MiB;
constexpr size_t WS_XB = 165 * MiB;
constexpr size_t WS_GDN = 165 * MiB;
constexpr size_t WS_YN = 197 * MiB;
constexpr size_t WS_END = 256 * MiB;

typedef unsigned short bf16_t;
__device__ __forceinline__ unsigned f2bf(float f) { unsigned u = __builtin_bit_cast(unsigned, f); return (u + 0x7fffu + ((u >> 16) & 1u)) >> 16; }
__device__ __forceinline__ float bf2f(bf16_t b) { return __builtin_bit_cast(float, (unsigned)b << 16); }
__device__ __forceinline__ float siluf(float x) { return x / (1.f + __expf(-x)); }
__device__ __forceinline__ float wave_sum(float v) {
#pragma unroll
    for (int o = 1; o < 64; o <<= 1) v += __shfl_xor(v, o);
    return v;
}

#define LAS __attribute__((address_space(3)))
#define GAS __attribute__((address_space(1)))
typedef short bf16x8 __attribute__((ext_vector_type(8)));
typedef float f32x4 __attribute__((ext_vector_type(4)));
typedef float f32x2 __attribute__((ext_vector_type(2)));
typedef float f32x16 __attribute__((ext_vector_type(16)));
typedef unsigned u32x4 __attribute__((ext_vector_type(4)));
typedef unsigned u32x2 __attribute__((ext_vector_type(2)));
typedef __bf16 bf16x2_t __attribute__((ext_vector_type(2)));
__device__ __forceinline__ unsigned cvtpk(float lo, float hi) { f32x2 v = {lo, hi}; bf16x2_t b = __builtin_convertvector(v, bf16x2_t); return __builtin_bit_cast(unsigned, b); }
#define LDS_WAIT() asm volatile("s_waitcnt lgkmcnt(0)" ::: "memory")
#define VM_WAIT() asm volatile("s_waitcnt vmcnt(0)" ::: "memory")

constexpr int RING_BYTES = 131072;
constexpr int LDS_RS = 131072;
constexpr int LDS_MISC = 131072 + 24576;
constexpr int LDS_BYTES = 163840;

namespace pg8 {
constexpr int BM = 256, BK = 64, HALF = 128, HTB = HALF * BK * 2, NXCD = 8, WGM = 8;
__host__ __device__ __forceinline__ int lds_byte(int r, int c) { const int st = (r >> 4) * 2 + (c >> 5), rr = r & 15, cc = c & 31, ob = rr * 64 + cc * 2; return st * 1024 + (ob ^ (((ob >> 9) & 1) << 5)); }
__host__ __device__ __forceinline__ void stage_rc(int b, int& R, int& C) { const int st = b / 1024, sb = b % 1024, swz = sb ^ (((sb >> 9) & 1) << 5); R = (st >> 1) * 16 + swz / 64; C = (st & 1) * 32 + (swz % 64) / 2; }
__host__ __device__ __forceinline__ int perm32(int rho) { const int n = rho >> 4, i = rho & 15; return 8 * (i >> 2) + 4 * n + (i & 3); }
struct Unit { int pm, pn; };
struct Gemm { const bf16_t* A; const bf16_t* Bt; int lda, ldb, K; };
struct StaticOrder {
    int nM, nN, nwg, G, c;
    __device__ void init(int M, int N, int G_, int c_) { nM = M / BM; nN = N / BM; nwg = nM * nN; G = G_; c = c_; }
    __device__ bool next(int i, Unit& u) const {
        const long L = (long)i * G + c; if (L >= nwg) return false;
        int wgid = (int)L; { const int q = nwg / NXCD, r = nwg % NXCD, xcd = wgid % NXCD, off = wgid / NXCD; wgid = (xcd < r ? xcd * (q + 1) : r * (q + 1) + (xcd - r) * q) + off; }
        const int nig = WGM * nN, gid = wgid / nig, fm = gid * WGM, gsz = (nM - fm) < WGM ? (nM - fm) : WGM;
        u.pm = fm + ((wgid % nig) % gsz); u.pn = (wgid % nig) / gsz; return true;
    }
};
struct OneUnit {
    int pm, pn; bool have;
    __device__ bool next(int i, Unit& u) const { if (i > 0 || !have) return false; u.pm = pm; u.pn = pn; return true; }
};
template <class Epi, class Sched>
__device__ __forceinline__ void gemm_phase(LAS unsigned char* lds, const Gemm g, const Sched& S, const Epi& E) {
    int tid_ = threadIdx.x; asm volatile("" : "+v"(tid_));
    const int tid = tid_, wid = __builtin_amdgcn_readfirstlane(tid >> 6), lane = tid & 63, wr = wid >> 2, wc = wid & 3, fr = lane & 15, fq = lane >> 4;
    int K_ = g.K; asm volatile("" : "+s"(K_));
    const int K = K_, nt = K / BK;
    unsigned voffA[2], voffB[2];
#pragma unroll
    for (int i = 0; i < 2; ++i) { int R, C; stage_rc(tid * 16 + i * 8192, R, C); const int Rb = Epi::PERM ? ((R & ~31) + perm32(R & 31)) : R;
        voffA[i] = (unsigned)(R * g.lda + C) * 2u; voffB[i] = (unsigned)(Rb * g.ldb + C) * 2u; }
    const size_t kstep = (size_t)(BK * 2);
    const size_t hstepA = (size_t)HALF * g.lda * 2, hstepB = (size_t)HALF * g.ldb * 2, tstepA = 2 * hstepA, tstepB = 2 * hstepB;
    const unsigned ldsw = (unsigned)wid * 1024u;
    const int aoff = lds_byte(wr * 64 + fr, fq * 8), boff = lds_byte(wc * 32 + fr, fq * 8);
#define PG8_SA(b, h) (((b) * 2 + (h)) * HTB)
#define PG8_SB(b, h) ((4 + (b) * 2 + (h)) * HTB)
#define PG8_STAGE(bufoff, gbase, voff) do { _Pragma("unroll") for (int _i = 0; _i < 2; ++_i) \
        __builtin_amdgcn_global_load_lds((const unsigned*)((const char*)(gbase) + (voff)[_i]), (LAS unsigned*)(lds + (bufoff) + ldsw + _i * 8192), 16, 0, 0); } while (0)
#define PG8_LDA(dst, b, h) do { _Pragma("unroll") for (int m = 0; m < 4; ++m) _Pragma("unroll") for (int k = 0; k < 2; ++k) dst[m][k] = *(const LAS bf16x8*)(lds + PG8_SA(b, h) + aoff + m * 2048 + k * 1024); } while (0)
#define PG8_LDB(dst, b, h) do { _Pragma("unroll") for (int n = 0; n < 2; ++n) _Pragma("unroll") for (int k = 0; k < 2; ++k) dst[n][k] = *(const LAS bf16x8*)(lds + PG8_SB(b, h) + boff + n * 2048 + k * 1024); } while (0)
#define PG8_MMA(ai, bj, At, Bt) do { __builtin_amdgcn_s_setprio(1); _Pragma("unroll") for (int m = 0; m < 4; ++m) _Pragma("unroll") for (int n = 0; n < 2; ++n) _Pragma("unroll") for (int k = 0; k < 2; ++k) \
        acc[ai][bj][m][n] = __builtin_amdgcn_mfma_f32_16x16x32_bf16(Bt[n][k], At[m][k], acc[ai][bj][m][n], 0, 0, 0); __builtin_amdgcn_s_setprio(0); } while (0)
#define PG8_WAIT_V(n) asm volatile("s_waitcnt vmcnt(" #n ")" ::: "memory")
#define PG8_WAIT_L(n) asm volatile("s_waitcnt lgkmcnt(" #n ")" ::: "memory")
#define PG8_BAR __builtin_amdgcn_s_barrier()
#define PG8_SCHED __builtin_amdgcn_sched_barrier(0)
    Unit cur, nxt; int ui = 0;
    if (!S.next(0, cur)) return;
    f32x4 acc[2][2][4][2];
#pragma unroll
    for (int a = 0; a < 2; ++a)
#pragma unroll
        for (int b = 0; b < 2; ++b)
#pragma unroll
            for (int m = 0; m < 4; ++m)
#pragma unroll
                for (int n = 0; n < 2; ++n) acc[a][b][m][n] = (f32x4){0.f, 0.f, 0.f, 0.f};
    bf16x8 At[4][2], B0[2][2], B1[2][2];
    const char* cA = (const char*)g.A + (size_t)cur.pm * tstepA; const char* cB = (const char*)g.Bt + (size_t)cur.pn * tstepB;
    PG8_STAGE(PG8_SB(0, 0), cB, voffB); PG8_STAGE(PG8_SB(0, 1), cB + hstepB, voffB); PG8_STAGE(PG8_SA(0, 0), cA, voffA); PG8_STAGE(PG8_SA(0, 1), cA + hstepA, voffA);
    if (wr == 1) PG8_BAR;
    PG8_WAIT_V(2); PG8_BAR;
    PG8_STAGE(PG8_SB(1, 0), cB + kstep, voffB); PG8_STAGE(PG8_SA(1, 0), cA + kstep, voffA); PG8_STAGE(PG8_SB(1, 1), cB + hstepB + kstep, voffB);
    PG8_WAIT_V(6); PG8_BAR;
    for (;;) {
        const bool has_next = S.next(ui + 1, nxt);
        const char* nA = has_next ? (const char*)g.A + (size_t)nxt.pm * tstepA : cA; const char* nB = has_next ? (const char*)g.Bt + (size_t)nxt.pn * tstepB : cB;
        for (int t = 0; t < nt; t += 2) {
            const bool last = (t == nt - 2);
            const char* a1 = cA + (size_t)(t + 1) * kstep;
            const char* a2 = last ? nA : cA + (size_t)(t + 2) * kstep; const char* b2 = last ? nB : cB + (size_t)(t + 2) * kstep;
            const char* a3 = a2 + kstep; const char* b3 = b2 + kstep;
            PG8_LDB(B0, 0, 0); PG8_LDB(B1, 0, 1); PG8_SCHED; PG8_LDA(At, 0, 0); PG8_STAGE(PG8_SA(1, 1), a1 + hstepA, voffA);
            PG8_WAIT_V(8); PG8_WAIT_L(0); PG8_BAR; PG8_MMA(0, 0, At, B0); PG8_MMA(0, 1, At, B1); PG8_BAR; PG8_SCHED;
            PG8_LDA(At, 0, 1); PG8_STAGE(PG8_SB(0, 0), b2, voffB); PG8_STAGE(PG8_SB(0, 1), b2 + hstepB, voffB); PG8_STAGE(PG8_SA(0, 0), a2, voffA);
            PG8_WAIT_V(8); PG8_WAIT_L(0); PG8_BAR; PG8_MMA(1, 0, At, B0); PG8_MMA(1, 1, At, B1); PG8_BAR; PG8_SCHED;
            PG8_LDB(B0, 1, 0); PG8_LDB(B1, 1, 1); PG8_SCHED; PG8_LDA(At, 1, 0); PG8_STAGE(PG8_SA(0, 1), a2 + hstepA, voffA);
            PG8_WAIT_V(8); PG8_WAIT_L(0); PG8_BAR; PG8_MMA(0, 0, At, B0); PG8_MMA(0, 1, At, B1); PG8_BAR; PG8_SCHED;
            PG8_LDA(At, 1, 1); PG8_STAGE(PG8_SB(1, 0), b3, voffB); PG8_STAGE(PG8_SB(1, 1), b3 + hstepB, voffB); PG8_STAGE(PG8_SA(1, 0), a3, voffA);
            PG8_WAIT_V(8); PG8_WAIT_L(0); PG8_BAR; PG8_MMA(1, 0, At, B0); PG8_MMA(1, 1, At, B1); PG8_BAR; PG8_SCHED;
        }
        if (wr == 0) PG8_BAR;
        if constexpr (!Epi::AFTER_DRAIN) { E(acc, cur, wr, wc, fr, fq); }
        if (!has_next) break;
#pragma unroll
        for (int a = 0; a < 2; ++a)
#pragma unroll
            for (int b = 0; b < 2; ++b)
#pragma unroll
                for (int m = 0; m < 4; ++m)
#pragma unroll
                    for (int n = 0; n < 2; ++n) acc[a][b][m][n] = (f32x4){0.f, 0.f, 0.f, 0.f};
        cur = nxt; cA = nA; cB = nB; ++ui;
        if (wr == 1) PG8_BAR;
    }
    PG8_WAIT_V(0);
    PG8_BAR;
    if constexpr (Epi::AFTER_DRAIN) { E.fused(acc, cur, wr, wc, fr, fq, lds, wid, lane); }
#undef PG8_SA
#undef PG8_SB
#undef PG8_STAGE
#undef PG8_LDA
#undef PG8_LDB
#undef PG8_MMA
#undef PG8_WAIT_V
#undef PG8_WAIT_L
#undef PG8_BAR
#undef PG8_SCHED
}

struct EpiProj {
    static constexpr bool PERM = true, AFTER_DRAIN = false;
    bf16_t* O; const float* ssq;
    __device__ __forceinline__ void operator()(const f32x4 (&acc)[2][2][4][2], const Unit& u, int wr, int wc, int fr, int fq) const {
        const int row0 = u.pm * BM + wr * 64 + fr, col0 = u.pn * BM + wc * 32 + 8 * fq;
#pragma unroll
        for (int ai = 0; ai < 2; ++ai)
#pragma unroll
            for (int m = 0; m < 4; ++m) { const int row = row0 + ai * HALF + m * 16; const f32x4 q = *(const f32x4*)(ssq + (size_t)row * 4);
                const float rs = rsqrtf(((q[0] + q[1]) + (q[2] + q[3])) * (1.f / D_MODEL) + RMS_EPS); bf16_t* rowp = O + (size_t)row * PROJ_LD + col0;
#pragma unroll
                for (int bj = 0; bj < 2; ++bj) { if (col0 + bj * HALF < IN_COLS) { const f32x4 v0 = acc[ai][bj][m][0] * rs, v1 = acc[ai][bj][m][1] * rs;
                    u32x4 w; w.x = cvtpk(v0[0], v0[1]); w.y = cvtpk(v0[2], v0[3]); w.z = cvtpk(v1[0], v1[1]); w.w = cvtpk(v1[2], v1[3]); *(u32x4*)(rowp + bj * HALF) = w; } } }
    }
};
struct EpiRes {
    static constexpr bool PERM = false, AFTER_DRAIN = true;
    const float* xin; float* xf; bf16_t* xb; float* ssq;
    __device__ __forceinline__ void fused(f32x4 (&acc)[2][2][4][2], const Unit& u, int wr, int wc, int fr, int fq, LAS unsigned char* lds, int wid, int lane) const {
        LAS float* P = (LAS float*)lds;
        const int col0 = u.pn * BM + wc * 32 + 4 * fq;
#pragma unroll
        for (int ai = 0; ai < 2; ++ai)
#pragma unroll
            for (int m = 0; m < 4; ++m) { const int rl = ai * HALF + wr * 64 + m * 16 + fr; const size_t off = (size_t)(u.pm * BM + rl) * D_MODEL + col0; float s = 0.f;
#pragma unroll
                for (int bj = 0; bj < 2; ++bj)
#pragma unroll
                    for (int n = 0; n < 2; ++n) { const size_t o2 = off + bj * HALF + n * 16; const f32x4 o = *(const f32x4*)(xin + o2) + acc[ai][bj][m][n]; *(f32x4*)(xf + o2) = o;
                        u32x2 w; w.x = cvtpk(o[0], o[1]); w.y = cvtpk(o[2], o[3]); *(u32x2*)(xb + o2) = w; s += (o[0] * o[0] + o[1] * o[1]) + (o[2] * o[2] + o[3] * o[3]); }
                s += __shfl_xor(s, 16); s += __shfl_xor(s, 32);
                if (fq == 0) P[rl * 4 + wc] = s; }
        LDS_WAIT(); __builtin_amdgcn_s_barrier(); asm volatile("" ::: "memory");
        const int t = wid * 64 + lane;
        if (t < 256) { const f32x4 p = *(const LAS f32x4*)(P + t * 4); ssq[(size_t)(u.pm * BM + t) * 4 + u.pn] = (p[0] + p[1]) + (p[2] + p[3]); }
        LDS_WAIT(); __builtin_amdgcn_s_barrier();
    }
};
struct EpiQ {
    static constexpr bool PERM = false, AFTER_DRAIN = false;
    bf16_t* Q; const LAS float* RS; const float* cs; const float* sn; float qscale;
    __device__ __forceinline__ void operator()(const f32x4 (&acc)[2][2][4][2], const Unit& u, int wr, int wc, int fr, int fq) const {
#pragma unroll
        for (int ai = 0; ai < 2; ++ai)
#pragma unroll
            for (int m = 0; m < 4; ++m) { const int rl = ai * HALF + wr * 64 + m * 16 + fr, row = u.pm * BM + rl, pos = row & (SEQ - 1); const float rs = RS[rl * 2] * qscale;
                const f32x4 c4 = *(const f32x4*)(cs + pos * 16 + 4 * fq), s4 = *(const f32x4*)(sn + pos * 16 + 4 * fq);
#pragma unroll
                for (int bj = 0; bj < 2; ++bj) { const int cb = u.pn * BM + bj * HALF + wc * 32; if (cb < 384) {
                    f32x4 v0 = acc[ai][bj][m][0], v1 = acc[ai][bj][m][1];
                    if (((cb >> 5) % 3) == 2) { const f32x4 a = v0 * c4 - v1 * s4, b = v0 * s4 + v1 * c4; v0 = a; v1 = b; }
                    v0 = v0 * rs; v1 = v1 * rs; bf16_t* p = Q + (size_t)row * Q_LD + cb + 4 * fq;
                    u32x2 w0, w1; w0.x = cvtpk(v0[0], v0[1]); w0.y = cvtpk(v0[2], v0[3]); w1.x = cvtpk(v1[0], v1[1]); w1.y = cvtpk(v1[2], v1[3]);
                    *(u32x2*)p = w0; *(u32x2*)(p + 16) = w1; } }
                asm volatile("" ::: "memory"); }
    }
};
struct EpiKV {
    static constexpr bool PERM = true, AFTER_DRAIN = false;
    bf16_t* Kb; bf16_t* Vb; const LAS float* RS;
    __device__ __forceinline__ void operator()(const f32x4 (&acc)[2][2][4][2], const Unit& u, int wr, int wc, int fr, int fq) const {
#pragma unroll
        for (int ai = 0; ai < 2; ++ai)
#pragma unroll
            for (int m = 0; m < 4; ++m) { const int rl = ai * HALF + wr * 64 + m * 16 + fr, row = u.pm * BM + rl; const float rs = RS[rl * 2 + 1];
#pragma unroll
                for (int bj = 0; bj < 2; ++bj) { const int c = bj * HALF + wc * 32 + 8 * fq; const f32x4 v0 = acc[ai][bj][m][0] * rs, v1 = acc[ai][bj][m][1] * rs;
                    u32x4 w; w.x = cvtpk(v0[0], v0[1]); w.y = cvtpk(v0[2], v0[3]); w.z = cvtpk(v1[0], v1[1]); w.w = cvtpk(v1[2], v1[3]);
                    bf16_t* p = (u.pn == 0) ? Kb + (size_t)row * K_LD + 96 * (c >> 6) + (c & 63) : Vb + (size_t)row * V_LD + c;
                    *(u32x4*)p = w; } }
    }
};
}

#define XB_TMO      128
#define XB_XCNT(j)  (256  + 64 * (j))
#define XB_XSUB(j)  (1280 + 64 * (j))
#define XB_XGEN(j)  (2304 + 64 * (j))
#define XB_TOP      3328
#define XB_TOPGEN   3392
#define XCD_BAR_WORDS 3456
#define XB_SPIN_CAP (1u << 20)
__device__ __forceinline__ unsigned xb_ld(unsigned* p)              { return __hip_atomic_load(p, __ATOMIC_RELAXED, __HIP_MEMORY_SCOPE_AGENT); }
__device__ __forceinline__ unsigned xb_add(unsigned* p, unsigned v) { return __hip_atomic_fetch_add(p, v, __ATOMIC_RELAXED, __HIP_MEMORY_SCOPE_AGENT); }
__device__ __forceinline__ unsigned xb_xcc_id() { return (unsigned)__builtin_amdgcn_s_getreg((3 << 11) | 20) & 0xFu; }
#define XB_SPIN(cond, bar) do { unsigned _sp = 0; while (cond) { __builtin_amdgcn_s_sleep(1); \
    if ((++_sp & 255u) == 0u) { if (xb_ld(&(bar)[XB_TMO])) break; if (_sp > XB_SPIN_CAP) { atomicAdd(&(bar)[XB_TMO], 1u); break; } } } } while (0)
struct XcdBarrier { unsigned* bar; unsigned x; volatile LAS unsigned* st; };
__device__ __forceinline__ XcdBarrier xcd_barrier_post(unsigned* bar, volatile LAS unsigned* st) {
    XcdBarrier b; b.bar = bar; b.x = xb_xcc_id(); b.st = st;
    if (threadIdx.x == 0) (void)xb_add(&bar[XB_XCNT(b.x)], 1u);
    return b;
}
__device__ __forceinline__ void xcd_barrier_complete(unsigned* bar, unsigned x, unsigned& nloc, unsigned& nx) {
    const unsigned G = gridDim.x * gridDim.y * gridDim.z;
    unsigned sum, cnt, mine, sp = 0u;
    for (;;) {
        sum = 0u; cnt = 0u; mine = 0u;
#pragma unroll
        for (unsigned j = 0; j < 16; ++j) { const unsigned c = xb_ld(&bar[XB_XCNT(j)]); sum += c; cnt += (c > 0u) ? 1u : 0u; mine = (j == x) ? c : mine; }
        if (sum == G) break;
        __builtin_amdgcn_s_sleep(1);
        if ((++sp & 255u) == 0u) { if (xb_ld(&bar[XB_TMO])) break; if (sp > XB_SPIN_CAP) { atomicAdd(&bar[XB_TMO], 1u); break; } }
    }
    nloc = mine > 0u ? mine : 1u; nx = cnt > 0u ? cnt : 1u;
}
__device__ __forceinline__ void xcd_barrier(const XcdBarrier& b) {
    asm volatile("s_waitcnt vmcnt(0)" ::: "memory");
    __syncthreads();
    if (threadIdx.x == 0) {
        unsigned* bar = b.bar;
        __builtin_amdgcn_s_waitcnt(0);
        unsigned nloc = b.st[0], nx = b.st[1];
        if (nloc == 0u) { xcd_barrier_complete(bar, b.x, nloc, nx); b.st[0] = nloc; b.st[1] = nx; }
        const unsigned old = xb_add(&bar[XB_XSUB(b.x)], 1u);
        const unsigned gen = old / nloc;
        if (old + 1u == (gen + 1u) * nloc) {
            __builtin_amdgcn_fence(__ATOMIC_RELEASE, "agent");
            asm volatile("s_waitcnt vmcnt(0)" ::: "memory");
            const unsigned og = xb_add(&bar[XB_TOP], 1u);
            const unsigned tg = og / nx;
            if (og + 1u == (tg + 1u) * nx) xb_add(&bar[XB_TOPGEN], 1u);
            else XB_SPIN(xb_ld(&bar[XB_TOPGEN]) == tg, bar);
            __builtin_amdgcn_fence(__ATOMIC_ACQUIRE, "agent");
            xb_add(&bar[XB_XGEN(b.x)], 1u);
            asm volatile("s_waitcnt vmcnt(0)" ::: "memory");
        } else {
            XB_SPIN(xb_ld(&bar[XB_XGEN(b.x)]) == gen, bar);
            __builtin_amdgcn_fence(__ATOMIC_ACQUIRE, "agent");
            asm volatile("s_waitcnt vmcnt(0)" ::: "memory");
        }
    }
    __syncthreads();
}
constexpr int NWAVES = 8, NTHREADS = 512;
constexpr int CW_BAR = 4096, CW_Q = 131072;
constexpr size_t CTL_ZERO_BYTES = 1 * MiB;
constexpr int N_PHASES = 2 + 4 * DEPTH;
constexpr float QSCALE = 0.10206207261596577f * 1.4426950408889634f;

struct Args { const float* in[14]; float* out; unsigned char* ws; int ph_lo, ph_hi; int fastmask, pad; };
struct Frame { LAS unsigned char* lds; int tid, lane, wave, G, bx; unsigned char* ws; };
typedef const __attribute__((address_space(4))) Args* kargs_t;
__device__ __forceinline__ kargs_t kargs() { kargs_t p = (kargs_t)__builtin_amdgcn_kernarg_segment_ptr(); asm volatile("" : "+s"(p)); return p; }
#define IN_X(a) ((a)->in[0])
#define IN_NORMW(a) ((a)->in[1])
#define IN_WIN(a) ((a)->in[2])
#define IN_QNORM(a) ((a)->in[3])
#define IN_WUQ(a) ((a)->in[4])
#define IN_KVNORM(a) ((a)->in[5])
#define IN_WUKV(a) ((a)->in[6])
#define IN_CONVW(a) ((a)->in[7])
#define IN_ALOG(a) ((a)->in[8])
#define IN_DTB(a) ((a)->in[9])
#define IN_GNORM(a) ((a)->in[10])
#define IN_WOUT(a) ((a)->in[11])
#define IN_T5(a) ((a)->in[12])
#define IN_FNORM(a) ((a)->in[13])
#define W_TBL(ws) ((float*)((ws) + WS_TBL))
#define W_KM(ws) ((float*)((ws) + WS_KMEAN))
#define W_SSQ(ws) ((float*)((ws) + WS_SSQ))
#define W_COS(ws) ((float*)((ws) + WS_COS))
#define W_SIN(ws) ((float*)((ws) + WS_SIN))
#define W_WIN(ws) ((bf16_t*)((ws) + WS_WIN))
#define W_WOUT(ws) ((bf16_t*)((ws) + WS_WOUT))
#define W_WUQ(ws) ((bf16_t*)((ws) + WS_WUQ))
#define W_WUKV(ws) ((bf16_t*)((ws) + WS_WUKV))
#define W_Q(ws) ((bf16_t*)((ws) + WS_Q))
#define W_K(ws) ((bf16_t*)((ws) + WS_K))
#define W_V(ws) ((bf16_t*)((ws) + WS_V))
#define W_PROJ(ws) ((bf16_t*)((ws) + WS_PROJ))
#define W_XB(ws) ((bf16_t*)((ws) + WS_XB))
#define W_Y(ws) ((bf16_t*)((ws) + WS_PROJ) + C_GQ)
constexpr int LDY = PROJ_LD;

__device__ __forceinline__ Frame opaque(const Frame& F) { Frame G = F; asm volatile("" : "+v"(G.tid)); G.lane = G.tid & 63; return G; }
__device__ __forceinline__ void tr_item(const float* W, int K, int N, int NP, const float* sc, bf16_t* WT, int mode, LAS float* scr, int item, int lane) {
    const int nblk = NP / 32, kb = item / nblk, nb = item % nblk, k0 = 64 * kb, n0 = 32 * nb;
    int n = n0 + (lane & 31); const bool valid = n < N;
    if (mode == 1) { const int nn = n & 255, hd = nn >> 6, c = nn & 63; n = hd * 128 + c + ((n >= 256) ? 64 : 0); }
#pragma unroll 8
    for (int i = 0; i < 32; ++i) { const int kk = 2 * i + (lane >> 5); float v = 0.f; if (valid) { v = W[(size_t)(k0 + kk) * N + n]; if (sc) v *= sc[k0 + kk]; } scr[kk * 33 + (lane & 31)] = v; }
    LDS_WAIT(); asm volatile("" ::: "memory");
    const int c = lane & 7;
#pragma unroll
    for (int j = 0; j < 4; ++j) { const int nn = (lane >> 3) + 8 * j; const LAS float* s = scr + (8 * c) * 33 + nn;
        u32x4 o; o.x = cvtpk(s[0 * 33], s[1 * 33]); o.y = cvtpk(s[2 * 33], s[3 * 33]); o.z = cvtpk(s[4 * 33], s[5 * 33]); o.w = cvtpk(s[6 * 33], s[7 * 33]);
        *(u32x4*)(WT + (size_t)(n0 + nn) * K + k0 + 8 * c) = o; }
    LDS_WAIT(); asm volatile("" ::: "memory");
}
__device__ __forceinline__ void convert_weights(const Frame& F0, kargs_t A, int l, int which) {
    const Frame F = opaque(F0);
    LAS float* scr = (LAS float*)(F.lds + F.wave * 16384);
    const int gw = F.bx * NWAVES + F.wave, NGW = F.G * NWAVES;
    constexpr int I_IN = 16 * 120, I_UQ = 4 * 16, I_UKV = 2 * 16, I_OUT = 16 * 32;
    if (which & 1) for (int it = gw; it < I_IN + I_UQ + I_UKV; it += NGW) {
        int r = it;
        if (r < I_IN) { tr_item(IN_WIN(A) + (size_t)l * 1024 * IN_COLS, 1024, IN_COLS, 3840, IN_NORMW(A) + l * 1024, W_WIN(F.ws), 0, scr, r, F.lane); continue; } r -= I_IN;
        if (r < I_UQ) { tr_item(IN_WUQ(A) + (size_t)l * 256 * 384, 256, 384, 512, IN_QNORM(A) + l * 256, W_WUQ(F.ws), 0, scr, r, F.lane); continue; } r -= I_UQ;
        tr_item(IN_WUKV(A) + (size_t)l * 128 * 512, 128, 512, 512, IN_KVNORM(A) + l * 128, W_WUKV(F.ws), 1, scr, r, F.lane);
    }
    if (which & 2) for (int it = gw; it < I_OUT; it += NGW) tr_item(IN_WOUT(A) + (size_t)l * 1024 * 1024, 1024, 1024, 1024, nullptr, W_WOUT(F.ws), 0, scr, it, F.lane);
}
__device__ __forceinline__ float rope_inv(int j) {
    unsigned b = 0x3f800000u;
    b = (j == 1) ? 0x3f0ff59au : b;
    b = (j == 2) ? 0x3ea1e89bu : b;
    b = (j == 3) ? 0x3e361887u : b;
    b = (j == 4) ? 0x3dcccccdu : b;
    b = (j == 5) ? 0x3d6655c2u : b;
    b = (j == 6) ? 0x3d0186e3u : b;
    b = (j == 7) ? 0x3c91ad39u : b;
    b = (j == 8) ? 0x3c23d70au : b;
    b = (j == 9) ? 0x3bb8449cu : b;
    b = (j == 10) ? 0x3b4f3e38u : b;
    b = (j == 11) ? 0x3ae91528u : b;
    b = (j == 12) ? 0x3a83126fu : b;
    b = (j == 13) ? 0x3a136a16u : b;
    b = (j == 14) ? 0x39a5cb60u : b;
    b = (j == 15) ? 0x393a7753u : b;
    return __builtin_bit_cast(float, b);
}
__device__ __forceinline__ void p0_prologue(const Frame& F0, kargs_t A) {
    const Frame F = opaque(F0);
    const int gt = F.bx * NTHREADS + F.tid, NGT = F.G * NTHREADS;
    float* TBL = W_TBL(F.ws); float* COS = W_COS(F.ws); float* SIN = W_SIN(F.ws);
    for (int i = gt; i < SEQ * 16; i += NGT) {
        if (i < 4 * 2048) { const int h = i >> 11, rel = i & 2047; int b;
            if (rel < 16) b = rel; else { b = 16 + (int)(__logf((float)rel * 0.0625f) * (16.f / 4.852030263919617f)); if (b > 31) b = 31; }
            TBL[i] = IN_T5(A)[b * 4 + h]; }
        const int pos = i >> 4, j = i & 15;
        const float inv = rope_inv(j); const float ang = (float)pos * inv;
        const float k = __builtin_rintf(ang * 0.636619772f);
        float r = __builtin_fmaf(-k, 1.5703125f, ang); r = __builtin_fmaf(-k, 4.837512969970703125e-4f, r); r = __builtin_fmaf(-k, 7.54978995489188e-8f, r);
        const float r2 = r * r;
        float sp = 2.7557319e-06f; sp = __builtin_fmaf(sp, r2, -1.9841270e-04f); sp = __builtin_fmaf(sp, r2, 8.3333333e-03f); sp = __builtin_fmaf(sp, r2, -1.6666667e-01f); sp = __builtin_fmaf(sp * r2, r, r);
        float cp = 2.4801587e-05f; cp = __builtin_fmaf(cp, r2, -1.3888889e-03f); cp = __builtin_fmaf(cp, r2, 4.1666667e-02f); cp = __builtin_fmaf(cp, r2, -0.5f); cp = __builtin_fmaf(cp, r2, 1.0f);
        const int q = (int)k & 3; const float sf = sp, cf = cp;
        COS[i] = (q == 0) ? cf : (q == 1) ? -sf : (q == 2) ? -cf : sf;
        SIN[i] = (q == 0) ? sf : (q == 1) ? cf : (q == 2) ? -sf : -cf;
    }
    convert_weights(F0, A, 0, 3);
    const int gw = F.bx * NWAVES + F.wave, NGW = F.G * NWAVES;
    bf16_t* XB = W_XB(F.ws); float* SSQ = W_SSQ(F.ws);
    for (int row = gw; row < M_TOK; row += NGW) {
        const f32x4* xr = (const f32x4*)(IN_X(A) + (size_t)row * D_MODEL) + F.lane; float s = 0.f;
#pragma unroll
        for (int j = 0; j < 4; ++j) { const f32x4 v = xr[64 * j]; s += (v[0] * v[0] + v[1] * v[1]) + (v[2] * v[2] + v[3] * v[3]);
            u32x2 w; w.x = cvtpk(v[0], v[1]); w.y = cvtpk(v[2], v[3]); *((u32x2*)(XB + (size_t)row * D_MODEL) + F.lane + 64 * j) = w; }
        s = wave_sum(s); if (F.lane == 0) *(f32x4*)(SSQ + (size_t)row * 4) = (f32x4){s, 0.f, 0.f, 0.f};
    }
}
__device__ __forceinline__ void pb_prepass(const Frame& F0, int pm, bool do_kpe) {
    const Frame F = opaque(F0);
    const bf16_t* PROJ = W_PROJ(F.ws); bf16_t* Kb = W_K(F.ws); const float* COS = W_COS(F.ws); const float* SIN = W_SIN(F.ws);
    LAS float* RS = (LAS float*)(F.lds + LDS_RS);
    for (int i = 0; i < 32; ++i) { const int rl = F.wave * 32 + i, row = pm * 256 + rl; const bf16_t* p = PROJ + (size_t)row * PROJ_LD;
        const u32x2 a = *(const u32x2*)(p + C_MCQ + 4 * F.lane); const unsigned b = *(const unsigned*)(p + C_MCKV + 2 * F.lane);
        const float a0 = bf2f((bf16_t)(a.x & 0xffff)), a1 = bf2f((bf16_t)(a.x >> 16)), a2 = bf2f((bf16_t)(a.y & 0xffff)), a3 = bf2f((bf16_t)(a.y >> 16)), b0 = bf2f((bf16_t)(b & 0xffff)), b1 = bf2f((bf16_t)(b >> 16));
        const float s1 = wave_sum((a0 * a0 + a1 * a1) + (a2 * a2 + a3 * a3)), s2 = wave_sum(b0 * b0 + b1 * b1);
        if (F.lane == 0) { RS[rl * 2] = rsqrtf(s1 * (1.f / 256.f) + RMS_EPS); RS[rl * 2 + 1] = rsqrtf(s2 * (1.f / 128.f) + RMS_EPS); }
        if (do_kpe && F.lane < 16) { const int pos = row & (SEQ - 1); const float c = COS[pos * 16 + F.lane], sg = SIN[pos * 16 + F.lane];
            const float x1 = bf2f(p[C_MKR + F.lane]), x2 = bf2f(p[C_MKR + 16 + F.lane]); const bf16_t r1 = (bf16_t)f2bf(x1 * c - x2 * sg), r2 = (bf16_t)f2bf(x1 * sg + x2 * c);
#pragma unroll
            for (int h = 0; h < 4; ++h) { Kb[(size_t)row * K_LD + 96 * h + 64 + F.lane] = r1; Kb[(size_t)row * K_LD + 96 * h + 80 + F.lane] = r2; } }
    }
}
__device__ __forceinline__ void final_norm(const Frame& F0, float* out, const float* fnorm) {
    const Frame F = opaque(F0);
    const int gw = F.bx * NWAVES + F.wave, NGW = F.G * NWAVES;
    for (int row = gw; row < M_TOK; row += NGW) { f32x4* xr = (f32x4*)(out + (size_t)row * D_MODEL) + F.lane; f32x4 v[4]; float s = 0.f;
#pragma unroll
        for (int j = 0; j < 4; ++j) { v[j] = xr[64 * j]; s += (v[j][0] * v[j][0] + v[j][1] * v[j][1]) + (v[j][2] * v[j][2] + v[j][3] * v[j][3]); }
        const float rs = rsqrtf(wave_sum(s) * (1.f / D_MODEL) + RMS_EPS);
#pragma unroll
        for (int j = 0; j < 4; ++j) { const f32x4 w = *((const f32x4*)fnorm + F.lane + 64 * j); xr[64 * j] = v[j] * rs * w; }
    }
}

namespace att {
typedef short v4i16_t __attribute__((ext_vector_type(4)));
constexpr int A_K = 0, A_KSLOT = 12288, A_V = 24576, A_VSLOT = 8192, A_WS = 40960, A_OST = 43008, A_OSTW = 8704  , A_KM = 112640, A_TB = 120832;
static_assert(A_OST + 8 * A_OSTW <= A_KM && A_TB + 8192 <= RING_BYTES, "attention LDS map");
__device__ __forceinline__ int crow(int r, int hi) { return (r & 3) + 8 * (r >> 2) + 4 * hi; }
__device__ __forceinline__ float other_half(float v) { return __shfl_xor(v, 32); }
__device__ __forceinline__ int other_half_i(int v) { return __shfl_xor(v, 32); }

template <int MODE>
__device__ __forceinline__ void attn_unit(const Frame& F0, int b, int h, int qb) {
    constexpr int DQ = MODE == 0 ? 96 : 64, ND0 = DQ / 16, NCH = DQ / 8;
    Frame F = F0; asm volatile("" : "+v"(F.tid)); F.lane = F.tid & 63;
    const int lane = F.lane, wid = F.wave, r32 = lane & 31, hi = lane >> 5;
    unsigned char* ws = F.ws; LAS unsigned char* lds = F.lds;
    const bf16_t* PROJ = W_PROJ(ws);
    const int ldq = MODE == 0 ? Q_LD : PROJ_LD, ldk = MODE == 0 ? K_LD : PROJ_LD, ldv = MODE == 0 ? V_LD : PROJ_LD;
    const size_t rowbase = (size_t)b * SEQ; const int q0 = qb * 256;
    const bf16_t* Qh = (MODE == 0 ? W_Q(ws) + 96 * h : PROJ + C_CQ + 64 * h) + rowbase * ldq;
    const bf16_t* Kh = (MODE == 0 ? W_K(ws) + 96 * h : PROJ + C_CK + 64 * h) + rowbase * ldk;
    const bf16_t* Vh = (MODE == 0 ? W_V(ws) + 64 * h : PROJ + C_CV + 64 * h) + rowbase * ldv;
    const int qpos = q0 + wid * 32 + r32;
    LAS float* wsf = (LAS float*)(lds + A_WS) + wid * 64;
    bf16x8 qr[ND0];
#pragma unroll
    for (int d0 = 0; d0 < ND0; ++d0) qr[d0] = *(const bf16x8*)(Qh + (size_t)qpos * ldq + d0 * 16 + hi * 8);
    unsigned selmask = 0xffffffffu, umask = 0u; const int own = qb;
    if (MODE == 1) {
        LAS float* kml = (LAS float*)(lds + A_KM); LAS float* tbl = (LAS float*)(lds + A_TB); LAS unsigned* um = (LAS unsigned*)(lds + LDS_MISC + 64);
        const float* km = W_KM(ws) + (size_t)(b * 4 + h) * 32 * 64; const float* tb = W_TBL(ws) + h * 2048;
        { const f32x4 a = *(const f32x4*)(km + F.tid * 4); *(LAS f32x4*)(kml + F.tid * 4) = a; const f32x4 t4 = *(const f32x4*)(tb + F.tid * 4) * 1.4426950408889634f; *(LAS f32x4*)(tbl + F.tid * 4) = t4; }
        if (F.tid == 0) *um = 0u;
        float qf[64];
#pragma unroll
        for (int c = 0; c < 8; ++c) { const bf16x8 v = *(const bf16x8*)(Qh + (size_t)qpos * ldq + c * 8);
#pragma unroll
            for (int j = 0; j < 8; ++j) qf[c * 8 + j] = bf2f((bf16_t)v[j]); }
        LDS_WAIT(); __syncthreads();
        float g0 = -INFINITY, g1 = -INFINITY, g2 = -INFINITY; int s0 = 64, s1 = 64, s2 = 64;
        for (int n = hi; n < own; n += 2) { const LAS f32x4* kp = (const LAS f32x4*)(kml + n * 64); float g = 0.f;
#pragma unroll
            for (int c = 0; c < 16; ++c) { const f32x4 k4 = kp[c]; g += qf[4 * c] * k4[0]; g += qf[4 * c + 1] * k4[1]; g += qf[4 * c + 2] * k4[2]; g += qf[4 * c + 3] * k4[3]; }
            if (g > g0) { g2 = g1; s2 = s1; g1 = g0; s1 = s0; g0 = g; s0 = n; } else if (g > g1) { g2 = g1; s2 = s1; g1 = g; s1 = n; } else if (g > g2) { g2 = g; s2 = n; } }
        const float h0 = other_half(g0), h1 = other_half(g1), h2 = other_half(g2); const int t0 = other_half_i(s0), t1 = other_half_i(s1), t2 = other_half_i(s2);
#define ATT_INS(gg, ss) do { const float g_ = (gg); const int s_ = (ss); \
            if (g_ > g0 || (g_ == g0 && s_ < s0)) { g2 = g1; s2 = s1; g1 = g0; s1 = s0; g0 = g_; s0 = s_; } \
            else if (g_ > g1 || (g_ == g1 && s_ < s1)) { g2 = g1; s2 = s1; g1 = g_; s1 = s_; } \
            else if (g_ > g2 || (g_ == g2 && s_ < s2)) { g2 = g_; s2 = s_; } } while (0)
        ATT_INS(h0, t0); ATT_INS(h1, t1); ATT_INS(h2, t2);
#undef ATT_INS
        selmask = 1u << own; if (s0 < 32) selmask |= 1u << s0; if (s1 < 32) selmask |= 1u << s1; if (s2 < 32) selmask |= 1u << s2;
        (void)__hip_atomic_fetch_or(um, selmask, __ATOMIC_RELAXED, __HIP_MEMORY_SCOPE_WORKGROUP);
        LDS_WAIT(); __syncthreads();
        umask = __builtin_amdgcn_readfirstlane(*um);
    }
    const int NT = MODE == 0 ? 4 * (qb + 1) : 4 * __builtin_popcount(umask);
    auto dma = [&](int key0, int s) {
        const bf16_t* ks = Kh + (size_t)(key0 + lane) * ldk + wid * 8;
        __builtin_amdgcn_global_load_lds((const unsigned*)ks, (LAS unsigned*)(lds + A_K + s * A_KSLOT + wid * 1024), 16, 0, 0);
        if (NCH > 8 && wid < NCH - 8) __builtin_amdgcn_global_load_lds((const unsigned*)(ks + 64), (LAS unsigned*)(lds + A_K + s * A_KSLOT + (8 + wid) * 1024), 16, 0, 0);
        const bf16_t* vs = Vh + (size_t)(key0 + 16 * (wid & 3) + (lane >> 2)) * ldv + (wid >> 2) * 32 + (lane & 3) * 8;
        __builtin_amdgcn_global_load_lds((const unsigned*)vs, (LAS unsigned*)(lds + A_V + s * A_VSLOT + wid * 1024), 16, 0, 0);
    };
    unsigned rem = umask; int blk = 0, sub = 0;
    auto next_key0 = [&](int t) -> int { if (MODE == 0) return 64 * t; if (sub == 0) { blk = __builtin_ctz(rem); rem &= rem - 1; } const int k0 = blk * 256 + sub * 64; sub = (sub + 1) & 3; return k0; };
    int key_cur = next_key0(0);
    dma(key_cur, 0);
    float m = -1e20f, l = 0.f; f32x16 o[2]; o[0] = f32x16{}; o[1] = f32x16{};
    VM_WAIT(); __syncthreads();
    for (int t = 0; t < NT; ++t) {
        const int s = t & 1; int key_nxt = 0;
        if (t + 1 < NT) { key_nxt = next_key0(t + 1); dma(key_nxt, s ^ 1); }
        const int key0 = key_cur; key_cur = key_nxt;
        bool act = true;
        if (MODE == 0) act = key0 <= q0 + wid * 32 + 31;
        else { const int n = key0 >> 8; act = __builtin_amdgcn_readfirstlane(__any((selmask >> n) & 1u)) != 0; if (n == own) act = act && (key0 <= q0 + wid * 32 + 31); }
        if (act) {
            f32x16 p0 = f32x16{}, p1 = f32x16{};
            const LAS unsigned char* kb = lds + A_K + s * A_KSLOT + hi * 1024 + r32 * 16;
#pragma unroll
            for (int d0 = 0; d0 < ND0; ++d0) { const bf16x8 k0 = *(const LAS bf16x8*)(kb + d0 * 2048), k1 = *(const LAS bf16x8*)(kb + d0 * 2048 + 512);
                p0 = __builtin_amdgcn_mfma_f32_32x32x16_bf16(k0, qr[d0], p0, 0, 0, 0); p1 = __builtin_amdgcn_mfma_f32_32x32x16_bf16(k1, qr[d0], p1, 0, 0, 0); }
            if (MODE == 0) {
                if (key0 + 63 > q0 + wid * 32) {
#pragma unroll
                    for (int r = 0; r < 16; ++r) { const int kv = key0 + crow(r, hi); if (kv > qpos) p0[r] = -1e30f; if (kv + 32 > qpos) p1[r] = -1e30f; }
                }
            } else {
                const LAS float* tbl = (const LAS float*)(lds + A_TB); const int n = key0 >> 8; const bool mine = (selmask >> n) & 1u; const float SC = 0.125f * 1.4426950408889634f;
                const int relb = qpos - key0 - 4 * hi;
                if (q0 + wid * 32 - key0 - 63 >= 2047) {
                    const float bz = tbl[2047];
#pragma unroll
                    for (int r = 0; r < 16; ++r) { p0[r] = mine ? __builtin_fmaf(p0[r], SC, bz) : -1e30f; p1[r] = mine ? __builtin_fmaf(p1[r], SC, bz) : -1e30f; }
                } else {
#pragma unroll
                    for (int r = 0; r < 16; ++r) { const int rel0 = relb - ((r & 3) + 8 * (r >> 2)), rel1 = rel0 - 32;
                        const float b0 = tbl[rel0 < 0 ? 0 : (rel0 > 2047 ? 2047 : rel0)], b1 = tbl[rel1 < 0 ? 0 : (rel1 > 2047 ? 2047 : rel1)];
                        p0[r] = (mine && rel0 >= 0) ? __builtin_fmaf(p0[r], SC, b0) : -1e30f; p1[r] = (mine && rel1 >= 0) ? __builtin_fmaf(p1[r], SC, b1) : -1e30f; }
                }
            }
            float rm = p0[0];
#pragma unroll
            for (int r = 1; r < 16; ++r) rm = fmaxf(rm, p0[r]);
#pragma unroll
            for (int r = 0; r < 16; ++r) rm = fmaxf(rm, p1[r]);
            rm = fmaxf(rm, other_half(rm));
            const float mn = fmaxf(m, rm), alpha = __builtin_amdgcn_exp2f(m - mn); m = mn;
            float rs = 0.f;
#pragma unroll
            for (int r = 0; r < 16; ++r) { p0[r] = __builtin_amdgcn_exp2f(p0[r] - mn); p1[r] = __builtin_amdgcn_exp2f(p1[r] - mn); rs += p0[r] + p1[r]; }
            l = l * alpha + rs;
            if (__any(alpha != 1.0f)) {
                if (hi == 0) wsf[r32] = alpha;
                LDS_WAIT(); asm volatile("" ::: "memory");
#pragma unroll
                for (int g = 0; g < 4; ++g) { const f32x4 a4 = *(const LAS f32x4*)(wsf + 8 * g + 4 * hi);
#pragma unroll
                    for (int j = 0; j < 4; ++j) { o[0][4 * g + j] *= a4[j]; o[1][4 * g + j] *= a4[j]; } }
            }
            u32x4 pw[4];
#pragma unroll
            for (int j = 0; j < 4; ++j) { pw[0][j] = cvtpk(p0[2 * j], p0[2 * j + 1]); pw[1][j] = cvtpk(p0[8 + 2 * j], p0[9 + 2 * j]); pw[2][j] = cvtpk(p1[2 * j], p1[2 * j + 1]); pw[3][j] = cvtpk(p1[8 + 2 * j], p1[9 + 2 * j]); }
            const LAS unsigned char* vp = lds + A_V + s * A_VSLOT + ((lane >> 4) & 1) * 32 + (lane & 3) * 8 + (4 * hi + ((lane & 15) >> 2)) * 64;
#pragma unroll
            for (int d0 = 0; d0 < 2; ++d0)
#pragma unroll
                for (int ks = 0; ks < 4; ++ks) {
                    const v4i16_t lo = __builtin_amdgcn_ds_read_tr16_b64_v4i16((LAS v4i16_t*)(vp + d0 * 4096 + ks * 1024)), hv = __builtin_amdgcn_ds_read_tr16_b64_v4i16((LAS v4i16_t*)(vp + d0 * 4096 + ks * 1024 + 512));
                    const bf16x8 vf = (bf16x8){lo[0], lo[1], lo[2], lo[3], hv[0], hv[1], hv[2], hv[3]};
                    o[d0] = __builtin_amdgcn_mfma_f32_32x32x16_bf16(__builtin_bit_cast(bf16x8, pw[ks]), vf, o[d0], 0, 0, 0);
                }
        }
        LDS_WAIT(); VM_WAIT(); __syncthreads();
    }
    l += other_half(l);
    if (hi == 0) wsf[r32] = 1.0f / l;
    LDS_WAIT(); asm volatile("" ::: "memory");
    LAS float* stg = (LAS float*)(lds + A_OST + wid * A_OSTW);
#pragma unroll
    for (int g = 0; g < 4; ++g) { const f32x4 a4 = *(const LAS f32x4*)(wsf + 8 * g + 4 * hi);
#pragma unroll
        for (int j = 0; j < 4; ++j) { const int r = 4 * g + j, orow = crow(r, hi); stg[orow * 68 + r32] = o[0][r] * a4[j]; stg[orow * 68 + 32 + r32] = o[1][r] * a4[j]; } }
    LDS_WAIT(); asm volatile("" ::: "memory");
    bf16_t* Y = W_Y(ws); const int ycol = (MODE == 0 ? 0 : 768) + 64 * h, gcol = (MODE == 0 ? C_MGATE : C_CGATE) + 64 * h;
#pragma unroll
    for (int i = 0; i < 4; ++i) { const int row = i * 8 + (lane >> 3), c8 = (lane & 7) * 8; const size_t grow = rowbase + q0 + wid * 32 + row;
        const f32x4 a = *(const LAS f32x4*)(stg + row * 68 + c8), c = *(const LAS f32x4*)(stg + row * 68 + c8 + 4);
        const bf16x8 gt = *(const bf16x8*)(PROJ + grow * PROJ_LD + gcol + c8);
        u32x4 w; w.x = cvtpk(a[0] * siluf(bf2f((bf16_t)gt[0])), a[1] * siluf(bf2f((bf16_t)gt[1]))); w.y = cvtpk(a[2] * siluf(bf2f((bf16_t)gt[2])), a[3] * siluf(bf2f((bf16_t)gt[3])));
        w.z = cvtpk(c[0] * siluf(bf2f((bf16_t)gt[4])), c[1] * siluf(bf2f((bf16_t)gt[5]))); w.w = cvtpk(c[2] * siluf(bf2f((bf16_t)gt[6])), c[3] * siluf(bf2f((bf16_t)gt[7])));
        *(u32x4*)(Y + grow * LDY + ycol + c8) = w; }
    LDS_WAIT(); __syncthreads();
}
}
namespace gdn {
constexpr int CH_BYTES = 73728, O_WN = 0, O_QG = 16384, O_KE = 32768, O_AQK = 49152, O_U0 = 57344;
constexpr int P_Q = 0, P_K = 17408, P_V = 34816, P_L = 52224, P_AQ = 69632, P_W = 78848, P_U0 = 96256, P_SC = 112640;
constexpr int QKV_LD = 136;
__device__ __forceinline__ int crow(int r, int hi) { return (r & 3) + 8 * (r >> 2) + 4 * hi; }

__device__ __forceinline__ void prep_chunk(const Frame& F0, int l, int b, int h, int n) {
    Frame F = F0; asm volatile("" : "+v"(F.tid)); F.lane = F.tid & 63;
    const int lane = F.lane, wid = F.wave, tid = F.tid, r32 = lane & 31, hi = lane >> 5;
    LAS unsigned char* lds = F.lds; unsigned char* ws = F.ws;
    const bf16_t* PROJ = W_PROJ(ws);
    const int t0 = n * 64; const size_t rowb = (size_t)b * SEQ;
    unsigned char* G = ws + WS_GDN + (size_t)((b * 4 + h) * 128 + n) * CH_BYTES;
    LAS float* SC = (LAS float*)(lds + P_SC);
    kargs_t ka = kargs();
    {
        const float* cw = IN_CONVW(ka) + (size_t)l * 4 * 1536 + h * 128 + 2 * lane;
        float w[3][4][2];
#pragma unroll
        for (int a = 0; a < 3; ++a)
#pragma unroll
            for (int j = 0; j < 4; ++j) { const f32x2 v = *(const f32x2*)(cw + j * 1536 + a * 512); w[a][j][0] = v[0]; w[a][j][1] = v[1]; }
        unsigned x[3][11];
#pragma unroll
        for (int rr = 0; rr < 11; ++rr) { const int t = t0 + 8 * wid - 3 + rr; const bf16_t* p = PROJ + (rowb + (t < 0 ? 0 : t)) * PROJ_LD + h * 128 + 2 * lane;
#pragma unroll
            for (int a = 0; a < 3; ++a) { const unsigned v = *(const unsigned*)(p + (a == 0 ? C_GQ : a == 1 ? C_GK : C_GV)); x[a][rr] = (t < 0) ? 0u : v; } }
#pragma unroll
        for (int i = 0; i < 8; ++i) { float r0[3], r1[3];
#pragma unroll
            for (int a = 0; a < 3; ++a) { float s0 = 0.f, s1 = 0.f;
#pragma unroll
                for (int j = 0; j < 4; ++j) { const unsigned v = x[a][i + j]; s0 += w[a][j][0] * bf2f((bf16_t)(v & 0xffff)); s1 += w[a][j][1] * bf2f((bf16_t)(v >> 16)); }
                r0[a] = siluf(s0); r1[a] = siluf(s1); }
            const float nq = rsqrtf(wave_sum(r0[0] * r0[0] + r1[0] * r1[0]) + 1e-6f) * 0.08838834764831845f, nk = rsqrtf(wave_sum(r0[1] * r0[1] + r1[1] * r1[1]) + 1e-6f);
            const int row = 8 * wid + i;
            *(LAS unsigned*)(lds + P_Q + row * 272 + 4 * lane) = cvtpk(r0[0] * nq, r1[0] * nq);
            *(LAS unsigned*)(lds + P_K + row * 272 + 4 * lane) = cvtpk(r0[1] * nk, r1[1] * nk);
            *(LAS unsigned*)(lds + P_V + row * 272 + 4 * lane) = cvtpk(r0[2], r1[2]); }
    }
    if (wid == 0) {
        const bf16_t* p = PROJ + (rowb + t0 + lane) * PROJ_LD;
        const float bb = bf2f(p[C_GB + h]), aa = bf2f(p[C_GA + h]) + IN_DTB(ka)[l * 4 + h];
        const float beta = 1.f / (1.f + __expf(-bb)), sp = (aa > 20.f) ? aa : __logf(1.f + __expf(aa));
        float g = -__expf(IN_ALOG(ka)[l * 4 + h]) * sp;
#pragma unroll
        for (int o = 1; o < 64; o <<= 1) { const float v = __shfl_up(g, o); if (lane >= o) g += v; }
        const float gl = __shfl(g, 63);
        SC[lane] = g; SC[64 + lane] = beta; SC[128 + lane] = __expf(g); SC[192 + lane] = __expf(gl - g);
        if (lane == 63) ((float*)(ws + WS_GEND))[(b * 4 + h) * 128 + n] = __expf(gl);
    }
    LDS_WAIT(); __syncthreads();
    {
        const int which = wid >> 2, ti = (wid >> 1) & 1, tj = wid & 1;
        f32x16 acc = f32x16{};
        if (ti >= tj) {
            const LAS unsigned char* ap = lds + (which ? P_Q : P_K) + (32 * ti + r32) * 272 + hi * 16; const LAS unsigned char* bp = lds + P_K + (32 * tj + r32) * 272 + hi * 16;
#pragma unroll
            for (int ks = 0; ks < 8; ++ks) acc = __builtin_amdgcn_mfma_f32_32x32x16_bf16(*(const LAS bf16x8*)(ap + ks * 32), *(const LAS bf16x8*)(bp + ks * 32), acc, 0, 0, 0);
        }
        const int j = 32 * tj + r32; const float gj = SC[j];
#pragma unroll
        for (int r = 0; r < 16; ++r) { const int i = 32 * ti + crow(r, hi); const float d = __expf(i >= j ? SC[i] - gj : 0.f);
            if (which == 0) *(LAS float*)(lds + P_L + (i * 68 + j) * 4) = (i > j) ? SC[64 + i] * acc[r] * d : 0.f;
            else *(LAS bf16_t*)(lds + P_AQ + (i * 72 + j) * 2) = (bf16_t)f2bf((i >= j) ? acc[r] * d : 0.f); }
    }
    LDS_WAIT(); __syncthreads();
    if (wid < 4) {
        const int c = 64 * wid + lane; const bool isw = c < 128;
        const LAS unsigned char* src = lds + (isw ? P_K + 2 * c : P_V + 2 * (c - 128));
        float x[64];
#pragma unroll
        for (int i = 0; i < 64; ++i) {
            const float egi = SC[128 + i]; float a0 = bf2f(*(const LAS bf16_t*)(src + i * 272)) * SC[64 + i] * (isw ? egi : 1.f), a1 = 0.f;
            const LAS f32x4* Lr = (const LAS f32x4*)(lds + P_L + i * 272);
#pragma unroll
            for (int jc = 0; jc < (i + 3) / 4; ++jc) { const f32x4 L4 = Lr[jc];
#pragma unroll
                for (int jj = 0; jj < 4; ++jj) { const int j = 4 * jc + jj; if (j < i) { if (j & 1) a1 -= L4[jj] * x[j]; else a0 -= L4[jj] * x[j]; } } }
            { float xi = a0 + a1; asm volatile("" : "+v"(xi) :: "memory"); x[i] = xi; }
        }
        if (isw) {
#pragma unroll
            for (int i = 0; i < 64; ++i) *(LAS bf16_t*)(lds + P_W + i * 272 + 2 * c) = (bf16_t)f2bf(-x[i]);
        } else {
            const int dv = c - 128; LAS bf16_t* up = (LAS bf16_t*)(lds + P_U0) + (size_t)((dv >> 5) * 2) * 1024 + (dv & 31) * 16;
#pragma unroll
            for (int i = 0; i < 64; ++i) { const int mt = i >> 5, ii = i & 31, hh = (ii >> 2) & 1, r = (ii & 3) | ((ii >> 3) << 2); up[mt * 1024 + hh * 512 + r] = (bf16_t)f2bf(x[i]); }
        }
    } else {
        const int t4 = tid - 256;
#pragma unroll
        for (int it = 0; it < 4; ++it) {
            const int p = it * 256 + t4, f = p >> 6, ln = p & 63, mt = f & 1, s = (f >> 1) & 1, kt = f >> 2, hh = ln >> 5, r = ln & 31, row = 32 * mt + r, k0 = 32 * kt + 16 * s + 4 * hh;
            const u32x2 a = *(const LAS u32x2*)(lds + P_Q + row * 272 + k0 * 2), c2 = *(const LAS u32x2*)(lds + P_Q + row * 272 + k0 * 2 + 16); const float e = SC[128 + row];
            u32x4 o; o.x = cvtpk(bf2f((bf16_t)(a.x & 0xffff)) * e, bf2f((bf16_t)(a.x >> 16)) * e); o.y = cvtpk(bf2f((bf16_t)(a.y & 0xffff)) * e, bf2f((bf16_t)(a.y >> 16)) * e);
            o.z = cvtpk(bf2f((bf16_t)(c2.x & 0xffff)) * e, bf2f((bf16_t)(c2.x >> 16)) * e); o.w = cvtpk(bf2f((bf16_t)(c2.y & 0xffff)) * e, bf2f((bf16_t)(c2.y >> 16)) * e);
            *(u32x4*)(G + O_QG + p * 16) = o; }
#pragma unroll
        for (int it = 0; it < 4; ++it) {
            const int p = it * 256 + t4, f = p >> 6, ln = p & 63, mt = f & 3, s = (f >> 2) & 1, kt = f >> 3, hh = ln >> 5, r = ln & 31, dk = 32 * mt + r, p0 = 32 * kt + 16 * s + 4 * hh;
            float v[8];
#pragma unroll
            for (int j = 0; j < 8; ++j) { const int pos = p0 + 8 * (j >> 2) + (j & 3); v[j] = bf2f(*(const LAS bf16_t*)(lds + P_K + pos * 272 + dk * 2)) * SC[192 + pos]; }
            u32x4 o; o.x = cvtpk(v[0], v[1]); o.y = cvtpk(v[2], v[3]); o.z = cvtpk(v[4], v[5]); o.w = cvtpk(v[6], v[7]);
            *(u32x4*)(G + O_KE + p * 16) = o; }
    }
    LDS_WAIT(); __syncthreads();
#pragma unroll
    for (int it = 0; it < 2; ++it) {
        const int p = it * 512 + tid, f = p >> 6, ln = p & 63, mt = f & 1, s = (f >> 1) & 1, kt = f >> 2, hh = ln >> 5, r = ln & 31, row = 32 * mt + r, k0 = 32 * kt + 16 * s + 4 * hh;
        const u32x2 a = *(const LAS u32x2*)(lds + P_W + row * 272 + k0 * 2), c2 = *(const LAS u32x2*)(lds + P_W + row * 272 + k0 * 2 + 16);
        *(u32x4*)(G + O_WN + p * 16) = (u32x4){a.x, a.y, c2.x, c2.y}; }
    {
        const int p = tid, f = p >> 6, ln = p & 63, mt = f & 1, s = (f >> 1) & 1, kt = f >> 2, hh = ln >> 5, r = ln & 31, row = 32 * mt + r, k0 = 32 * kt + 16 * s + 4 * hh;
        const u32x2 a = *(const LAS u32x2*)(lds + P_AQ + row * 144 + k0 * 2), c2 = *(const LAS u32x2*)(lds + P_AQ + row * 144 + k0 * 2 + 16);
        *(u32x4*)(G + O_AQK + p * 16) = (u32x4){a.x, a.y, c2.x, c2.y}; }
#pragma unroll
    for (int it = 0; it < 2; ++it) { const int p = it * 512 + tid; *(u32x4*)(G + O_U0 + p * 16) = *(const LAS u32x4*)(lds + P_U0 + p * 16); }
    LDS_WAIT(); __syncthreads();
}

__device__ __forceinline__ void kmean_item(const Frame& F0, int item) {
    Frame F = F0; asm volatile("" : "+v"(F.tid));
    const int tid = F.tid, n = item & 31, h = (item >> 5) & 3, b = item >> 7, rg = tid >> 3, c8 = (tid & 7) * 8;
    const bf16_t* p = W_PROJ(F.ws) + ((size_t)b * SEQ + n * 256 + rg * 4) * PROJ_LD + C_CK + 64 * h + c8;
    float s[8] = {0.f, 0.f, 0.f, 0.f, 0.f, 0.f, 0.f, 0.f};
#pragma unroll
    for (int i = 0; i < 4; ++i) { const bf16x8 v = *(const bf16x8*)(p + (size_t)i * PROJ_LD);
#pragma unroll
        for (int j = 0; j < 8; ++j) s[j] += bf2f((bf16_t)v[j]); }
    LAS float* part = (LAS float*)F.lds;
#pragma unroll
    for (int j = 0; j < 8; ++j) part[rg * 64 + c8 + j] = s[j];
    LDS_WAIT(); __syncthreads();
    if (tid < 64) { float a = 0.f;
#pragma unroll 8
        for (int g = 0; g < 64; ++g) a += part[g * 64 + tid];
        W_KM(F.ws)[(size_t)item * 64 + tid] = a * (1.f / 256.f); }
    LDS_WAIT(); __syncthreads();
}
}
namespace gdn {
constexpr int S_BUFSZ = 57344, S_OST = 2 * S_BUFSZ, S_OSTSZ = 17408;
static_assert(S_OST + 2 * S_OSTSZ <= LDS_MISC, "scan LDS map");
__device__ __forceinline__ bf16x8 pack8(const f32x16& v, int s) {
    u32x4 w; w.x = cvtpk(v[8 * s], v[8 * s + 1]); w.y = cvtpk(v[8 * s + 2], v[8 * s + 3]); w.z = cvtpk(v[8 * s + 4], v[8 * s + 5]); w.w = cvtpk(v[8 * s + 6], v[8 * s + 7]);
    return __builtin_bit_cast(bf16x8, w);
}
__device__ __forceinline__ void scan_load_z(u32x4 (&z)[4], const bf16_t* PROJ, size_t grow0, int hw, int lane, int h) {
    const u32x4* p = (const u32x4*)(PROJ + (grow0 + 16 * hw + (lane >> 2)) * PROJ_LD + C_GZ + 128 * h + 32 * (lane & 3));
#pragma unroll
    for (int i = 0; i < 4; ++i) z[i] = p[i];
}
__device__ __forceinline__ void scan_out_rows(u32x4 (&yv)[4], const LAS unsigned char* op, const u32x4 (&z)[4], int hw, int lane, const float (&nw)[32]) {
    const LAS u32x4* o4 = (const LAS u32x4*)(op + (16 * hw + (lane >> 2)) * 272 + 64 * (lane & 3));
    float o[32]; float ss = 0.f;
#pragma unroll
    for (int i = 0; i < 4; ++i) { const u32x4 v = o4[i];
#pragma unroll
        for (int j = 0; j < 4; ++j) { o[8 * i + 2 * j] = bf2f((bf16_t)(v[j] & 0xffff)); o[8 * i + 2 * j + 1] = bf2f((bf16_t)(v[j] >> 16)); } }
#pragma unroll
    for (int i = 0; i < 32; ++i) ss += o[i] * o[i];
    ss += __shfl_xor(ss, 1); ss += __shfl_xor(ss, 2);
    const float rs = rsqrtf(ss * (1.f / 128.f) + RMS_EPS);
#pragma unroll
    for (int i = 0; i < 4; ++i)
#pragma unroll
        for (int j = 0; j < 4; ++j) { const unsigned zz = z[i][j]; const int c = 8 * i + 2 * j;
            yv[i][j] = cvtpk(o[c] * rs * nw[c] * siluf(bf2f((bf16_t)(zz & 0xffff))), o[c + 1] * rs * nw[c + 1] * siluf(bf2f((bf16_t)(zz >> 16)))); }
}
__device__ __forceinline__ void scan_store_y(const u32x4 (&yv)[4], bf16_t* Y, size_t grow0, int hw, int lane, int h) {
    u32x4* p = (u32x4*)(Y + (grow0 + 16 * hw + (lane >> 2)) * LDY + 256 + 128 * h + 32 * (lane & 3));
#pragma unroll
    for (int i = 0; i < 4; ++i) p[i] = yv[i];
}
__device__ __forceinline__ void scan_chain(const Frame& F0, int l, int bh, int var = 0) {
    Frame F = F0; asm volatile("" : "+v"(F.tid)); F.lane = F.tid & 63;
    const int lane = F.lane, wid = F.wave, r32 = lane & 31, hi = lane >> 5, b = bh >> 2, h = bh & 3;
    LAS unsigned char* lds = F.lds; unsigned char* ws = F.ws;
    const unsigned char* Gb = ws + WS_GDN + (size_t)(bh * 128) * CH_BYTES;
    if (wid >= 4) {
        const int hw = wid - 4; const bf16_t* PROJ = W_PROJ(ws); bf16_t* Y = W_Y(ws); const size_t rb = (size_t)b * SEQ;
        kargs_t ka = kargs(); float nw[32];
#pragma unroll
        for (int i = 0; i < 8; ++i) { const f32x4 v = *(const f32x4*)(IN_GNORM(ka) + l * 128 + 32 * (lane & 3) + 4 * i); nw[4 * i] = v[0]; nw[4 * i + 1] = v[1]; nw[4 * i + 2] = v[2]; nw[4 * i + 3] = v[3]; }
        for (int pc = hw; pc < 56; pc += 4) __builtin_amdgcn_global_load_lds((const unsigned*)(Gb + pc * 1024 + lane * 16), (LAS unsigned*)(lds + pc * 1024), 16, 0, 0);
        u32x4 zc[4], zn[4], yv[4];
        VM_WAIT(); __syncthreads();
        for (int n = 0; n < 128; ++n) {
            if (n + 1 < 128 && !(var & 1)) { const unsigned char* Gn = Gb + (size_t)(n + 1) * CH_BYTES; LAS unsigned char* dst = lds + ((n + 1) & 1) * S_BUFSZ;
                for (int pc = hw; pc < 56; pc += 4) __builtin_amdgcn_global_load_lds((const unsigned*)(Gn + pc * 1024 + lane * 16), (LAS unsigned*)(dst + pc * 1024), 16, 0, 0); }
            if (!(var & 2)) scan_load_z(zn, PROJ, rb + n * 64, hw, lane, h);
            if (n >= 1 && !(var & 2)) scan_out_rows(yv, lds + S_OST + ((n - 1) & 1) * S_OSTSZ, zc, hw, lane, nw);
            LDS_WAIT(); VM_WAIT();
            if (n >= 1 && !(var & 34)) scan_store_y(yv, Y, rb + (n - 1) * 64, hw, lane, h);
#pragma unroll
            for (int i = 0; i < 4; ++i) zc[i] = zn[i];
            __syncthreads();
        }
        scan_out_rows(yv, lds + S_OST + (127 & 1) * S_OSTSZ, zc, hw, lane, nw);
        if (!(var & 34)) scan_store_y(yv, Y, rb + 127 * 64, hw, lane, h);
    } else {
        const int w = wid; const float* GE = (const float*)(ws + WS_GEND) + bh * 128; const float ge_lo = GE[lane], ge_hi = GE[64 + lane];
        f32x16 S[4]; S[0] = f32x16{}; S[1] = f32x16{}; S[2] = f32x16{}; S[3] = f32x16{};
        u32x4 u0n[4];
#pragma unroll
        for (int mt = 0; mt < 2; ++mt) { const u32x4* p = (const u32x4*)(Gb + O_U0 + ((w * 2 + mt) * 64 + lane) * 32); u0n[2 * mt] = p[0]; u0n[2 * mt + 1] = p[1]; }
        VM_WAIT(); __syncthreads();
        for (int n = 0; n < 128; ++n) {
            LAS unsigned char* ost = lds + S_OST + (n & 1) * S_OSTSZ;
            const LAS unsigned char* B = lds + (n & 1) * S_BUFSZ + lane * 16;
            const float ge = __builtin_bit_cast(float, __builtin_amdgcn_readlane(__builtin_bit_cast(int, (n < 64) ? ge_lo : ge_hi), n & 63));
            f32x16 U[2], O[2];
#pragma unroll
            for (int mt = 0; mt < 2; ++mt)
#pragma unroll
                for (int q = 0; q < 4; ++q) { const unsigned v0 = u0n[2 * mt][q], v1 = u0n[2 * mt + 1][q];
                    U[mt][2 * q] = bf2f((bf16_t)(v0 & 0xffff)); U[mt][2 * q + 1] = bf2f((bf16_t)(v0 >> 16)); U[mt][8 + 2 * q] = bf2f((bf16_t)(v1 & 0xffff)); U[mt][9 + 2 * q] = bf2f((bf16_t)(v1 >> 16)); }
            if (n + 1 < 128 && !(var & 16)) {
#pragma unroll
                for (int mt = 0; mt < 2; ++mt) { const u32x4* p = (const u32x4*)(Gb + (size_t)(n + 1) * CH_BYTES + O_U0 + ((w * 2 + mt) * 64 + lane) * 32); u0n[2 * mt] = p[0]; u0n[2 * mt + 1] = p[1]; }
            }
            O[0] = f32x16{}; O[1] = f32x16{};
            if (!(var & 4)) {
#pragma unroll
            for (int kt = 0; kt < 4; ++kt)
#pragma unroll
                for (int s = 0; s < 2; ++s) { const bf16x8 sb = pack8(S[kt], s);
#pragma unroll
                    for (int mt = 0; mt < 2; ++mt) { const int f = (kt * 2 + s) * 2 + mt;
                        U[mt] = __builtin_amdgcn_mfma_f32_32x32x16_bf16(*(const LAS bf16x8*)(B + O_WN + f * 1024), sb, U[mt], 0, 0, 0);
                        O[mt] = __builtin_amdgcn_mfma_f32_32x32x16_bf16(*(const LAS bf16x8*)(B + O_QG + f * 1024), sb, O[mt], 0, 0, 0); }
                    asm volatile("" ::: "memory"); }
#pragma unroll
            for (int mt = 0; mt < 4; ++mt) S[mt] = S[mt] * ge;
#pragma unroll
            for (int kt = 0; kt < 2; ++kt)
#pragma unroll
                for (int s = 0; s < 2; ++s) { const bf16x8 ub = pack8(U[kt], s);
#pragma unroll
                    for (int mt = 0; mt < 2; ++mt) O[mt] = __builtin_amdgcn_mfma_f32_32x32x16_bf16(*(const LAS bf16x8*)(B + O_AQK + ((kt * 2 + s) * 2 + mt) * 1024), ub, O[mt], 0, 0, 0);
#pragma unroll
                    for (int mt = 0; mt < 4; ++mt) S[mt] = __builtin_amdgcn_mfma_f32_32x32x16_bf16(*(const LAS bf16x8*)(B + O_KE + ((kt * 2 + s) * 4 + mt) * 1024), ub, S[mt], 0, 0, 0);
                    asm volatile("" ::: "memory"); }
            }
            if (!(var & 8))
#pragma unroll
            for (int mt = 0; mt < 2; ++mt)
#pragma unroll
                for (int r = 0; r < 16; ++r) *(LAS bf16_t*)(ost + (32 * mt + crow(r, hi)) * 272 + (32 * w + r32) * 2) = (bf16_t)f2bf(O[mt][r]);
            LDS_WAIT(); __syncthreads();
        }
    }
    LDS_WAIT(); VM_WAIT(); __syncthreads();
}
}
#ifndef PROBE_XA
#define PROBE_XA 0
#endif
#ifndef PROBE_XB
#define PROBE_XB 0
#endif
#ifndef PROBE_XC
#define PROBE_XC 0
#endif
#ifndef PROBE_XD
#define PROBE_XD 0
#endif
#ifndef PROBE_PB_PARTS
#define PROBE_PB_PARTS 7
#endif
#ifndef PROBE_SCAN_VAR
#define PROBE_SCAN_VAR 0
#endif
#ifndef PROBE_PC_PARTS
#define PROBE_PC_PARTS 7
#endif
__global__ void __launch_bounds__(NTHREADS, 2) skel_fwd(Args args) {
    extern __shared__ __attribute__((aligned(16))) unsigned char lds_raw[];
    Frame F;
    F.lds = (LAS unsigned char*)lds_raw; F.tid = threadIdx.x; F.lane = F.tid & 63; F.wave = __builtin_amdgcn_readfirstlane(F.tid >> 6); F.G = gridDim.x; F.bx = blockIdx.x; F.ws = args.ws;
    unsigned char* ws = args.ws;
    unsigned* ctl = (unsigned*)(ws + WS_CTL);
    volatile LAS unsigned* MISC = (volatile LAS unsigned*)(F.lds + LDS_MISC);
    for (int u = F.tid; u < 64; u += NTHREADS) MISC[u] = 0u;
    __syncthreads();
    const int lo = args.ph_lo, hi = args.ph_hi;
    const bool multi = (hi - lo) > 1;
    XcdBarrier bar; bar.bar = ctl + CW_BAR + lo * XCD_BAR_WORDS; bar.x = 0; bar.st = nullptr;
    if (multi) bar = xcd_barrier_post(ctl + CW_BAR + lo * XCD_BAR_WORDS, MISC + 8);
    for (int ph = lo; ph < hi; ++ph) {
        if (ph == 0) {
            p0_prologue(F, kargs());
        } else if (ph == N_PHASES - 1) {
            { kargs_t ka = kargs(); final_norm(F, ka->out, IN_FNORM(ka)); }
        } else {
            const int l = (ph - 1) >> 2, sub = (ph - 1) & 3;
            const int nrep = 1 + (sub == 0 ? PROBE_XA : sub == 1 ? PROBE_XB : sub == 2 ? PROBE_XC : (l == 0 ? PROBE_XD : 0));
            for (int rep = 0; rep < nrep; ++rep) {
            if (rep) xcd_barrier(bar);
            if (sub == 0) {
                if (l > 0) { convert_weights(F, kargs(), l, 2); }
                VM_WAIT(); __syncthreads();
                pg8::Gemm g{W_XB(ws), W_WIN(ws), 1024, 1024, 1024}; pg8::StaticOrder S; S.init(M_TOK, 3840, F.G, F.bx);
                pg8::EpiProj E{W_PROJ(ws), W_SSQ(ws)};
                pg8::gemm_phase<pg8::EpiProj, pg8::StaticOrder>(F.lds, g, S, E);
            } else if (sub == 1) {
                const int parts = rep ? PROBE_PB_PARTS : 7;
                if (F.G == 256 && (parts & 1)) {
                    const bool isq = F.bx < 128; const int ui = isq ? F.bx : F.bx - 128, pm = ui >> 1, pn = ui & 1;
                    pb_prepass(F, pm, (!isq) && pn == 0);
                    LDS_WAIT(); VM_WAIT(); __syncthreads();
                    const LAS float* RS = (const LAS float*)(F.lds + LDS_RS);
                    { pg8::Gemm g{W_PROJ(ws) + C_MCQ, W_WUQ(ws), PROJ_LD, 256, 256}; pg8::OneUnit S{pm, pn, isq}; pg8::EpiQ E{W_Q(ws), RS, W_COS(ws), W_SIN(ws), QSCALE};
                      pg8::gemm_phase<pg8::EpiQ, pg8::OneUnit>(F.lds, g, S, E); }
                    { pg8::Gemm g{W_PROJ(ws) + C_MCKV, W_WUKV(ws), PROJ_LD, 128, 128}; pg8::OneUnit S{pm, pn, !isq}; pg8::EpiKV E{W_K(ws), W_V(ws), RS};
                      pg8::gemm_phase<pg8::EpiKV, pg8::OneUnit>(F.lds, g, S, E); }
                }
                if (parts & 2) for (int c = F.bx; c < 1024; c += F.G) gdn::prep_chunk(F, l, c >> 9, (c >> 7) & 3, c & 127);
                if (parts & 4) for (int it = F.bx; it < 256; it += F.G) gdn::kmean_item(F, it);
            } else if (sub == 2) {
                volatile LAS int* slot = (volatile LAS int*)(F.lds + LDS_MISC + 128);
                const int parts = rep ? PROBE_PC_PARTS : 7;
                for (;;) {
                    if (F.tid == 0) *slot = (int)__hip_atomic_fetch_add(ctl + CW_Q + 64 * (l * 4 + rep), 1u, __ATOMIC_RELAXED, __HIP_MEMORY_SCOPE_AGENT);
                    __syncthreads();
                    const int u = __builtin_amdgcn_readfirstlane(*slot);
                    __syncthreads();
                    if (u >= 520) break;
                    if (u < 8) { if (parts & 1) gdn::scan_chain(F, l, u, rep ? PROBE_SCAN_VAR : 0); continue; }
                    const int v = u - 8, qb = 31 - (v >> 4), kind = (v >> 3) & 1, bh = v & 7;
                    if (!((parts >> (1 + kind)) & 1)) continue;
                    if (kind == 0) att::attn_unit<0>(F, bh >> 2, bh & 3, qb); else att::attn_unit<1>(F, bh >> 2, bh & 3, qb);
                }
            } else {
                if (l + 1 < DEPTH) { convert_weights(F, kargs(), l + 1, 1); }
                VM_WAIT(); __syncthreads();
                if (F.G == 256) {
                    pg8::Gemm g{W_Y(ws), W_WOUT(ws), LDY, 1024, 1024}; pg8::StaticOrder S; S.init(M_TOK, 1024, F.G, F.bx);
                    kargs_t ka = kargs(); float* xo = ka->out; pg8::EpiRes E{(l == 0) ? IN_X(ka) : xo, xo, W_XB(ws), W_SSQ(ws)};
                    pg8::gemm_phase<pg8::EpiRes, pg8::StaticOrder>(F.lds, g, S, E);
                }
            }
            }
        }
        if (ph + 1 < hi) xcd_barrier(bar);
    }
}
extern "C" void kernel_launch(void* const* d_in, const int* in_sizes, int n_in, void* d_out, int out_size, void* d_ws, size_t ws_size, hipStream_t stream) {
    static int grid = 0;
    if (grid == 0) {
        int dev = 0, cus = 0;
        if (n_in != 14 || ws_size < WS_END || hipGetDevice(&dev) != hipSuccess || hipDeviceGetAttribute(&cus, hipDeviceAttributeMultiprocessorCount, dev) != hipSuccess) { grid = -1; return; }
        if (hipFuncSetAttribute((const void*)skel_fwd, hipFuncAttributeMaxDynamicSharedMemorySize, LDS_BYTES) != hipSuccess) { grid = -1; return; }
        grid = cus;
    }
    if (grid != 256) return;
    unsigned char* ws = (unsigned char*)d_ws;
    (void)hipMemsetAsync(ws + WS_CTL, 0, CTL_ZERO_BYTES, stream);
    Args a{};
    for (int i = 0; i < 14; ++i) a.in[i] = (const float*)d_in[i];
    a.out = (float*)d_out; a.ws = ws;
    auto fast = [&](int lo, int hi) { a.ph_lo = lo; a.ph_hi = hi; hipLaunchKernelGGL(skel_fwd, dim3(grid), dim3(NTHREADS), LDS_BYTES, stream, a); };
    fast(0, N_PHASES);
}
```

```cpp
#include <hip/hip_runtime.h>
#include <cstdint>
#include <cstddef>

constexpr int D_MODEL = 1024, BATCH = 2, SEQ = 8192, DEPTH = 4, M_TOK = BATCH * SEQ;
constexpr int IN_COLS = 3752, PROJ_LD = 3840;
constexpr int C_MCQ = 0, C_MCKV = 256, C_MKR = 384, C_MGATE = 416, C_GQ = 672, C_GK = 1184, C_GV = 1696, C_GZ = 2208, C_GB = 2720, C_GA = 2724,
              C_CQ = 2728, C_CK = 2984, C_CV = 3240, C_CGATE = 3496;
constexpr float RMS_EPS = 1e-6f;
constexpr int Q_LD = 384, K_LD = 384, V_LD = 256;

constexpr size_t MiB = 1u << 20;
constexpr size_t WS_CTL = 0;
constexpr size_t WS_TBL = 1 * MiB;
constexpr size_t WS_KMEAN = WS_TBL + 32768;
constexpr size_t WS_SSQ = WS_KMEAN + 65536;
constexpr size_t WS_RQ = WS_SSQ + 262144;
constexpr size_t WS_RKV = WS_RQ + 65536;
constexpr size_t WS_COS = WS_RKV + 65536;
constexpr size_t WS_SIN = WS_COS + 524288;
constexpr size_t WS_GEND = WS_SIN + 524288;
constexpr size_t WS_WIN = 3 * MiB;
constexpr size_t WS_WOUT = WS_WIN + 3840 * 1024 * 2;
constexpr size_t WS_WUQ = WS_WOUT + 2 * MiB;
constexpr size_t WS_WUKV = WS_WUQ + 262144;
constexpr size_t WS_Q = 13 * MiB;
constexpr size_t WS_K = 25 * MiB;
constexpr size_t WS_V = 37 * MiB;
constexpr size_t WS_PROJ = 45 * MiB;
constexpr size_t WS_XB = 165 * MiB;
constexpr size_t WS_GDN = 165 * MiB;
constexpr size_t WS_YN = 197 * MiB;
constexpr size_t WS_OUTG = 237 * MiB;
constexpr size_t WS_END = 256 * MiB;

typedef unsigned short bf16_t;
__device__ __forceinline__ unsigned f2bf(float f) { unsigned u = __builtin_bit_cast(unsigned, f); return (u + 0x7fffu + ((u >> 16) & 1u)) >> 16; }
__device__ __forceinline__ float bf2f(bf16_t b) { return __builtin_bit_cast(float, (unsigned)b << 16); }
__device__ __forceinline__ float siluf(float x) { return x / (1.f + __expf(-x)); }
__device__ __forceinline__ float wave_sum(float v) {
    v += __builtin_bit_cast(float, __builtin_amdgcn_update_dpp(0, __builtin_bit_cast(int, v), 0x111, 0xf, 0xf, true));
    v += __builtin_bit_cast(float, __builtin_amdgcn_update_dpp(0, __builtin_bit_cast(int, v), 0x112, 0xf, 0xf, true));
    v += __builtin_bit_cast(float, __builtin_amdgcn_update_dpp(0, __builtin_bit_cast(int, v), 0x114, 0xf, 0xf, true));
    v += __builtin_bit_cast(float, __builtin_amdgcn_update_dpp(0, __builtin_bit_cast(int, v), 0x118, 0xf, 0xf, true));
    const int b = __builtin_bit_cast(int, v);
    return (__builtin_bit_cast(float, __builtin_amdgcn_readlane(b, 15)) + __builtin_bit_cast(float, __builtin_amdgcn_readlane(b, 31))) + (__builtin_bit_cast(float, __builtin_amdgcn_readlane(b, 47)) + __builtin_bit_cast(float, __builtin_amdgcn_readlane(b, 63)));
}

#define LAS __attribute__((address_space(3)))
#define GAS __attribute__((address_space(1)))
typedef short bf16x8 __attribute__((ext_vector_type(8)));
typedef float f32x4 __attribute__((ext_vector_type(4)));
typedef float f32x2 __attribute__((ext_vector_type(2)));
typedef float f32x16 __attribute__((ext_vector_type(16)));
typedef unsigned u32x4 __attribute__((ext_vector_type(4)));
typedef unsigned u32x2 __attribute__((ext_vector_type(2)));
typedef __bf16 bf16x2_t __attribute__((ext_vector_type(2)));
__device__ __forceinline__ unsigned cvtpk(float lo, float hi) { f32x2 v = {lo, hi}; bf16x2_t b = __builtin_convertvector(v, bf16x2_t); return __builtin_bit_cast(unsigned, b); }
#define LDS_WAIT() asm volatile("s_waitcnt lgkmcnt(0)" ::: "memory")
#define VM_WAIT() asm volatile("s_waitcnt vmcnt(0)" ::: "memory")

constexpr int RING_BYTES = 131072;
constexpr int LDS_RS = 131072;
constexpr int LDS_MISC = 131072 + 24576;
constexpr int LDS_BYTES = 163840;

namespace pg8 {
constexpr int BM = 256, BK = 64, HALF = 128, HTB = HALF * BK * 2, NXCD = 8, WGM = 8;
__host__ __device__ __forceinline__ int lds_byte(int r, int c) { const int st = (r >> 4) * 2 + (c >> 5), rr = r & 15, cc = c & 31, ob = rr * 64 + cc * 2; return st * 1024 + (ob ^ (((ob >> 9) & 1) << 5)); }
__host__ __device__ __forceinline__ void stage_rc(int b, int& R, int& C) { const int st = b / 1024, sb = b % 1024, swz = sb ^ (((sb >> 9) & 1) << 5); R = (st >> 1) * 16 + swz / 64; C = (st & 1) * 32 + (swz % 64) / 2; }
__host__ __device__ __forceinline__ int perm32(int rho) { const int n = rho >> 4, i = rho & 15; return 8 * (i >> 2) + 4 * n + (i & 3); }
struct Unit { int pm, pn; };
struct Gemm { const bf16_t* A; const bf16_t* Bt; int lda, ldb, K; };
struct StaticOrder {
    int nM, nN, nwg, G, c;
    __device__ void init(int M, int N, int G_, int c_) { nM = M / BM; nN = N / BM; nwg = nM * nN; G = G_; c = c_; }
    __device__ bool next(int i, Unit& u) const {
        const long L = (long)i * G + c; if (L >= nwg) return false;
        int wgid = (int)L; { const int q = nwg / NXCD, r = nwg % NXCD, xcd = wgid % NXCD, off = wgid / NXCD; wgid = (xcd < r ? xcd * (q + 1) : r * (q + 1) + (xcd - r) * q) + off; }
        const int nig = WGM * nN, gid = wgid / nig, fm = gid * WGM, gsz = (nM - fm) < WGM ? (nM - fm) : WGM;
        u.pm = fm + ((wgid % nig) % gsz); u.pn = (wgid % nig) / gsz; return true;
    }
};
struct OneUnit {
    int pm, pn; bool have;
    __device__ bool next(int i, Unit& u) const { if (i > 0 || !have) return false; u.pm = pm; u.pn = pn; return true; }
};
template <class Epi, class Sched>
__device__ __forceinline__ void gemm_phase(LAS unsigned char* lds, const Gemm g, const Sched& S, const Epi& E, int wave_id) {
    unsigned m_ = ~0u; asm volatile("" : "+s"(m_));
    const int tid = wave_id * 64 + (int)__builtin_amdgcn_mbcnt_hi(m_, __builtin_amdgcn_mbcnt_lo(m_, 0u)), wid = wave_id, lane = tid & 63, wr = wid >> 2, wc = wid & 3, fr = lane & 15, fq = lane >> 4;
    int K_ = g.K; asm volatile("" : "+s"(K_));
    const int K = K_, nt = K / BK;
    unsigned voffA[2], voffB[2];
#pragma unroll
    for (int i = 0; i < 2; ++i) { int R, C; stage_rc(tid * 16 + i * 8192, R, C); const int Rb = Epi::PERM ? ((R & ~31) + perm32(R & 31)) : R;
        voffA[i] = (unsigned)(R * g.lda + C) * 2u; voffB[i] = (unsigned)(Rb * g.ldb + C) * 2u; }
    const size_t kstep = (size_t)(BK * 2);
    const size_t hstepA = (size_t)HALF * g.lda * 2, hstepB = (size_t)HALF * g.ldb * 2, tstepA = 2 * hstepA, tstepB = 2 * hstepB;
    const unsigned ldsw = (unsigned)wid * 1024u;
    const int aoff = lds_byte(wr * 64 + fr, fq * 8), boff = lds_byte(wc * 32 + fr, fq * 8);
#define PG8_SA(b, h) (((b) * 2 + (h)) * HTB)
#define PG8_SB(b, h) ((4 + (b) * 2 + (h)) * HTB)
#define PG8_STAGE(bufoff, gbase, voff) do { _Pragma("unroll") for (int _i = 0; _i < 2; ++_i) \
        __builtin_amdgcn_global_load_lds((const unsigned*)((const char*)(gbase) + (voff)[_i]), (LAS unsigned*)(lds + (bufoff) + ldsw + _i * 8192), 16, 0, 0); } while (0)
#define PG8_LDA(dst, b, h) do { _Pragma("unroll") for (int m = 0; m < 4; ++m) _Pragma("unroll") for (int k = 0; k < 2; ++k) dst[m][k] = *(const LAS bf16x8*)(lds + PG8_SA(b, h) + aoff + m * 2048 + k * 1024); } while (0)
#define PG8_LDB(dst, b, h) do { _Pragma("unroll") for (int n = 0; n < 2; ++n) _Pragma("unroll") for (int k = 0; k < 2; ++k) dst[n][k] = *(const LAS bf16x8*)(lds + PG8_SB(b, h) + boff + n * 2048 + k * 1024); } while (0)
#define PG8_MMA(ai, bj, At, Bt) do { __builtin_amdgcn_s_setprio(1); _Pragma("unroll") for (int m = 0; m < 4; ++m) _Pragma("unroll") for (int n = 0; n < 2; ++n) _Pragma("unroll") for (int k = 0; k < 2; ++k) \
        acc[ai][bj][m][n] = __builtin_amdgcn_mfma_f32_16x16x32_bf16(Bt[n][k], At[m][k], acc[ai][bj][m][n], 0, 0, 0); __builtin_amdgcn_s_setprio(0); } while (0)
#define PG8_WAIT_V(n) asm volatile("s_waitcnt vmcnt(" #n ")" ::: "memory")
#define PG8_WAIT_L(n) asm volatile("s_waitcnt lgkmcnt(" #n ")" ::: "memory")
#define PG8_BAR __builtin_amdgcn_s_barrier()
#define PG8_SCHED __builtin_amdgcn_sched_barrier(0)
    Unit cur, nxt; int ui = 0;
    if (!S.next(0, cur)) return;
    f32x4 acc[2][2][4][2];
#pragma unroll
    for (int a = 0; a < 2; ++a)
#pragma unroll
        for (int b = 0; b < 2; ++b)
#pragma unroll
            for (int m = 0; m < 4; ++m)
#pragma unroll
                for (int n = 0; n < 2; ++n) acc[a][b][m][n] = (f32x4){0.f, 0.f, 0.f, 0.f};
    bf16x8 At[4][2], B0[2][2], B1[2][2];
    const char* cA = (const char*)g.A + (size_t)cur.pm * tstepA; const char* cB = (const char*)g.Bt + (size_t)cur.pn * tstepB;
    PG8_STAGE(PG8_SB(0, 0), cB, voffB); PG8_STAGE(PG8_SB(0, 1), cB + hstepB, voffB); PG8_STAGE(PG8_SA(0, 0), cA, voffA); PG8_STAGE(PG8_SA(0, 1), cA + hstepA, voffA);
    if (wr == 1) PG8_BAR;
    PG8_WAIT_V(2); PG8_BAR;
    PG8_STAGE(PG8_SB(1, 0), cB + kstep, voffB); PG8_STAGE(PG8_SA(1, 0), cA + kstep, voffA); PG8_STAGE(PG8_SB(1, 1), cB + hstepB + kstep, voffB);
    PG8_WAIT_V(6); PG8_BAR;
    for (;;) {
        const bool has_next = S.next(ui + 1, nxt);
        const char* nA = has_next ? (const char*)g.A + (size_t)nxt.pm * tstepA : cA; const char* nB = has_next ? (const char*)g.Bt + (size_t)nxt.pn * tstepB : cB;
        for (int t = 0; t < nt; t += 2) {
            const bool last = (t == nt - 2);
            const char* a1 = cA + (size_t)(t + 1) * kstep;
            const char* a2 = last ? nA : cA + (size_t)(t + 2) * kstep; const char* b2 = last ? nB : cB + (size_t)(t + 2) * kstep;
            const char* a3 = a2 + kstep; const char* b3 = b2 + kstep;
            PG8_LDB(B0, 0, 0); PG8_LDB(B1, 0, 1); PG8_SCHED; PG8_LDA(At, 0, 0); PG8_STAGE(PG8_SA(1, 1), a1 + hstepA, voffA);
            PG8_WAIT_V(8); PG8_WAIT_L(0); PG8_BAR; PG8_MMA(0, 0, At, B0); PG8_MMA(0, 1, At, B1); PG8_BAR; PG8_SCHED;
            PG8_LDA(At, 0, 1); PG8_STAGE(PG8_SB(0, 0), b2, voffB); PG8_STAGE(PG8_SB(0, 1), b2 + hstepB, voffB); PG8_STAGE(PG8_SA(0, 0), a2, voffA);
            PG8_WAIT_V(8); PG8_WAIT_L(0); PG8_BAR; PG8_MMA(1, 0, At, B0); PG8_MMA(1, 1, At, B1); PG8_BAR; PG8_SCHED;
            PG8_LDB(B0, 1, 0); PG8_LDB(B1, 1, 1); PG8_SCHED; PG8_LDA(At, 1, 0); PG8_STAGE(PG8_SA(0, 1), a2 + hstepA, voffA);
            PG8_WAIT_V(8); PG8_WAIT_L(0); PG8_BAR; PG8_MMA(0, 0, At, B0); PG8_MMA(0, 1, At, B1); PG8_BAR; PG8_SCHED;
            PG8_LDA(At, 1, 1); PG8_STAGE(PG8_SB(1, 0), b3, voffB); PG8_STAGE(PG8_SB(1, 1), b3 + hstepB, voffB); PG8_STAGE(PG8_SA(1, 0), a3, voffA);
            PG8_WAIT_V(8); PG8_WAIT_L(0); PG8_BAR; PG8_MMA(1, 0, At, B0); PG8_MMA(1, 1, At, B1); PG8_BAR; PG8_SCHED;
        }
        if (wr == 0) PG8_BAR;
        if constexpr (!Epi::AFTER_DRAIN) { E(acc, cur, wr, wc, fr, fq); }
        if (!has_next) break;
#pragma unroll
        for (int a = 0; a < 2; ++a)
#pragma unroll
            for (int b = 0; b < 2; ++b)
#pragma unroll
                for (int m = 0; m < 4; ++m)
#pragma unroll
                    for (int n = 0; n < 2; ++n) acc[a][b][m][n] = (f32x4){0.f, 0.f, 0.f, 0.f};
        cur = nxt; cA = nA; cB = nB; ++ui;
        if (wr == 1) PG8_BAR;
    }
    PG8_WAIT_V(0);
    PG8_BAR;
    if constexpr (Epi::AFTER_DRAIN) { E.fused(acc, cur, wr, wc, fr, fq, lds, wid, lane); }
#undef PG8_SA
#undef PG8_SB
#undef PG8_STAGE
#undef PG8_LDA
#undef PG8_LDB
#undef PG8_MMA
#undef PG8_WAIT_V
#undef PG8_WAIT_L
#undef PG8_BAR
#undef PG8_SCHED
}

struct EpiProj {
    static constexpr bool PERM = true, AFTER_DRAIN = false;
    bf16_t* O; const float* ssq;
    __device__ __forceinline__ void operator()(const f32x4 (&acc)[2][2][4][2], const Unit& u, int wr, int wc, int fr, int fq) const {
        const int row0 = u.pm * BM + wr * 64 + fr, col0 = u.pn * BM + wc * 32 + 8 * fq;
        f32x4 qs[8];
#pragma unroll
        for (int g = 0; g < 8; ++g) qs[g] = *(const f32x4*)(ssq + (size_t)(row0 + (g >> 2) * HALF + (g & 3) * 16) * 4);
        asm volatile("" ::: "memory");
#pragma unroll
        for (int ai = 0; ai < 2; ++ai)
#pragma unroll
            for (int m = 0; m < 4; ++m) { const int row = row0 + ai * HALF + m * 16; const f32x4 q = qs[ai * 4 + m];
                const float rs = rsqrtf(((q[0] + q[1]) + (q[2] + q[3])) * (1.f / D_MODEL) + RMS_EPS); bf16_t* rowp = O + (size_t)row * PROJ_LD + col0;
#pragma unroll
                for (int bj = 0; bj < 2; ++bj) { if (col0 + bj * HALF < IN_COLS) { const f32x4 v0 = acc[ai][bj][m][0] * rs, v1 = acc[ai][bj][m][1] * rs;
                    u32x4 w; w.x = cvtpk(v0[0], v0[1]); w.y = cvtpk(v0[2], v0[3]); w.z = cvtpk(v1[0], v1[1]); w.w = cvtpk(v1[2], v1[3]); *(u32x4*)(rowp + bj * HALF) = w; } } }
    }
};
struct EpiRes {
    static constexpr bool PERM = false, AFTER_DRAIN = true;
    const float* xin; float* xf; bf16_t* xb; float* ssq;
    __device__ __forceinline__ void fused(f32x4 (&acc)[2][2][4][2], const Unit& u, int wr, int wc, int fr, int fq, LAS unsigned char* lds, int wid, int lane) const {
        LAS float* P = (LAS float*)lds;
        const int col0 = u.pn * BM + wc * 32 + 4 * fq;
#pragma unroll
        for (int ai = 0; ai < 2; ++ai)
#pragma unroll
            for (int m = 0; m < 4; ++m) { const int rl = ai * HALF + wr * 64 + m * 16 + fr; const size_t off = (size_t)(u.pm * BM + rl) * D_MODEL + col0; float s = 0.f;
#pragma unroll
                for (int bj = 0; bj < 2; ++bj)
#pragma unroll
                    for (int n = 0; n < 2; ++n) { const size_t o2 = off + bj * HALF + n * 16; const f32x4 o = *(const f32x4*)(xin + o2) + acc[ai][bj][m][n]; *(f32x4*)(xf + o2) = o;
                        u32x2 w; w.x = cvtpk(o[0], o[1]); w.y = cvtpk(o[2], o[3]); *(u32x2*)(xb + o2) = w; s += (o[0] * o[0] + o[1] * o[1]) + (o[2] * o[2] + o[3] * o[3]); }
                s += __shfl_xor(s, 16); s += __shfl_xor(s, 32);
                if (fq == 0) P[rl * 4 + wc] = s; }
        LDS_WAIT(); __builtin_amdgcn_s_barrier(); asm volatile("" ::: "memory");
        const int t = wid * 64 + lane;
        if (t < 256) { const f32x4 p = *(const LAS f32x4*)(P + t * 4); ssq[(size_t)(u.pm * BM + t) * 4 + u.pn] = (p[0] + p[1]) + (p[2] + p[3]); }
        LDS_WAIT(); __builtin_amdgcn_s_barrier();
    }
};
struct EpiQ {
    static constexpr bool PERM = false, AFTER_DRAIN = false;
    bf16_t* Q; const LAS float* RS; const float* cs; const float* sn; float qscale;
    __device__ __forceinline__ void operator()(const f32x4 (&acc)[2][2][4][2], const Unit& u, int wr, int wc, int fr, int fq) const {
#pragma unroll
        for (int ai = 0; ai < 2; ++ai) {
            f32x4 cv[4], sv[4];
#pragma unroll
            for (int m = 0; m < 4; ++m) { const int pos = (u.pm * BM + ai * HALF + wr * 64 + m * 16 + fr) & (SEQ - 1); cv[m] = *(const f32x4*)(cs + pos * 16 + 4 * fq); sv[m] = *(const f32x4*)(sn + pos * 16 + 4 * fq); }
            asm volatile("" ::: "memory");
#pragma unroll
            for (int m = 0; m < 4; ++m) { const int rl = ai * HALF + wr * 64 + m * 16 + fr, row = u.pm * BM + rl; const float rs = RS[rl * 2] * qscale;
                const f32x4 c4 = cv[m], s4 = sv[m];
#pragma unroll
                for (int bj = 0; bj < 2; ++bj) { const int cb = u.pn * BM + bj * HALF + wc * 32; if (cb < 384) {
                    f32x4 v0 = acc[ai][bj][m][0], v1 = acc[ai][bj][m][1];
                    if (((cb >> 5) % 3) == 2) { const f32x4 a = v0 * c4 - v1 * s4, b = v0 * s4 + v1 * c4; v0 = a; v1 = b; }
                    v0 = v0 * rs; v1 = v1 * rs; bf16_t* p = Q + (size_t)row * Q_LD + cb + 4 * fq;
                    u32x2 w0, w1; w0.x = cvtpk(v0[0], v0[1]); w0.y = cvtpk(v0[2], v0[3]); w1.x = cvtpk(v1[0], v1[1]); w1.y = cvtpk(v1[2], v1[3]);
                    *(u32x2*)p = w0; *(u32x2*)(p + 16) = w1; } } }
            asm volatile("" ::: "memory"); }
    }
};
struct EpiKV {
    static constexpr bool PERM = true, AFTER_DRAIN = false;
    bf16_t* Kb; bf16_t* Vb; const LAS float* RS;
    __device__ __forceinline__ void operator()(const f32x4 (&acc)[2][2][4][2], const Unit& u, int wr, int wc, int fr, int fq) const {
#pragma unroll
        for (int ai = 0; ai < 2; ++ai)
#pragma unroll
            for (int m = 0; m < 4; ++m) { const int rl = ai * HALF + wr * 64 + m * 16 + fr, row = u.pm * BM + rl; const float rs = RS[rl * 2 + 1];
#pragma unroll
                for (int bj = 0; bj < 2; ++bj) { const int c = bj * HALF + wc * 32 + 8 * fq; const f32x4 v0 = acc[ai][bj][m][0] * rs, v1 = acc[ai][bj][m][1] * rs;
                    u32x4 w; w.x = cvtpk(v0[0], v0[1]); w.y = cvtpk(v0[2], v0[3]); w.z = cvtpk(v1[0], v1[1]); w.w = cvtpk(v1[2], v1[3]);
                    bf16_t* p = (u.pn == 0) ? Kb + (size_t)row * K_LD + 96 * (c >> 6) + (c & 63) : Vb + (size_t)row * V_LD + c;
                    *(u32x4*)p = w; } }
    }
};
}

#define XB_TMO      128
#define XB_XCNT(j)  (256  + 64 * (j))
#define XB_XSUB(j)  (1280 + 64 * (j))
#define XB_XGEN(j)  (2304 + 64 * (j))
#define XB_TOP      3328
#define XB_TOPGEN   3392
#define XCD_BAR_WORDS 3456
#define XB_SPIN_CAP (1u << 20)
__device__ __forceinline__ unsigned xb_ld(unsigned* p)              { return __hip_atomic_load(p, __ATOMIC_RELAXED, __HIP_MEMORY_SCOPE_AGENT); }
__device__ __forceinline__ unsigned xb_add(unsigned* p, unsigned v) { return __hip_atomic_fetch_add(p, v, __ATOMIC_RELAXED, __HIP_MEMORY_SCOPE_AGENT); }
__device__ __forceinline__ unsigned xb_xcc_id() { return (unsigned)__builtin_amdgcn_s_getreg((3 << 11) | 20) & 0xFu; }
#define XB_SPIN(cond, bar) do { unsigned _sp = 0; while (cond) { __builtin_amdgcn_s_sleep(1); \
    if ((++_sp & 255u) == 0u) { if (xb_ld(&(bar)[XB_TMO])) break; if (_sp > XB_SPIN_CAP) { atomicAdd(&(bar)[XB_TMO], 1u); break; } } } } while (0)
struct XcdBarrier { unsigned* bar; unsigned x; volatile LAS unsigned* st; };
__device__ __forceinline__ XcdBarrier xcd_barrier_post(unsigned* bar, volatile LAS unsigned* st, bool thread0) {
    XcdBarrier b; b.bar = bar; b.x = xb_xcc_id(); b.st = st;
    if (thread0) (void)xb_add(&bar[XB_XCNT(b.x)], 1u);
    return b;
}
__device__ __forceinline__ void xcd_barrier_complete(unsigned* bar, unsigned x, unsigned& nloc, unsigned& nx) {
    const unsigned G = gridDim.x * gridDim.y * gridDim.z;
    unsigned sum, cnt, mine, sp = 0u;
    for (;;) {
        sum = 0u; cnt = 0u; mine = 0u;
#pragma unroll
        for (unsigned j = 0; j < 16; ++j) { const unsigned c = xb_ld(&bar[XB_XCNT(j)]); sum += c; cnt += (c > 0u) ? 1u : 0u; mine = (j == x) ? c : mine; }
        if (sum == G) break;
        __builtin_amdgcn_s_sleep(1);
        if ((++sp & 255u) == 0u) { if (xb_ld(&bar[XB_TMO])) break; if (sp > XB_SPIN_CAP) { atomicAdd(&bar[XB_TMO], 1u); break; } }
    }
    nloc = mine > 0u ? mine : 1u; nx = cnt > 0u ? cnt : 1u;
}
__device__ __forceinline__ void xcd_barrier(const XcdBarrier& b, bool thread0) {
    asm volatile("s_waitcnt vmcnt(0)" ::: "memory");
    __syncthreads();
    if (thread0) {
        unsigned* bar = b.bar;
        __builtin_amdgcn_s_waitcnt(0);
        unsigned nloc = b.st[0], nx = b.st[1];
        if (nloc == 0u) { xcd_barrier_complete(bar, b.x, nloc, nx); b.st[0] = nloc; b.st[1] = nx; }
        const unsigned old = xb_add(&bar[XB_XSUB(b.x)], 1u);
        const unsigned gen = old / nloc;
        if (old + 1u == (gen + 1u) * nloc) {
            __builtin_amdgcn_fence(__ATOMIC_RELEASE, "agent");
            asm volatile("s_waitcnt vmcnt(0)" ::: "memory");
            const unsigned og = xb_add(&bar[XB_TOP], 1u);
            const unsigned tg = og / nx;
            if (og + 1u == (tg + 1u) * nx) xb_add(&bar[XB_TOPGEN], 1u);
            else XB_SPIN(xb_ld(&bar[XB_TOPGEN]) == tg, bar);
            __builtin_amdgcn_fence(__ATOMIC_ACQUIRE, "agent");
            xb_add(&bar[XB_XGEN(b.x)], 1u);
            asm volatile("s_waitcnt vmcnt(0)" ::: "memory");
        } else {
            XB_SPIN(xb_ld(&bar[XB_XGEN(b.x)]) == gen, bar);
            __builtin_amdgcn_fence(__ATOMIC_ACQUIRE, "agent");
            asm volatile("s_waitcnt vmcnt(0)" ::: "memory");
        }
    }
    __syncthreads();
}
constexpr int NWAVES = 8, NTHREADS = 512;
constexpr int CW_BAR = 4096, CW_Q = 131072;
constexpr size_t CTL_ZERO_BYTES = 1 * MiB;
constexpr int N_PHASES = 2 + 4 * DEPTH;
constexpr float QSCALE = 0.10206207261596577f * 1.4426950408889634f;

struct Args { const float* in[14]; float* out; unsigned char* ws; int ph_lo, ph_hi; int fastmask, pad; };
struct Frame { LAS unsigned char* lds; int tid, lane, wave, G, bx; unsigned char* ws; };
typedef const __attribute__((address_space(4))) Args* kargs_t;
__device__ __forceinline__ kargs_t kargs() { kargs_t p = (kargs_t)__builtin_amdgcn_kernarg_segment_ptr(); asm volatile("" : "+s"(p)); return p; }
#define IN_X(a) ((a)->in[0])
#define IN_NORMW(a) ((a)->in[1])
#define IN_WIN(a) ((a)->in[2])
#define IN_QNORM(a) ((a)->in[3])
#define IN_WUQ(a) ((a)->in[4])
#define IN_KVNORM(a) ((a)->in[5])
#define IN_WUKV(a) ((a)->in[6])
#define IN_CONVW(a) ((a)->in[7])
#define IN_ALOG(a) ((a)->in[8])
#define IN_DTB(a) ((a)->in[9])
#define IN_GNORM(a) ((a)->in[10])
#define IN_WOUT(a) ((a)->in[11])
#define IN_T5(a) ((a)->in[12])
#define IN_FNORM(a) ((a)->in[13])
#define W_TBL(ws) ((float*)((ws) + WS_TBL))
#define W_KM(ws) ((float*)((ws) + WS_KMEAN))
#define W_SSQ(ws) ((float*)((ws) + WS_SSQ))
#define W_COS(ws) ((float*)((ws) + WS_COS))
#define W_SIN(ws) ((float*)((ws) + WS_SIN))
#define W_WIN(ws) ((bf16_t*)((ws) + WS_WIN))
#define W_WOUT(ws) ((bf16_t*)((ws) + WS_WOUT))
#define W_WUQ(ws) ((bf16_t*)((ws) + WS_WUQ))
#define W_WUKV(ws) ((bf16_t*)((ws) + WS_WUKV))
#define W_Q(ws) ((bf16_t*)((ws) + WS_Q))
#define W_K(ws) ((bf16_t*)((ws) + WS_K))
#define W_V(ws) ((bf16_t*)((ws) + WS_V))
#define W_PROJ(ws) ((bf16_t*)((ws) + WS_PROJ))
#define W_XB(ws) ((bf16_t*)((ws) + WS_XB))
#define W_Y(ws) ((bf16_t*)((ws) + WS_PROJ) + C_GQ)
constexpr int LDY = PROJ_LD;

__device__ __forceinline__ Frame opaque(const Frame& F) { Frame G = F; asm volatile("" : "+s"(G.ws), "+s"(G.bx), "+s"(G.wave), "+s"(G.G));
    unsigned m_ = ~0u; asm volatile("" : "+s"(m_)); G.lane = (int)__builtin_amdgcn_mbcnt_hi(m_, __builtin_amdgcn_mbcnt_lo(m_, 0u)); G.tid = G.wave * 64 + G.lane; return G; }
__device__ __forceinline__ void tr_item(const float* W, int K, int N, int NP, const float* sc, bf16_t* WT, int mode, LAS float* scr, int item, int lane) {
    const int nblk = NP / 32, kb = item / nblk, nb = item % nblk, k0 = 64 * kb, n0 = 32 * nb;
    int n = n0 + (lane & 31); const bool valid = n < N;
    if (mode == 1) { const int nn = n & 255, hd = nn >> 6, c = nn & 63; n = hd * 128 + c + ((n >= 256) ? 64 : 0); }
    const float* wp = W + (size_t)(k0 + (lane >> 5)) * N + (valid ? n : N - 1);
    float v[32];
#pragma unroll
    for (int i = 0; i < 32; ++i) v[i] = wp[(size_t)(2 * i) * N];
    if (sc) { const float* sp = sc + k0 + (lane >> 5); float sv[32];
#pragma unroll
        for (int i = 0; i < 32; ++i) sv[i] = sp[2 * i];
#pragma unroll
        for (int i = 0; i < 32; ++i) v[i] *= sv[i]; }
#pragma unroll
    for (int i = 0; i < 32; ++i) scr[(2 * i + (lane >> 5)) * 33 + (lane & 31)] = valid ? v[i] : 0.f;
    LDS_WAIT(); asm volatile("" ::: "memory");
    const int c = lane & 7;
#pragma unroll
    for (int j = 0; j < 4; ++j) { const int nn = (lane >> 3) + 8 * j; const LAS float* s = scr + (8 * c) * 33 + nn;
        u32x4 o; o.x = cvtpk(s[0 * 33], s[1 * 33]); o.y = cvtpk(s[2 * 33], s[3 * 33]); o.z = cvtpk(s[4 * 33], s[5 * 33]); o.w = cvtpk(s[6 * 33], s[7 * 33]);
        *(u32x4*)(WT + (size_t)(n0 + nn) * K + k0 + 8 * c) = o; }
    LDS_WAIT(); asm volatile("" ::: "memory");
}
constexpr int I_IN = 16 * 120, I_UQ = 4 * 16, I_UKV = 2 * 16, I_OUT = 16 * 32, N_CONV_IN = I_IN + I_UQ + I_UKV;
__device__ __forceinline__ void convert_in_item(const Frame& F, kargs_t A, int l, int r, LAS float* scr) {
    if (r < I_IN) { tr_item(IN_WIN(A) + (size_t)l * 1024 * IN_COLS, 1024, IN_COLS, 3840, IN_NORMW(A) + l * 1024, W_WIN(F.ws), 0, scr, r, F.lane); return; } r -= I_IN;
    if (r < I_UQ) { tr_item(IN_WUQ(A) + (size_t)l * 256 * 384, 256, 384, 512, IN_QNORM(A) + l * 256, W_WUQ(F.ws), 0, scr, r, F.lane); return; } r -= I_UQ;
    tr_item(IN_WUKV(A) + (size_t)l * 128 * 512, 128, 512, 512, IN_KVNORM(A) + l * 128, W_WUKV(F.ws), 1, scr, r, F.lane);
}
__device__ __forceinline__ void convert_weights(const Frame& F0, kargs_t A, int l, int which) {
    const Frame F = opaque(F0);
    LAS float* scr = (LAS float*)(F.lds + F.wave * 16384);
    const int gw = F.bx * NWAVES + F.wave, NGW = F.G * NWAVES;
    if (which & 1) for (int it = gw; it < N_CONV_IN; it += NGW) convert_in_item(F, A, l, it, scr);
    if (which & 2) for (int it = gw; it < I_OUT; it += NGW) tr_item(IN_WOUT(A) + (size_t)l * 1024 * 1024, 1024, 1024, 1024, nullptr, W_WOUT(F.ws), 0, scr, it, F.lane);
}
__device__ __forceinline__ float rope_inv(int j) {
    unsigned b = 0x3f800000u;
    b = (j == 1) ? 0x3f0ff59au : b;
    b = (j == 2) ? 0x3ea1e89bu : b;
    b = (j == 3) ? 0x3e361887u : b;
    b = (j == 4) ? 0x3dcccccdu : b;
    b = (j == 5) ? 0x3d6655c2u : b;
    b = (j == 6) ? 0x3d0186e3u : b;
    b = (j == 7) ? 0x3c91ad39u : b;
    b = (j == 8) ? 0x3c23d70au : b;
    b = (j == 9) ? 0x3bb8449cu : b;
    b = (j == 10) ? 0x3b4f3e38u : b;
    b = (j == 11) ? 0x3ae91528u : b;
    b = (j == 12) ? 0x3a83126fu : b;
    b = (j == 13) ? 0x3a136a16u : b;
    b = (j == 14) ? 0x39a5cb60u : b;
    b = (j == 15) ? 0x393a7753u : b;
    return __builtin_bit_cast(float, b);
}
__device__ __forceinline__ void p0_prologue(const Frame& F0, kargs_t A) {
    const Frame F = opaque(F0);
    const int gt = F.bx * NTHREADS + F.tid, NGT = F.G * NTHREADS;
    float* TBL = W_TBL(F.ws); float* COS = W_COS(F.ws); float* SIN = W_SIN(F.ws);
    for (int i = gt; i < SEQ * 16; i += NGT) {
        if (i < 4 * 2048) { const int h = i >> 11, rel = i & 2047; int b;
            if (rel < 16) b = rel; else { b = 16 + (int)(__logf((float)rel * 0.0625f) * (16.f / 4.852030263919617f)); if (b > 31) b = 31; }
            TBL[i] = IN_T5(A)[b * 4 + h]; }
        const int pos = i >> 4, j = i & 15;
        const float inv = rope_inv(j); const float ang = (float)pos * inv;
        const float k = __builtin_rintf(ang * 0.636619772f);
        float r = __builtin_fmaf(-k, 1.5703125f, ang); r = __builtin_fmaf(-k, 4.837512969970703125e-4f, r); r = __builtin_fmaf(-k, 7.54978995489188e-8f, r);
        const float r2 = r * r;
        float sp = 2.7557319e-06f; sp = __builtin_fmaf(sp, r2, -1.9841270e-04f); sp = __builtin_fmaf(sp, r2, 8.3333333e-03f); sp = __builtin_fmaf(sp, r2, -1.6666667e-01f); sp = __builtin_fmaf(sp * r2, r, r);
        float cp = 2.4801587e-05f; cp = __builtin_fmaf(cp, r2, -1.3888889e-03f); cp = __builtin_fmaf(cp, r2, 4.1666667e-02f); cp = __builtin_fmaf(cp, r2, -0.5f); cp = __builtin_fmaf(cp, r2, 1.0f);
        const int q = (int)k & 3; const float sf = sp, cf = cp;
        COS[i] = (q == 0) ? cf : (q == 1) ? -sf : (q == 2) ? -cf : sf;
        SIN[i] = (q == 0) ? sf : (q == 1) ? cf : (q == 2) ? -sf : -cf;
    }
    convert_weights(F0, A, 0, 3);
    const int gw = F.bx * NWAVES + F.wave, NGW = F.G * NWAVES;
    bf16_t* XB = W_XB(F.ws); float* SSQ = W_SSQ(F.ws);
    for (int row0 = gw * 4; row0 < M_TOK; row0 += NGW * 4) {
        f32x4 v[4][4];
#pragma unroll
        for (int r = 0; r < 4; ++r)
#pragma unroll
            for (int j = 0; j < 4; ++j) v[r][j] = *((const f32x4*)(IN_X(A) + (size_t)(row0 + r) * D_MODEL) + F.lane + 64 * j);
#pragma unroll
        for (int r = 0; r < 4; ++r) { float s = 0.f;
#pragma unroll
            for (int j = 0; j < 4; ++j) { const f32x4 w4 = v[r][j]; s += (w4[0] * w4[0] + w4[1] * w4[1]) + (w4[2] * w4[2] + w4[3] * w4[3]);
                u32x2 w; w.x = cvtpk(w4[0], w4[1]); w.y = cvtpk(w4[2], w4[3]); *((u32x2*)(XB + (size_t)(row0 + r) * D_MODEL) + F.lane + 64 * j) = w; }
            s = wave_sum(s); if (F.lane == 0) *(f32x4*)(SSQ + (size_t)(row0 + r) * 4) = (f32x4){s, 0.f, 0.f, 0.f}; }
    }
}
__device__ __forceinline__ void pb_prepass(const Frame& F0, int pm, bool do_kpe) {
    const Frame F = opaque(F0);
    const bf16_t* PROJ = W_PROJ(F.ws); bf16_t* Kb = W_K(F.ws); const float* COS = W_COS(F.ws); const float* SIN = W_SIN(F.ws);
    LAS float* RS = (LAS float*)(F.lds + LDS_RS);
    { const int rl = F.tid >> 1, hf = F.tid & 1; const bf16_t* p = PROJ + (size_t)(pm * 256 + rl) * PROJ_LD;
      float s1 = 0.f, s2 = 0.f;
#pragma unroll
      for (int hb = 0; hb < 2; ++hb) {
          bf16x8 a[8], b[4];
#pragma unroll
          for (int i = 0; i < 8; ++i) a[i] = *(const bf16x8*)(p + C_MCQ + hf * 128 + 64 * hb + 8 * i);
#pragma unroll
          for (int i = 0; i < 4; ++i) b[i] = *(const bf16x8*)(p + C_MCKV + hf * 64 + 32 * hb + 8 * i);
          asm volatile("" ::: "memory");
#pragma unroll
          for (int i = 0; i < 8; ++i)
#pragma unroll
              for (int j = 0; j < 8; ++j) { const float v = bf2f((bf16_t)a[i][j]); s1 += v * v; }
#pragma unroll
          for (int i = 0; i < 4; ++i)
#pragma unroll
              for (int j = 0; j < 8; ++j) { const float v = bf2f((bf16_t)b[i][j]); s2 += v * v; }
          asm volatile("" ::: "memory"); }
      s1 += __shfl_xor(s1, 1); s2 += __shfl_xor(s2, 1);
      if (hf == 0) { RS[rl * 2] = rsqrtf(s1 * (1.f / 256.f) + RMS_EPS); RS[rl * 2 + 1] = rsqrtf(s2 * (1.f / 128.f) + RMS_EPS); } }
    if (do_kpe) {
        float x1[8], x2[8], c[8], sg[8];
#pragma unroll
        for (int i = 0; i < 8; ++i) { const int it = i * 512 + F.tid, rl = it >> 4, j = it & 15, row = pm * 256 + rl, pos = row & (SEQ - 1); const bf16_t* p = PROJ + (size_t)row * PROJ_LD + C_MKR;
            x1[i] = bf2f(p[j]); x2[i] = bf2f(p[16 + j]); c[i] = COS[pos * 16 + j]; sg[i] = SIN[pos * 16 + j]; }
#pragma unroll
        for (int i = 0; i < 8; ++i) { const int it = i * 512 + F.tid, rl = it >> 4, j = it & 15, row = pm * 256 + rl;
            const bf16_t r1 = (bf16_t)f2bf(x1[i] * c[i] - x2[i] * sg[i]), r2 = (bf16_t)f2bf(x1[i] * sg[i] + x2[i] * c[i]);
#pragma unroll
            for (int h = 0; h < 4; ++h) { Kb[(size_t)row * K_LD + 96 * h + 64 + j] = r1; Kb[(size_t)row * K_LD + 96 * h + 80 + j] = r2; } }
    }
}
__device__ __forceinline__ void final_norm(const Frame& F0, float* out, const float* fnorm) {
    const Frame F = opaque(F0);
    const int gw = F.bx * NWAVES + F.wave, NGW = F.G * NWAVES;
    f32x4 w[4];
#pragma unroll
    for (int j = 0; j < 4; ++j) w[j] = *((const f32x4*)fnorm + F.lane + 64 * j);
    for (int row0 = gw * 4; row0 < M_TOK; row0 += NGW * 4) {
        f32x4 v[4][4];
#pragma unroll
        for (int r = 0; r < 4; ++r)
#pragma unroll
            for (int j = 0; j < 4; ++j) v[r][j] = *((const f32x4*)(out + (size_t)(row0 + r) * D_MODEL) + F.lane + 64 * j);
#pragma unroll
        for (int r = 0; r < 4; ++r) { float s = 0.f;
#pragma unroll
            for (int j = 0; j < 4; ++j) s += (v[r][j][0] * v[r][j][0] + v[r][j][1] * v[r][j][1]) + (v[r][j][2] * v[r][j][2] + v[r][j][3] * v[r][j][3]);
            const float rs = rsqrtf(wave_sum(s) * (1.f / D_MODEL) + RMS_EPS);
#pragma unroll
            for (int j = 0; j < 4; ++j) *((f32x4*)(out + (size_t)(row0 + r) * D_MODEL) + F.lane + 64 * j) = v[r][j] * rs * w[j]; }
    }
}

namespace att {
typedef short v4i16_t __attribute__((ext_vector_type(4)));
constexpr int NSLOT = 6, A_SLOT = 20480  , A_K = 0, A_V = 12288, A_WS = NSLOT * A_SLOT, A_KM = A_WS + 2048, A_TB = A_KM + 8192  , A_OST = 0  , A_OSTW = 8704  ;
static_assert(8 * A_OSTW <= NSLOT * A_SLOT && A_TB + 9216 <= LDS_MISC, "attention LDS map");
__device__ __forceinline__ int crow(int r, int hi) { return (r & 3) + 8 * (r >> 2) + 4 * hi; }
__device__ __forceinline__ void glds16(const void* gsrc, unsigned lds_dst) { unsigned keep;
    asm volatile("s_mov_b32 %0, m0\n\ts_mov_b32 m0, %2\n\ts_nop 0\n\tglobal_load_lds_dwordx4 %1, off\n\ts_mov_b32 m0, %0" : "=&s"(keep) : "v"(gsrc), "s"(lds_dst) : "memory"); }
__device__ __forceinline__ void glds4(const void* gsrc, unsigned lds_dst) { unsigned keep;
    asm volatile("s_mov_b32 %0, m0\n\ts_mov_b32 m0, %2\n\ts_nop 0\n\tglobal_load_lds_dword %1, off\n\ts_mov_b32 m0, %0" : "=&s"(keep) : "v"(gsrc), "s"(lds_dst) : "memory"); }
__device__ __forceinline__ float max3f(float a, float b, float c) { float r; asm("v_max3_f32 %0, %1, %2, %3" : "=v"(r) : "v"(a), "v"(b), "v"(c)); return r; }
__device__ __forceinline__ float max_halves(float m) { auto rr = __builtin_amdgcn_permlane32_swap(__float_as_uint(m), __float_as_uint(m), false, false); return max3f(__uint_as_float(rr[0]), __uint_as_float(rr[1]), __uint_as_float(rr[1])); }
__device__ __forceinline__ float other_half(float v) { return __shfl_xor(v, 32); }
__device__ __forceinline__ int other_half_i(int v) { return __shfl_xor(v, 32); }

template <int MODE>
__device__ __forceinline__ void attn_unit(const Frame& F0, int b, int h, int qb, int var = 0) {
    constexpr int DQ = MODE == 0 ? 96 : 64, ND0 = DQ / 16, NCH = DQ / 8;
    const Frame F = opaque(F0);
    const int lane = F.lane, wid = F.wave, r32 = lane & 31, hi = lane >> 5;
    unsigned char* ws = F.ws; LAS unsigned char* lds = F.lds;
    const bf16_t* PROJ = W_PROJ(ws);
    const int ldq = MODE == 0 ? Q_LD : PROJ_LD, ldk = MODE == 0 ? K_LD : PROJ_LD, ldv = MODE == 0 ? V_LD : PROJ_LD;
    const size_t rowbase = (size_t)b * SEQ; const int q0 = qb * 256;
    const bf16_t* Qh = (MODE == 0 ? W_Q(ws) + 96 * h : PROJ + C_CQ + 64 * h) + rowbase * ldq;
    const bf16_t* Kh = (MODE == 0 ? W_K(ws) + 96 * h : PROJ + C_CK + 64 * h) + rowbase * ldk;
    const bf16_t* Vh = (MODE == 0 ? W_V(ws) + 64 * h : PROJ + C_CV + 64 * h) + rowbase * ldv;
    const int qpos = q0 + wid * 32 + r32;
    LAS float* wsf = (LAS float*)(lds + A_WS) + wid * 64;
    bf16x8 qr[ND0];
#pragma unroll
    for (int d0 = 0; d0 < ND0; ++d0) { qr[d0] = *(const bf16x8*)(Qh + (size_t)qpos * ldq + d0 * 16 + hi * 8);
        if (MODE == 1) { const float SC = 0.125f * 1.4426950408889634f; u32x4 w;
#pragma unroll
            for (int j = 0; j < 4; ++j) w[j] = cvtpk(bf2f((bf16_t)qr[d0][2 * j]) * SC, bf2f((bf16_t)qr[d0][2 * j + 1]) * SC);
            qr[d0] = __builtin_bit_cast(bf16x8, w); } }
    unsigned selmask = 0xffffffffu, umask = 0u; const int own = qb;
    if (MODE == 1) {
        LAS float* kml = (LAS float*)(lds + A_KM); LAS float* tbl = (LAS float*)(lds + A_TB); LAS unsigned* um = (LAS unsigned*)(lds + LDS_MISC + 64);
        const float* km = W_KM(ws) + (size_t)(b * 4 + h) * 32 * 64; const float* tb = W_TBL(ws) + h * 2048;
        { const f32x4 a = *(const f32x4*)(km + F.tid * 4);
          const float b31 = tb[2047]; float tv[5];
#pragma unroll
          for (int j = 0; j < 5; ++j) { int rel = F.tid + 512 * j - 64; rel = rel < 0 ? 0 : (rel > 2046 ? 2046 : rel); tv[j] = tb[rel]; }
          *(LAS f32x4*)(kml + F.tid * 4) = a;
#pragma unroll
          for (int j = 0; j < 5; ++j) { const int i = F.tid + 512 * j; const int rel = i - 64; const float e = rel < 0 ? -1e30f : (rel >= 2047 ? 0.f : (tv[j] - b31) * 1.4426950408889634f); if (i < 2240) tbl[i] = e; } }
        if (F.tid == 0) *um = 0u;
        float qf[64];
#pragma unroll
        for (int c = 0; c < 8; ++c) { const bf16x8 v = *(const bf16x8*)(Qh + (size_t)qpos * ldq + c * 8);
#pragma unroll
            for (int j = 0; j < 8; ++j) qf[c * 8 + j] = bf2f((bf16_t)v[j]); }
        LDS_WAIT(); __syncthreads();
        float g0 = -INFINITY, g1 = -INFINITY, g2 = -INFINITY; int s0 = 64, s1 = 64, s2 = 64;
        for (int n = hi; n < own; n += 2) { const LAS f32x4* kp = (const LAS f32x4*)(kml + n * 64); float g = 0.f;
#pragma unroll
            for (int c = 0; c < 16; ++c) { const f32x4 k4 = kp[c]; g += qf[4 * c] * k4[0]; g += qf[4 * c + 1] * k4[1]; g += qf[4 * c + 2] * k4[2]; g += qf[4 * c + 3] * k4[3]; }
            if (g > g0) { g2 = g1; s2 = s1; g1 = g0; s1 = s0; g0 = g; s0 = n; } else if (g > g1) { g2 = g1; s2 = s1; g1 = g; s1 = n; } else if (g > g2) { g2 = g; s2 = n; } }
        const float h0 = other_half(g0), h1 = other_half(g1), h2 = other_half(g2); const int t0 = other_half_i(s0), t1 = other_half_i(s1), t2 = other_half_i(s2);
#define ATT_INS(gg, ss) do { const float g_ = (gg); const int s_ = (ss); \
            if (g_ > g0 || (g_ == g0 && s_ < s0)) { g2 = g1; s2 = s1; g1 = g0; s1 = s0; g0 = g_; s0 = s_; } \
            else if (g_ > g1 || (g_ == g1 && s_ < s1)) { g2 = g1; s2 = s1; g1 = g_; s1 = s_; } \
            else if (g_ > g2 || (g_ == g2 && s_ < s2)) { g2 = g_; s2 = s_; } } while (0)
        ATT_INS(h0, t0); ATT_INS(h1, t1); ATT_INS(h2, t2);
#undef ATT_INS
        selmask = 1u << own; if (s0 < 32) selmask |= 1u << s0; if (s1 < 32) selmask |= 1u << s1; if (s2 < 32) selmask |= 1u << s2;
        (void)__hip_atomic_fetch_or(um, selmask, __ATOMIC_RELAXED, __HIP_MEMORY_SCOPE_WORKGROUP);
        LDS_WAIT(); __syncthreads();
        umask = __builtin_amdgcn_readfirstlane(*um);
    }
    const int NT = MODE == 0 ? 4 * (qb + 1) : 4 * __builtin_popcount(umask);
    const unsigned lds0 = (unsigned)(__UINTPTR_TYPE__)lds;
    auto dma = [&](int key0, int s) {
        if (var & 1) return;
        const bf16_t* ks = Kh + (size_t)(key0 + lane) * ldk + wid * 8;
        glds16(ks, (unsigned)__builtin_amdgcn_readfirstlane(lds0 + s * A_SLOT + A_K + wid * 1024));
        if (NCH > 8) { const int c2 = (wid < NCH - 8) ? 8 + wid : wid;
            glds16(ks + (c2 - wid) * 8, (unsigned)__builtin_amdgcn_readfirstlane(lds0 + s * A_SLOT + A_K + c2 * 1024)); }
        const bf16_t* vs = Vh + (size_t)(key0 + 16 * (wid & 3) + (lane >> 2)) * ldv + (wid >> 2) * 32 + (lane & 3) * 8;
        glds16(vs, (unsigned)__builtin_amdgcn_readfirstlane(lds0 + s * A_SLOT + A_V + wid * 1024));
    };
#define ATT_WAITV(n) asm volatile("s_waitcnt vmcnt(" #n ")" ::: "memory")
#define ATT_WAIT_PREV() do { if (MODE == 0) ATT_WAITV(3); else ATT_WAITV(2); } while (0)
#define ATT_BAR() do { ATT_WAIT_PREV(); LDS_WAIT(); __builtin_amdgcn_s_barrier(); } while (0)
    unsigned rem_i = umask, rem_c = umask; int blk_i = 0, sub_i = 0, blk_c = 0, sub_c = 0;
    auto key_issue = [&](int t) -> int { if (MODE == 0) return 64 * t; if (sub_i == 0) { blk_i = __builtin_ctz(rem_i); rem_i &= rem_i - 1; } const int k0 = blk_i * 256 + sub_i * 64; sub_i = (sub_i + 1) & 3; return k0; };
    auto key_comp = [&](int t) -> int { if (MODE == 0) return 64 * t; if (sub_c == 0) { blk_c = __builtin_ctz(rem_c); rem_c &= rem_c - 1; } const int k0 = blk_c * 256 + sub_c * 64; sub_c = (sub_c + 1) & 3; return k0; };
    int key_last = 0;
    { const int k0 = key_issue(0); dma(k0, 0); const int k1 = key_issue(1); dma(k1, 1); const int k2 = key_issue(2); dma(k2, 2); const int k3 = key_issue(3); dma(k3, 3); key_last = k3; }
    int sl_c = 0, sl_n = 1, sl_d = 4;
    constexpr float THR = 8.0f;
    float mref = 0.f; bool started = false; f32x16 o[2]; o[0] = f32x16{}; o[1] = f32x16{}; float lsum = 0.f;
    bool mine = true;
    f32x16 negm = f32x16{}; asm volatile("" : "+v"(negm));
    auto set_negm = [&]() { const float c = mine ? -mref : -1e30f;
#pragma unroll
        for (int r = 0; r < 16; ++r) negm[r] = c; asm volatile("" : "+v"(negm)); };
    auto tile_active = [&](int key0) -> bool { bool a;
        if (MODE == 0) a = key0 <= q0 + wid * 32 + 31;
        else { const int n = key0 >> 8; a = __builtin_amdgcn_readfirstlane(__any((selmask >> n) & 1u)) != 0; if (n == own) a = a && (key0 <= q0 + wid * 32 + 31); }
        return a && !(var & 2); };
    auto new_block = [&](int key0) {
        if (MODE == 1 && (key0 & 255) == 0) { const bool mn_ = (selmask >> (key0 >> 8)) & 1u;
            if (__any(mn_ != mine)) { mine = mn_; set_negm(); } } };
    auto maskbias = [&](f32x16& P0, f32x16& P1, int key0, int g) {
        if (MODE == 0) {
            if (key0 + 63 > q0 + wid * 32) {
#pragma unroll
                for (int j = 0; j < 4; ++j) { const int r = 4 * g + j, kv = key0 + crow(r, hi); if (kv > qpos) P0[r] = -1e30f; if (kv + 32 > qpos) P1[r] = -1e30f; }
            }
        } else if (q0 + wid * 32 - key0 - 63 < 2047) {
            const int relb = qpos - key0 - 4 * hi; const LAS float* tb2 = (const LAS float*)(lds + A_TB) + (relb + 5);
#pragma unroll
            for (int j = 0; j < 4; ++j) { const int r = 4 * g + j, k = (r & 3) + 8 * (r >> 2); P0[r] += tb2[59 - k]; P1[r] += tb2[27 - k]; }
        } };
    auto decide = [&](f32x16& P0, f32x16& P1, float& alpha, bool& resc) {
        float rm = max3f(P0[0], P1[0], P0[1]), rm2 = max3f(P1[1], P0[2], P1[2]);
#pragma unroll
        for (int r = 3; r < 15; r += 2) { rm = max3f(rm, P0[r], P1[r]); rm2 = max3f(rm2, P0[r + 1], P1[r + 1]); }
        rm = max3f(rm, P0[15], P1[15]); rm = max3f(rm, rm2, rm2);
        rm = max_halves(rm);
        const bool live = rm > -1e29f; const bool need = live && (!started || rm > THR);
        alpha = 1.0f; resc = false;
        if (__any(need)) { const float delta = need ? rm : 0.f;
#pragma unroll
            for (int r = 0; r < 16; ++r) { P0[r] -= delta; P1[r] -= delta; }
            alpha = (need && started) ? __builtin_amdgcn_exp2f(-delta) : 1.0f; mref += delta; resc = true; set_negm(); }
        started = started || live; };
    ATT_BAR();
    f32x16 pa0 = f32x16{}, pa1 = f32x16{}, pb0 = f32x16{}, pb1 = f32x16{};
    int key_c = key_comp(0); bool act_c = tile_active(key_c); float alpha_c = 1.0f; bool resc_c = false;
    if (act_c) { new_block(key_c);
        const LAS unsigned char* kb = lds + 0 * A_SLOT + A_K + hi * 1024 + r32 * 16; bf16x8 kf[2 * ND0];
#pragma unroll
        for (int d0 = 0; d0 < ND0; ++d0) { kf[2 * d0] = *(const LAS bf16x8*)(kb + d0 * 2048); kf[2 * d0 + 1] = *(const LAS bf16x8*)(kb + d0 * 2048 + 512); }
        pa0 = __builtin_amdgcn_mfma_f32_32x32x16_bf16(kf[0], qr[0], negm, 0, 0, 0); pa1 = __builtin_amdgcn_mfma_f32_32x32x16_bf16(kf[1], qr[0], negm, 0, 0, 0);
#pragma unroll
        for (int d0 = 1; d0 < ND0; ++d0) { pa0 = __builtin_amdgcn_mfma_f32_32x32x16_bf16(kf[2 * d0], qr[d0], pa0, 0, 0, 0); pa1 = __builtin_amdgcn_mfma_f32_32x32x16_bf16(kf[2 * d0 + 1], qr[d0], pa1, 0, 0, 0); }
#pragma unroll
        for (int g = 0; g < 4; ++g) maskbias(pa0, pa1, key_c, g);
        decide(pa0, pa1, alpha_c, resc_c); }
#define ATT_BODY(PC0, PC1, PN0, PN1, AC, AN) do { \
          \
        float rs_ = 0.f; \
        bf16x8 kf[2][2];                        \
        const LAS unsigned char* kb = lds + sl_n * A_SLOT + A_K + hi * 1024 + r32 * 16; \
        if (AN) { new_block(key_n); kf[0][0] = *(const LAS bf16x8*)(kb); kf[0][1] = *(const LAS bf16x8*)(kb + 512); } \
        __builtin_amdgcn_sched_barrier(0); \
        _Pragma("unroll") for (int d0 = 0; d0 < ND0; ++d0) { \
            if (AN) { if (d0 + 1 < ND0) { kf[(d0 + 1) & 1][0] = *(const LAS bf16x8*)(kb + (d0 + 1) * 2048); kf[(d0 + 1) & 1][1] = *(const LAS bf16x8*)(kb + (d0 + 1) * 2048 + 512); } \
                if (d0 == 0) { PN0 = __builtin_amdgcn_mfma_f32_32x32x16_bf16(kf[0][0], qr[0], negm, 0, 0, 0); PN1 = __builtin_amdgcn_mfma_f32_32x32x16_bf16(kf[0][1], qr[0], negm, 0, 0, 0); } \
                else { PN0 = __builtin_amdgcn_mfma_f32_32x32x16_bf16(kf[d0 & 1][0], qr[d0], PN0, 0, 0, 0); PN1 = __builtin_amdgcn_mfma_f32_32x32x16_bf16(kf[d0 & 1][1], qr[d0], PN1, 0, 0, 0); } } \
            if (AC) { _Pragma("unroll") for (int e = (32 * d0) / ND0; e < (32 * (d0 + 1)) / ND0; ++e) { if (e < 16) { PC0[e] = __builtin_amdgcn_exp2f(PC0[e]); rs_ += PC0[e]; } else { PC1[e - 16] = __builtin_amdgcn_exp2f(PC1[e - 16]); rs_ += PC1[e - 16]; } } } \
            __builtin_amdgcn_sched_barrier(0); } \
        u32x4 pw[4]; v4i16_t vf[2][4];          \
        const LAS unsigned char* vp = lds + sl_c * A_SLOT + A_V + ((lane >> 4) & 1) * 32 + (lane & 3) * 8 + (4 * hi + ((lane & 15) >> 2)) * 64; \
        if (AC) { \
            lsum = lsum * alpha_c + rs_; \
            if (resc_c) { if (hi == 0) wsf[r32] = alpha_c; LDS_WAIT(); asm volatile("" ::: "memory"); \
                _Pragma("unroll") for (int g = 0; g < 4; ++g) { const f32x4 a4 = *(const LAS f32x4*)(wsf + 8 * g + 4 * hi); \
                    _Pragma("unroll") for (int j = 0; j < 4; ++j) { o[0][4 * g + j] *= a4[j]; o[1][4 * g + j] *= a4[j]; } } } \
            _Pragma("unroll") for (int d0 = 0; d0 < 2; ++d0) { vf[0][2 * d0] = __builtin_amdgcn_ds_read_tr16_b64_v4i16((LAS v4i16_t*)(vp + d0 * 4096)); vf[0][2 * d0 + 1] = __builtin_amdgcn_ds_read_tr16_b64_v4i16((LAS v4i16_t*)(vp + d0 * 4096 + 512)); } \
            _Pragma("unroll") for (int j = 0; j < 4; ++j) { pw[0][j] = cvtpk(PC0[2 * j], PC0[2 * j + 1]); pw[1][j] = cvtpk(PC0[8 + 2 * j], PC0[9 + 2 * j]); pw[2][j] = cvtpk(PC1[2 * j], PC1[2 * j + 1]); pw[3][j] = cvtpk(PC1[8 + 2 * j], PC1[9 + 2 * j]); } } \
        __builtin_amdgcn_sched_barrier(0); \
          \
        _Pragma("unroll") for (int ks = 0; ks < 4; ++ks) { \
            if (AC) { \
                if (ks + 1 < 4) { _Pragma("unroll") for (int d0 = 0; d0 < 2; ++d0) { vf[(ks + 1) & 1][2 * d0] = __builtin_amdgcn_ds_read_tr16_b64_v4i16((LAS v4i16_t*)(vp + d0 * 4096 + (ks + 1) * 1024)); vf[(ks + 1) & 1][2 * d0 + 1] = __builtin_amdgcn_ds_read_tr16_b64_v4i16((LAS v4i16_t*)(vp + d0 * 4096 + (ks + 1) * 1024 + 512)); } } \
                _Pragma("unroll") for (int d0 = 0; d0 < 2; ++d0) { const v4i16_t lo = vf[ks & 1][2 * d0], hv = vf[ks & 1][2 * d0 + 1]; \
                    const bf16x8 vfr = (bf16x8){lo[0], lo[1], lo[2], lo[3], hv[0], hv[1], hv[2], hv[3]}; \
                    o[d0] = __builtin_amdgcn_mfma_f32_32x32x16_bf16(__builtin_bit_cast(bf16x8, pw[ks]), vfr, o[d0], 0, 0, 0); } \
                } \
            if (AN) maskbias(PN0, PN1, key_n, ks); \
            __builtin_amdgcn_sched_barrier(0); } \
        alpha_c = 1.0f; resc_c = false; \
        if (AN) decide(PN0, PN1, alpha_c, resc_c); \
        } while (0)
#define ATT_STEP(PC0, PC1, PN0, PN1) do { \
        { int kn = key_last; if (t + 4 < NT) { kn = key_issue(t + 4); key_last = kn; } dma(kn, sl_d); } \
        const bool has_n = t + 1 < NT; const int key_n = has_n ? key_comp(t + 1) : 0; const bool act_n = has_n && tile_active(key_n); \
          \
        if (act_c && act_n) ATT_BODY(PC0, PC1, PN0, PN1, 1, 1); else if (act_c) ATT_BODY(PC0, PC1, PN0, PN1, 1, 0); else if (act_n) ATT_BODY(PC0, PC1, PN0, PN1, 0, 1); \
        if (!act_n) { alpha_c = 1.0f; resc_c = false; } \
        act_c = act_n; key_c = key_n; \
        sl_c = sl_n; sl_n = (sl_n == NSLOT - 1) ? 0 : sl_n + 1; sl_d = (sl_d == NSLOT - 1) ? 0 : sl_d + 1; \
        if (t & 1) ATT_BAR(); } while (0)
    for (int t = 0; t < NT; ++t) {
        ATT_STEP(pa0, pa1, pb0, pb1);
        pa0 = pb0; pa1 = pb1;
    }
#undef ATT_STEP
#undef ATT_BODY
    VM_WAIT(); LDS_WAIT(); __builtin_amdgcn_s_barrier();
#undef ATT_WAITV
#undef ATT_WAIT_PREV
#undef ATT_BAR
    bf16x8 gtv[4];
#pragma unroll
    for (int i = 0; i < 4; ++i) gtv[i] = *(const bf16x8*)(PROJ + (rowbase + q0 + wid * 32 + i * 8 + (lane >> 3)) * PROJ_LD + (MODE == 0 ? C_MGATE : C_CGATE) + 64 * h + (lane & 7) * 8);
    asm volatile("" ::: "memory");
    lsum += other_half(lsum);
    if (hi == 0) wsf[r32] = __builtin_amdgcn_rcpf(lsum);
    LDS_WAIT(); asm volatile("" ::: "memory");
    LAS float* stg = (LAS float*)(lds + A_OST + wid * A_OSTW);
#pragma unroll
    for (int g = 0; g < 4; ++g) { const f32x4 a4 = *(const LAS f32x4*)(wsf + 8 * g + 4 * hi);
#pragma unroll
        for (int j = 0; j < 4; ++j) { const int r = 4 * g + j, orow = crow(r, hi); stg[orow * 68 + r32] = o[0][r] * a4[j]; stg[orow * 68 + 32 + r32] = o[1][r] * a4[j]; } }
    LDS_WAIT(); asm volatile("" ::: "memory");
    bf16_t* Y = W_Y(ws); const int ycol = (MODE == 0 ? 0 : 768) + 64 * h, gcol = (MODE == 0 ? C_MGATE : C_CGATE) + 64 * h;
#pragma unroll
    for (int i = 0; i < 4; ++i) { const int row = i * 8 + (lane >> 3), c8 = (lane & 7) * 8; const size_t grow = rowbase + q0 + wid * 32 + row;
        const f32x4 a = *(const LAS f32x4*)(stg + row * 68 + c8), c = *(const LAS f32x4*)(stg + row * 68 + c8 + 4);
        const bf16x8 gt = gtv[i];
        u32x4 w; w.x = cvtpk(a[0] * siluf(bf2f((bf16_t)gt[0])), a[1] * siluf(bf2f((bf16_t)gt[1]))); w.y = cvtpk(a[2] * siluf(bf2f((bf16_t)gt[2])), a[3] * siluf(bf2f((bf16_t)gt[3])));
        w.z = cvtpk(c[0] * siluf(bf2f((bf16_t)gt[4])), c[1] * siluf(bf2f((bf16_t)gt[5]))); w.w = cvtpk(c[2] * siluf(bf2f((bf16_t)gt[6])), c[3] * siluf(bf2f((bf16_t)gt[7])));
        if (!(var & 4)) *(u32x4*)(Y + grow * LDY + ycol + c8) = w; }
    LDS_WAIT(); __syncthreads();
}
}
namespace gdn {
constexpr int CH_BYTES = 73728, O_WN = 0, O_QG = 16384, O_KE = 32768, O_AQK = 49152, O_U0 = 57344;
constexpr int P_Q = 0, P_K = 17408, P_V = 34816, P_L = 52224, P_AQ = 69632, P_XS = 78848  , XS_LD = 260, P_SC = 145408, P_DV = 146432  , DV_LD = 20, P_S1 = P_L  ;
static_assert(P_XS + 64 * XS_LD * 4 <= P_SC && P_SC + 1024 <= P_DV && P_DV + 4 * 16 * DV_LD * 4 <= LDS_MISC && P_S1 + 8 * 8448 <= P_SC, "prep LDS map");
__device__ __forceinline__ float silu_fast(float x) { return x * __builtin_amdgcn_rcpf(1.f + __expf(-x)); }
constexpr int QKV_LD = 136;
__device__ __forceinline__ int crow(int r, int hi) { return (r & 3) + 8 * (r >> 2) + 4 * hi; }

__device__ __forceinline__ void prep_load_raw(unsigned (&raw)[33], const bf16_t* PROJ, int b, int h, int n, int wid, int lane) {
#pragma unroll
    for (int rr = 0; rr < 11; ++rr) { const int t = n * 64 + 8 * wid - 3 + rr; const bf16_t* p = PROJ + ((size_t)b * SEQ + (t < 0 ? 0 : t)) * PROJ_LD + h * 128 + 2 * lane;
#pragma unroll
        for (int a = 0; a < 3; ++a) raw[rr * 3 + a] = *(const unsigned*)(p + (a == 0 ? C_GQ : a == 1 ? C_GK : C_GV)); }
}
__device__ __forceinline__ void prep_chunk(const Frame& F0, int l, int b, int h, int n, unsigned (&rawreg)[33], bool has_next, int nb, int nh, int nn, int var = 0) {
    const Frame F = opaque(F0);
    const int lane = F.lane, wid = F.wave, tid = F.tid, r32 = lane & 31, hi = lane >> 5;
    LAS unsigned char* lds = F.lds; unsigned char* ws = F.ws;
    const bf16_t* PROJ = W_PROJ(ws);
    const int t0 = n * 64; const size_t rowb = (size_t)b * SEQ;
    unsigned char* G = ws + WS_GDN + (size_t)((b * 4 + h) * 128 + n) * CH_BYTES;
    LAS float* SC = (LAS float*)(lds + P_SC);
    kargs_t ka = kargs();
    const bf16_t* pba = PROJ + (rowb + t0 + lane) * PROJ_LD; const bf16_t bb_raw = pba[C_GB + h], aa_raw = pba[C_GA + h]; const float dtb_ = IN_DTB(ka)[l * 4 + h], alog_ = IN_ALOG(ka)[l * 4 + h];
#ifdef PROBE_STAMP
    unsigned long long tsp[8]; int tsi = 0; unsigned long long ts_mid = 0;
#define PST() do { asm volatile("s_waitcnt vmcnt(0) lgkmcnt(0)" ::: "memory"); tsp[tsi++] = __builtin_amdgcn_s_memtime(); } while (0)
    PST();
#else
#define PST() do {} while (0)
#endif
    if (!(var & 1)) {
        const float* cw = IN_CONVW(ka) + (size_t)l * 4 * 1536 + h * 128 + 2 * lane;
        float w[3][4][2];
#pragma unroll
        for (int a = 0; a < 3; ++a)
#pragma unroll
            for (int j = 0; j < 4; ++j) { const f32x2 v = *(const f32x2*)(cw + j * 1536 + a * 512); w[a][j][0] = v[0]; w[a][j][1] = v[1]; }
        LAS unsigned* raw = (LAS unsigned*)(lds + P_S1 + wid * 8448) + lane;
        {
#pragma unroll
          for (int q = 0; q < 33; ++q) raw[q * 64] = rawreg[q];
          if (n == 0 && wid == 0) {
#pragma unroll
              for (int q = 0; q < 9; ++q) raw[q * 64] = 0u; } }
        if (has_next) prep_load_raw(rawreg, PROJ, nb, nh, nn, wid, lane);
        LDS_WAIT();
#ifdef PROBE_STAMP
        asm volatile("s_waitcnt vmcnt(0) lgkmcnt(0)" ::: "memory"); ts_mid = __builtin_amdgcn_s_memtime();
#endif
#pragma unroll 1
        for (int i = 0; i < 8; ++i) { float r0[3], r1[3];
#pragma unroll
            for (int a = 0; a < 3; ++a) { float s0 = 0.f, s1 = 0.f;
#pragma unroll
                for (int j = 0; j < 4; ++j) { const unsigned v = raw[((i + j) * 3 + a) * 64]; s0 += w[a][j][0] * bf2f((bf16_t)(v & 0xffff)); s1 += w[a][j][1] * bf2f((bf16_t)(v >> 16)); }
                r0[a] = silu_fast(s0); r1[a] = silu_fast(s1); }
            const float nq = rsqrtf(wave_sum(r0[0] * r0[0] + r1[0] * r1[0]) + 1e-6f) * 0.08838834764831845f, nk = rsqrtf(wave_sum(r0[1] * r0[1] + r1[1] * r1[1]) + 1e-6f);
            const int row = 8 * wid + i;
            *(LAS unsigned*)(lds + P_Q + row * 272 + 4 * lane) = cvtpk(r0[0] * nq, r1[0] * nq);
            *(LAS unsigned*)(lds + P_K + row * 272 + 4 * lane) = cvtpk(r0[1] * nk, r1[1] * nk);
            *(LAS unsigned*)(lds + P_V + row * 272 + 4 * lane) = cvtpk(r0[2], r1[2]); }
    }
    PST();
    if (wid == 0) {
        const float bb = bf2f(bb_raw), aa = bf2f(aa_raw) + dtb_;
        const float beta = 1.f / (1.f + __expf(-bb)), sp = (aa > 20.f) ? aa : __logf(1.f + __expf(aa));
        float g = -__expf(alog_) * sp;
#pragma unroll
        for (int o = 1; o < 64; o <<= 1) { const float v = __shfl_up(g, o); if (lane >= o) g += v; }
        const float gl = __shfl(g, 63);
        SC[lane] = g; SC[64 + lane] = beta; SC[128 + lane] = __expf(g); SC[192 + lane] = __expf(gl - g);
        if (lane == 63 && !(var & 32)) ((float*)(ws + WS_GEND))[(b * 4 + h) * 128 + n] = __expf(gl);
    }
    LDS_WAIT(); __builtin_amdgcn_s_barrier(); asm volatile("" ::: "memory");
    PST();
    if (!(var & 2)) {
        const int which = wid >> 2, ti = (wid >> 1) & 1, tj = wid & 1;
        f32x16 acc = f32x16{};
        if (ti >= tj) {
            const LAS unsigned char* ap = lds + (which ? P_Q : P_K) + (32 * ti + r32) * 272 + hi * 16; const LAS unsigned char* bp = lds + P_K + (32 * tj + r32) * 272 + hi * 16;
#pragma unroll
            for (int ks = 0; ks < 8; ++ks) acc = __builtin_amdgcn_mfma_f32_32x32x16_bf16(*(const LAS bf16x8*)(ap + ks * 32), *(const LAS bf16x8*)(bp + ks * 32), acc, 0, 0, 0);
        }
        const int j = 32 * tj + r32; const float gj = SC[j];
#pragma unroll
        for (int r = 0; r < 16; ++r) { const int i = 32 * ti + crow(r, hi); const float d = __expf(i >= j ? SC[i] - gj : 0.f);
            if (which == 0) *(LAS float*)(lds + P_L + (i * 68 + j) * 4) = (i > j) ? SC[64 + i] * acc[r] * d : 0.f;
            else *(LAS bf16_t*)(lds + P_AQ + (i * 72 + j) * 2) = (bf16_t)f2bf((i >= j) ? acc[r] * d : 0.f); }
    }
    LDS_WAIT(); __builtin_amdgcn_s_barrier(); asm volatile("" ::: "memory");
    PST();
    if (wid < 4 && !(var & 8)) { const int ib = wid, c = lane & 15;
        float m[16]; f32x4 Ld[2][4];
#pragma unroll
        for (int jc = 0; jc < 4; ++jc) { Ld[0][jc] = (f32x4){0.f, 0.f, 0.f, 0.f}; Ld[1][jc] = (f32x4){0.f, 0.f, 0.f, 0.f}; }
#pragma unroll
        for (int r = 0; r < 16; ++r) {
            if (r + 1 < 16) { const LAS f32x4* Lr = (const LAS f32x4*)(lds + P_L + (16 * ib + r + 1) * 272 + 64 * ib);
#pragma unroll
                for (int jc = 0; jc < (r + 1 + 3) / 4; ++jc) Ld[(r + 1) & 1][jc] = Lr[jc]; }
            float a = (r == c) ? 1.f : 0.f, a1 = 0.f;
#pragma unroll
            for (int jc = 0; jc < (r + 3) / 4; ++jc)
#pragma unroll
                for (int jj = 0; jj < 4; ++jj) if (4 * jc + jj < r) { if (jj & 1) a1 -= Ld[r & 1][jc][jj] * m[4 * jc + jj]; else a -= Ld[r & 1][jc][jj] * m[4 * jc + jj]; }
            m[r] = a + a1; asm volatile("" ::: "memory"); }
        if (lane < 16) { LAS float* dv = (LAS float*)(lds + P_DV) + ib * 16 * DV_LD + c;
#pragma unroll
            for (int r = 0; r < 16; ++r) dv[r * DV_LD] = m[r]; }
    }
    if (!(var & 4)) {
        const int t4 = tid;
#pragma unroll
        for (int it = 0; it < 2; ++it) {
            const int p = it * 512 + t4, f = p >> 6, ln = p & 63, mt = f & 1, s = (f >> 1) & 1, kt = f >> 2, hh = ln >> 5, r = ln & 31, row = 32 * mt + r, k0 = 32 * kt + 16 * s + 4 * hh;
            const u32x2 a = *(const LAS u32x2*)(lds + P_Q + row * 272 + k0 * 2), c2 = *(const LAS u32x2*)(lds + P_Q + row * 272 + k0 * 2 + 16); const float e = SC[128 + row];
            u32x4 o; o.x = cvtpk(bf2f((bf16_t)(a.x & 0xffff)) * e, bf2f((bf16_t)(a.x >> 16)) * e); o.y = cvtpk(bf2f((bf16_t)(a.y & 0xffff)) * e, bf2f((bf16_t)(a.y >> 16)) * e);
            o.z = cvtpk(bf2f((bf16_t)(c2.x & 0xffff)) * e, bf2f((bf16_t)(c2.x >> 16)) * e); o.w = cvtpk(bf2f((bf16_t)(c2.y & 0xffff)) * e, bf2f((bf16_t)(c2.y >> 16)) * e);
            if (!(var & 32)) *(u32x4*)(G + O_QG + p * 16) = o; }
#pragma unroll
        for (int it = 0; it < 2; ++it) {
            const int p = it * 512 + t4, f = p >> 6, ln = p & 63, mt = f & 3, s = (f >> 2) & 1, kt = f >> 3, hh = ln >> 5, r = ln & 31, dk = 32 * mt + r, p0 = 32 * kt + 16 * s + 4 * hh;
            float v[8];
#pragma unroll
            for (int j = 0; j < 8; ++j) { const int pos = p0 + 8 * (j >> 2) + (j & 3); v[j] = bf2f(*(const LAS bf16_t*)(lds + P_K + pos * 272 + dk * 2)) * SC[192 + pos]; }
            u32x4 o; o.x = cvtpk(v[0], v[1]); o.y = cvtpk(v[2], v[3]); o.z = cvtpk(v[4], v[5]); o.w = cvtpk(v[6], v[7]);
            if (!(var & 32)) *(u32x4*)(G + O_KE + p * 16) = o; }
    }
    LDS_WAIT(); __builtin_amdgcn_s_barrier(); asm volatile("" ::: "memory");
    if (!(var & 8)) {
        LAS float* XSb = (LAS float*)(lds + P_XS);
        const int nq = lane & 15, kq = lane >> 4;
        float avL[6][4], mv[4][4]; f32x4 rhs[4][2];
#pragma unroll
        for (int ib = 1; ib < 4; ++ib)
#pragma unroll
            for (int jb = 0; jb < ib; ++jb)
#pragma unroll
                for (int ks = 0; ks < 4; ++ks) avL[ib * (ib - 1) / 2 + jb][ks] = -*(const LAS float*)(lds + P_L + ((16 * ib + nq) * 68 + 16 * jb + 4 * ks + kq) * 4);
#pragma unroll
        for (int ib = 0; ib < 4; ++ib)
#pragma unroll
            for (int ks = 0; ks < 4; ++ks) mv[ib][ks] = *(const LAS float*)(lds + P_DV + ((ib * 16 + nq) * DV_LD + 4 * ks + kq) * 4);
#pragma unroll
        for (int ib = 0; ib < 4; ++ib)
#pragma unroll
            for (int r = 0; r < 4; ++r) { const int i = 16 * ib + 4 * kq + r; const float be = SC[64 + i], eg = SC[128 + i];
#pragma unroll
                for (int nt = 0; nt < 2; ++nt) { const int ncol0 = 32 * wid + 16 * nt; const bool isw = ncol0 < 128;
                    const float kv = bf2f(*(const LAS bf16_t*)(lds + (isw ? P_K + 2 * (ncol0 + nq) : P_V + 2 * (ncol0 - 128 + nq)) + i * 272));
                    rhs[ib][nt][r] = kv * be * (isw ? eg : 1.f); } }
        float xB[3][2][4];
#pragma unroll
        for (int ib = 0; ib < 4; ++ib) {
            f32x4 acc0 = rhs[ib][0], acc1 = rhs[ib][1];
#pragma unroll
            for (int jb = 0; jb < ib; ++jb)
#pragma unroll
                for (int ks = 0; ks < 4; ++ks) { acc0 = __builtin_amdgcn_mfma_f32_16x16x4f32(avL[ib * (ib - 1) / 2 + jb][ks], xB[jb][0][ks], acc0, 0, 0, 0); acc1 = __builtin_amdgcn_mfma_f32_16x16x4f32(avL[ib * (ib - 1) / 2 + jb][ks], xB[jb][1][ks], acc1, 0, 0, 0); }
#pragma unroll
            for (int r = 0; r < 4; ++r) { XSb[(16 * ib + 4 * kq + r) * XS_LD + 32 * wid + nq] = acc0[r]; XSb[(16 * ib + 4 * kq + r) * XS_LD + 32 * wid + 16 + nq] = acc1[r]; }
            asm volatile("" ::: "memory");
            float rv[2][4];
#pragma unroll
            for (int ks = 0; ks < 4; ++ks) { rv[0][ks] = XSb[(16 * ib + 4 * ks + kq) * XS_LD + 32 * wid + nq]; rv[1][ks] = XSb[(16 * ib + 4 * ks + kq) * XS_LD + 32 * wid + 16 + nq]; }
            f32x4 x0 = (f32x4){0.f, 0.f, 0.f, 0.f}, x1 = (f32x4){0.f, 0.f, 0.f, 0.f};
#pragma unroll
            for (int ks = 0; ks < 4; ++ks) { x0 = __builtin_amdgcn_mfma_f32_16x16x4f32(mv[ib][ks], rv[0][ks], x0, 0, 0, 0); x1 = __builtin_amdgcn_mfma_f32_16x16x4f32(mv[ib][ks], rv[1][ks], x1, 0, 0, 0); }
            asm volatile("" ::: "memory");
#pragma unroll
            for (int r = 0; r < 4; ++r) { XSb[(16 * ib + 4 * kq + r) * XS_LD + 32 * wid + nq] = x0[r]; XSb[(16 * ib + 4 * kq + r) * XS_LD + 32 * wid + 16 + nq] = x1[r]; }
            asm volatile("" ::: "memory");
            if (ib < 3) {
#pragma unroll
                for (int ks = 0; ks < 4; ++ks) { xB[ib][0][ks] = XSb[(16 * ib + 4 * ks + kq) * XS_LD + 32 * wid + nq]; xB[ib][1][ks] = XSb[(16 * ib + 4 * ks + kq) * XS_LD + 32 * wid + 16 + nq]; } }
        }
    }
    LDS_WAIT(); __builtin_amdgcn_s_barrier(); asm volatile("" ::: "memory");
    PST();
    if (!(var & 16)) {
#pragma unroll
    for (int it = 0; it < 2; ++it) {
        const int p = it * 512 + tid, f = p >> 6, ln = p & 63, mt = f & 1, s = (f >> 1) & 1, kt = f >> 2, hh = ln >> 5, r = ln & 31, row = 32 * mt + r, k0 = 32 * kt + 16 * s + 4 * hh;
        const f32x4 a = *(const LAS f32x4*)(lds + P_XS + (row * XS_LD + k0) * 4), c2 = *(const LAS f32x4*)(lds + P_XS + (row * XS_LD + k0 + 8) * 4);
        u32x4 o; o.x = cvtpk(-a[0], -a[1]); o.y = cvtpk(-a[2], -a[3]); o.z = cvtpk(-c2[0], -c2[1]); o.w = cvtpk(-c2[2], -c2[3]);
        if (!(var & 32)) *(u32x4*)(G + O_WN + p * 16) = o; }
    {
        const int p = tid, f = p >> 6, ln = p & 63, mt = f & 1, s = (f >> 1) & 1, kt = f >> 2, hh = ln >> 5, r = ln & 31, row = 32 * mt + r, k0 = 32 * kt + 16 * s + 4 * hh;
        const u32x2 a = *(const LAS u32x2*)(lds + P_AQ + row * 144 + k0 * 2), c2 = *(const LAS u32x2*)(lds + P_AQ + row * 144 + k0 * 2 + 16);
        if (!(var & 32)) *(u32x4*)(G + O_AQK + p * 16) = (u32x4){a.x, a.y, c2.x, c2.y}; }
#pragma unroll
    for (int it = 0; it < 2; ++it) {
        const int p = it * 512 + tid, part = p & 1, q = p >> 1, l2 = q & 63, wm = q >> 6, w = wm >> 1, mt = wm & 1, hh = l2 >> 5, cc = l2 & 31;
        const LAS float* xs = (const LAS float*)(lds + P_XS) + 128 + 32 * w + cc; float v[8];
#pragma unroll
        for (int e = 0; e < 8; ++e) v[e] = xs[(32 * mt + crow(8 * part + e, hh)) * XS_LD];
        u32x4 o; o.x = cvtpk(v[0], v[1]); o.y = cvtpk(v[2], v[3]); o.z = cvtpk(v[4], v[5]); o.w = cvtpk(v[6], v[7]);
        if (!(var & 32)) *(u32x4*)(G + O_U0 + p * 16) = o; }
    }
    LDS_WAIT(); __builtin_amdgcn_s_barrier(); asm volatile("" ::: "memory");
    PST();
#ifdef PROBE_STAMP
    if (b == 0 && h == 0 && n == 5 && wid == PROBE_STAMP_WAVE && lane == 0) { float* st = (float*)(ws + WS_CTL + 800000) + 16;
        for (int i = 0; i < 5; ++i) st[i] = (float)(tsp[i + 1] - tsp[i]); st[5] = (float)(tsp[5] - tsp[0]); st[6] = (float)(ts_mid - tsp[0]); }
#endif
#undef PST
}

__device__ __forceinline__ void gdn_finalize(const Frame& F0, int l) {
    const Frame F = opaque(F0);
    const int lane = F.lane, hd = lane >> 4, gw = F.bx * NWAVES + F.wave, NGW = F.G * NWAVES;
    const bf16_t* PROJ = W_PROJ(F.ws); bf16_t* Y = W_Y(F.ws); const bf16_t* OUTG = (const bf16_t*)(F.ws + WS_OUTG);
    kargs_t ka = kargs(); const f32x4 n0 = *(const f32x4*)(IN_GNORM(ka) + l * 128 + 8 * (lane & 15)), n1 = *(const f32x4*)(IN_GNORM(ka) + l * 128 + 8 * (lane & 15) + 4);
    for (int row0 = gw * 4; row0 < M_TOK; row0 += NGW * 4) {
        bf16x8 ovr[4], zvr[4];
#pragma unroll
        for (int r = 0; r < 4; ++r) { ovr[r] = *(const bf16x8*)(OUTG + (size_t)(row0 + r) * 512 + 8 * lane); zvr[r] = *(const bf16x8*)(PROJ + (size_t)(row0 + r) * PROJ_LD + C_GZ + 8 * lane); }
#pragma unroll
        for (int r = 0; r < 4; ++r) { const int row = row0 + r; const bf16x8 ov = ovr[r], zv = zvr[r];
        float o[8]; float ss = 0.f;
#pragma unroll
        for (int j = 0; j < 8; ++j) { o[j] = bf2f((bf16_t)ov[j]); ss += o[j] * o[j]; }
        ss += __builtin_bit_cast(float, __builtin_amdgcn_update_dpp(0, __builtin_bit_cast(int, ss), 0x111, 0xf, 0xf, true));
        ss += __builtin_bit_cast(float, __builtin_amdgcn_update_dpp(0, __builtin_bit_cast(int, ss), 0x112, 0xf, 0xf, true));
        ss += __builtin_bit_cast(float, __builtin_amdgcn_update_dpp(0, __builtin_bit_cast(int, ss), 0x114, 0xf, 0xf, true));
        ss += __builtin_bit_cast(float, __builtin_amdgcn_update_dpp(0, __builtin_bit_cast(int, ss), 0x118, 0xf, 0xf, true));
        const int sb = __builtin_bit_cast(int, ss);
        const float t0 = __builtin_bit_cast(float, __builtin_amdgcn_readlane(sb, 15)), t1 = __builtin_bit_cast(float, __builtin_amdgcn_readlane(sb, 31)), t2 = __builtin_bit_cast(float, __builtin_amdgcn_readlane(sb, 47)), t3 = __builtin_bit_cast(float, __builtin_amdgcn_readlane(sb, 63));
        const float tot = hd == 0 ? t0 : hd == 1 ? t1 : hd == 2 ? t2 : t3, rs = rsqrtf(tot * (1.f / 128.f) + RMS_EPS);
        u32x4 w; w.x = cvtpk(o[0] * rs * n0[0] * silu_fast(bf2f((bf16_t)zv[0])), o[1] * rs * n0[1] * silu_fast(bf2f((bf16_t)zv[1]))); w.y = cvtpk(o[2] * rs * n0[2] * silu_fast(bf2f((bf16_t)zv[2])), o[3] * rs * n0[3] * silu_fast(bf2f((bf16_t)zv[3])));
        w.z = cvtpk(o[4] * rs * n1[0] * silu_fast(bf2f((bf16_t)zv[4])), o[5] * rs * n1[1] * silu_fast(bf2f((bf16_t)zv[5]))); w.w = cvtpk(o[6] * rs * n1[2] * silu_fast(bf2f((bf16_t)zv[6])), o[7] * rs * n1[3] * silu_fast(bf2f((bf16_t)zv[7])));
        *(u32x4*)(Y + (size_t)row * LDY + 256 + 8 * lane) = w; }
    }
}
__device__ __forceinline__ void kmean_item(const Frame& F0, int item) {
    const Frame F = opaque(F0);
    const int tid = F.tid, n = item & 31, h = (item >> 5) & 3, b = item >> 7, rg = tid >> 3, c8 = (tid & 7) * 8;
    const bf16_t* p = W_PROJ(F.ws) + ((size_t)b * SEQ + n * 256 + rg * 4) * PROJ_LD + C_CK + 64 * h + c8;
    float s[8] = {0.f, 0.f, 0.f, 0.f, 0.f, 0.f, 0.f, 0.f};
#pragma unroll
    for (int i = 0; i < 4; ++i) { const bf16x8 v = *(const bf16x8*)(p + (size_t)i * PROJ_LD);
#pragma unroll
        for (int j = 0; j < 8; ++j) s[j] += bf2f((bf16_t)v[j]); }
    LAS float* part = (LAS float*)F.lds;
#pragma unroll
    for (int j = 0; j < 8; ++j) part[rg * 64 + c8 + j] = s[j];
    LDS_WAIT(); __syncthreads();
    if (tid < 64) { float a = 0.f;
#pragma unroll 8
        for (int g = 0; g < 64; ++g) a += part[g * 64 + tid];
        W_KM(F.ws)[(size_t)item * 64 + tid] = a * (1.f / 256.f); }
    LDS_WAIT(); __syncthreads();
}
}
namespace gdn {
constexpr int S_BUFSZ = 57344, S_OST = 2 * S_BUFSZ, S_OSTSZ = 17408;
static_assert(S_OST + 2 * S_OSTSZ <= LDS_MISC, "scan LDS map");
__device__ __forceinline__ bf16x8 pack8(const f32x16& v, int s) {
    u32x4 w; w.x = cvtpk(v[8 * s], v[8 * s + 1]); w.y = cvtpk(v[8 * s + 2], v[8 * s + 3]); w.z = cvtpk(v[8 * s + 4], v[8 * s + 5]); w.w = cvtpk(v[8 * s + 6], v[8 * s + 7]);
    return __builtin_bit_cast(bf16x8, w);
}
__device__ __forceinline__ void scan_chain(const Frame& F0, int l, int bh, int var = 0) {
    const Frame F = opaque(F0);
    const int lane = F.lane, wid = F.wave, r32 = lane & 31, hi = lane >> 5, b = bh >> 2, h = bh & 3;
    LAS unsigned char* lds = F.lds; unsigned char* ws = F.ws;
    const unsigned char* Gb = ws + WS_GDN + (size_t)(bh * 128) * CH_BYTES;
    if (wid >= 4) {
        const int hw = wid - 4; const size_t rb = (size_t)b * SEQ;
        const unsigned lds0 = (unsigned)(__UINTPTR_TYPE__)lds, dummy = lds0 + LDS_MISC + 512 + hw * 256;
        auto touch = [&](int c) { const unsigned char* Gc = Gb + (size_t)(c > 127 ? 127 : c) * CH_BYTES;
#pragma unroll
            for (int j = 0; j < 5; ++j) { int line = (j * 4 + hw) * 64 + lane; line = line > 1151 ? 1151 : line; att::glds4(Gc + (size_t)line * 64, (unsigned)__builtin_amdgcn_readfirstlane(dummy)); } };
        auto dma = [&](int c, unsigned dst) { const unsigned char* Gc = Gb + (size_t)c * CH_BYTES;
#pragma unroll
            for (int j = 0; j < 14; ++j) { const int pc = hw + 4 * j; att::glds16(Gc + pc * 1024 + lane * 16, (unsigned)__builtin_amdgcn_readfirstlane(dst + pc * 1024)); } };
        bf16_t* OUTG = (bf16_t*)(ws + WS_OUTG) + 128 * h + 32 * (lane & 3);
        auto copy_out = [&](int c) {
            const LAS u32x4* o4 = (const LAS u32x4*)(lds + S_OST + (c & 1) * S_OSTSZ + (16 * hw + (lane >> 2)) * 272 + 64 * (lane & 3));
            u32x4* g = (u32x4*)(OUTG + (rb + c * 64 + 16 * hw + (lane >> 2)) * 512);
            const u32x4 v0 = o4[0], v1 = o4[1], v2 = o4[2], v3 = o4[3]; g[0] = v0; g[1] = v1; g[2] = v2; g[3] = v3; };
        touch(1); touch(2); dma(0, lds0);
        VM_WAIT(); __builtin_amdgcn_s_barrier();
        for (int n = 0; n < 128; ++n) {
            if (n + 1 < 128 && !(var & 1)) dma(n + 1, lds0 + ((n + 1) & 1) * S_BUFSZ);
            touch(n + 3);
            asm volatile("s_waitcnt vmcnt(5)" ::: "memory");
            if (n >= 1 && !(var & 34)) copy_out(n - 1);
            LDS_WAIT(); __builtin_amdgcn_s_barrier();
        }
        if (!(var & 34)) copy_out(127);
    } else {
        const int w = wid; const float* GE = (const float*)(ws + WS_GEND) + bh * 128; const float ge_lo = GE[lane], ge_hi = GE[64 + lane];
        f32x16 S[4]; S[0] = f32x16{}; S[1] = f32x16{}; S[2] = f32x16{}; S[3] = f32x16{};
        u32x4 u0n[4];
#pragma unroll
        for (int mt = 0; mt < 2; ++mt) { const u32x4* p = (const u32x4*)(Gb + O_U0 + ((w * 2 + mt) * 64 + lane) * 32); u0n[2 * mt] = p[0]; u0n[2 * mt + 1] = p[1]; }
        VM_WAIT(); __builtin_amdgcn_s_barrier();
        for (int n = 0; n < 128; ++n) {
            LAS unsigned char* ost = lds + S_OST + (n & 1) * S_OSTSZ;
            const LAS unsigned char* B = lds + (n & 1) * S_BUFSZ + lane * 16;
            const float ge = __builtin_bit_cast(float, __builtin_amdgcn_readlane(__builtin_bit_cast(int, (n < 64) ? ge_lo : ge_hi), n & 63));
            f32x16 U[2], O[2];
#pragma unroll
            for (int mt = 0; mt < 2; ++mt)
#pragma unroll
                for (int q = 0; q < 4; ++q) { const unsigned v0 = u0n[2 * mt][q], v1 = u0n[2 * mt + 1][q];
                    U[mt][2 * q] = bf2f((bf16_t)(v0 & 0xffff)); U[mt][2 * q + 1] = bf2f((bf16_t)(v0 >> 16)); U[mt][8 + 2 * q] = bf2f((bf16_t)(v1 & 0xffff)); U[mt][9 + 2 * q] = bf2f((bf16_t)(v1 >> 16)); }
            if (n + 1 < 128 && !(var & 16)) {
#pragma unroll
                for (int mt = 0; mt < 2; ++mt) { const u32x4* p = (const u32x4*)(Gb + (size_t)(n + 1) * CH_BYTES + O_U0 + ((w * 2 + mt) * 64 + lane) * 32); u0n[2 * mt] = p[0]; u0n[2 * mt + 1] = p[1]; }
            }
            O[0] = f32x16{}; O[1] = f32x16{};
            if (!(var & 4)) {
#pragma unroll
            for (int kt = 0; kt < 4; ++kt)
#pragma unroll
                for (int s = 0; s < 2; ++s) { const bf16x8 sb = pack8(S[kt], s);
#pragma unroll
                    for (int mt = 0; mt < 2; ++mt) { const int f = (kt * 2 + s) * 2 + mt;
                        U[mt] = __builtin_amdgcn_mfma_f32_32x32x16_bf16(*(const LAS bf16x8*)(B + O_WN + f * 1024), sb, U[mt], 0, 0, 0);
                        O[mt] = __builtin_amdgcn_mfma_f32_32x32x16_bf16(*(const LAS bf16x8*)(B + O_QG + f * 1024), sb, O[mt], 0, 0, 0); }
                    asm volatile("" ::: "memory"); }
#pragma unroll
            for (int mt = 0; mt < 4; ++mt) S[mt] = S[mt] * ge;
#pragma unroll
            for (int kt = 0; kt < 2; ++kt)
#pragma unroll
                for (int s = 0; s < 2; ++s) { const bf16x8 ub = pack8(U[kt], s);
#pragma unroll
                    for (int mt = 0; mt < 2; ++mt) O[mt] = __builtin_amdgcn_mfma_f32_32x32x16_bf16(*(const LAS bf16x8*)(B + O_AQK + ((kt * 2 + s) * 2 + mt) * 1024), ub, O[mt], 0, 0, 0);
#pragma unroll
                    for (int mt = 0; mt < 4; ++mt) S[mt] = __builtin_amdgcn_mfma_f32_32x32x16_bf16(*(const LAS bf16x8*)(B + O_KE + ((kt * 2 + s) * 4 + mt) * 1024), ub, S[mt], 0, 0, 0);
                    asm volatile("" ::: "memory"); }
            }
            if (!(var & 8))
#pragma unroll
            for (int mt = 0; mt < 2; ++mt)
#pragma unroll
                for (int r = 0; r < 16; ++r) *(LAS bf16_t*)(ost + (32 * mt + crow(r, hi)) * 272 + (32 * w + r32) * 2) = (bf16_t)f2bf(O[mt][r]);
            LDS_WAIT(); __builtin_amdgcn_s_barrier(); asm volatile("" ::: "memory");
        }
    }
    LDS_WAIT(); VM_WAIT(); __syncthreads();
}
}
#ifndef PROBE_XA
#define PROBE_XA 0
#endif
#ifndef PROBE_XB
#define PROBE_XB 0
#endif
#ifndef PROBE_XC
#define PROBE_XC 0
#endif
#ifndef PROBE_XD
#define PROBE_XD 0
#endif
#ifndef PROBE_PREP_VAR
#define PROBE_PREP_VAR 0
#endif
#ifndef PROBE_PB_PARTS
#define PROBE_PB_PARTS 7
#endif
#ifndef PROBE_ATT_VAR
#define PROBE_ATT_VAR 0
#endif
#ifndef PROBE_SCAN_VAR
#define PROBE_SCAN_VAR 0
#endif
#ifndef PROBE_PC_PARTS
#define PROBE_PC_PARTS 7
#endif
__global__ void __launch_bounds__(NTHREADS, 2) skel_fwd(Args args) {
    extern __shared__ __attribute__((aligned(16))) unsigned char lds_raw[];
    Frame F_;
    F_.lds = (LAS unsigned char*)lds_raw; F_.tid = threadIdx.x; F_.lane = F_.tid & 63; F_.wave = __builtin_amdgcn_readfirstlane(F_.tid >> 6); F_.G = gridDim.x; F_.bx = blockIdx.x; F_.ws = args.ws;
    unsigned char* ws0 = args.ws;
    unsigned* ctl = (unsigned*)(ws0 + WS_CTL);
    volatile LAS unsigned* MISC = (volatile LAS unsigned*)(F_.lds + LDS_MISC);
    for (int u = F_.tid; u < 64; u += NTHREADS) MISC[u] = 0u;
    __syncthreads();
    const int lo = args.ph_lo, hi = args.ph_hi;
    const bool multi = (hi - lo) > 1;
    XcdBarrier bar; bar.bar = ctl + CW_BAR + lo * XCD_BAR_WORDS; bar.x = 0; bar.st = nullptr;
    if (multi) bar = xcd_barrier_post(ctl + CW_BAR + lo * XCD_BAR_WORDS, MISC + 8, F_.tid == 0);
    for (int ph = lo; ph < hi; ++ph) {
        const Frame F = opaque(F_);
        if (ph == 0) {
            p0_prologue(F, kargs());
        } else if (ph == N_PHASES - 1) {
            { kargs_t ka = kargs(); final_norm(F, ka->out, IN_FNORM(ka)); }
#ifdef PROBE_STAMP
            if (F.bx == 0) { VM_WAIT(); __syncthreads(); if (F.tid == 0) { kargs_t ka = kargs(); ka->out[0] = exp2f(__builtin_rintf(log2f(((const float*)(F.ws + WS_CTL + 800000))[PROBE_STAMP] + 1.0f) * 2.0f) * 0.5f); } }
#endif
        } else {
            const int l = (ph - 1) >> 2, sub = (ph - 1) & 3;
            unsigned char* ws = F.ws; asm volatile("" : "+s"(ws));
            const int nrep = 1 + (sub == 0 ? PROBE_XA : sub == 1 ? PROBE_XB : sub == 2 ? PROBE_XC : (l == 0 ? PROBE_XD : 0));
            for (int rep = 0; rep < nrep; ++rep) {
            if (rep) xcd_barrier(bar, opaque(F_).tid == 0);
            if (sub == 0) {
                if (l > 0) { convert_weights(F, kargs(), l, 2); }
                VM_WAIT(); __syncthreads();
                pg8::Gemm g{W_XB(ws), W_WIN(ws), 1024, 1024, 1024}; pg8::StaticOrder S; S.init(M_TOK, 3840, F.G, F.bx);
                pg8::EpiProj E{W_PROJ(ws), W_SSQ(ws)};
                pg8::gemm_phase<pg8::EpiProj, pg8::StaticOrder>(F.lds, g, S, E, F.wave);
            } else if (sub == 1) {
                const int parts = rep ? PROBE_PB_PARTS : 7;
                if (F.G == 256 && (parts & 1)) {
                    const bool isq = F.bx < 128; const int ui = isq ? F.bx : F.bx - 128, pm = ui >> 1, pn = ui & 1;
                    pb_prepass(F, pm, (!isq) && pn == 0);
                    LDS_WAIT(); VM_WAIT(); __syncthreads();
                    const LAS float* RS = (const LAS float*)(F.lds + LDS_RS);
                    { pg8::Gemm g{W_PROJ(ws) + C_MCQ, W_WUQ(ws), PROJ_LD, 256, 256}; pg8::OneUnit S{pm, pn, isq}; pg8::EpiQ E{W_Q(ws), RS, W_COS(ws), W_SIN(ws), QSCALE};
                      pg8::gemm_phase<pg8::EpiQ, pg8::OneUnit>(F.lds, g, S, E, F.wave); }
                    { pg8::Gemm g{W_PROJ(ws) + C_MCKV, W_WUKV(ws), PROJ_LD, 128, 128}; pg8::OneUnit S{pm, pn, !isq}; pg8::EpiKV E{W_K(ws), W_V(ws), RS};
                      pg8::gemm_phase<pg8::EpiKV, pg8::OneUnit>(F.lds, g, S, E, F.wave); }
                }
                if (parts & 2) { unsigned rawreg[33]; { const Frame Fp = opaque(F); const int c = Fp.bx; gdn::prep_load_raw(rawreg, W_PROJ(Fp.ws), c >> 9, (c >> 7) & 3, c & 127, Fp.wave, Fp.lane); }
                    for (int c = F.bx; c < 1024; c += F.G) { const int cn = c + F.G; gdn::prep_chunk(F, l, c >> 9, (c >> 7) & 3, c & 127, rawreg, cn < 1024, cn >> 9, (cn >> 7) & 3, cn & 127, rep ? PROBE_PREP_VAR : 0); } }
                if (parts & 4) for (int it = F.bx; it < 256; it += F.G) gdn::kmean_item(F, it);
            } else if (sub == 2) {
                volatile LAS int* slot = (volatile LAS int*)(F.lds + LDS_MISC + 128);
                const int parts = rep ? PROBE_PC_PARTS : 7;
                const int my_slot = (int)(xb_xcc_id() & 7u);
                for (int k8 = 0; k8 < 8; ++k8) { const int qs = (my_slot + k8) & 7;
                    for (;;) {
                        if (F.tid == 0) *slot = (int)__hip_atomic_fetch_add(ctl + CW_Q + 64 * ((l * 2 + rep) * 8 + qs), 1u, __ATOMIC_RELAXED, __HIP_MEMORY_SCOPE_AGENT);
                        __syncthreads();
                        const int u = __builtin_amdgcn_readfirstlane(*slot);
                        __syncthreads();
                        if (u >= 65) break;
                        if (u == 0) { if (parts & 1) gdn::scan_chain(F, l, qs, rep ? PROBE_SCAN_VAR : 0); continue; }
                        const int v = u - 1, qb = 31 - (v >> 1), kind = v & 1, bh = qs;
                        if (!((parts >> (1 + kind)) & 1)) continue;
                        if (kind == 0) att::attn_unit<0>(F, bh >> 2, bh & 3, qb, rep ? PROBE_ATT_VAR : 0); else att::attn_unit<1>(F, bh >> 2, bh & 3, qb, rep ? PROBE_ATT_VAR : 0);
                    }
                }
                if (l + 1 < DEPTH && rep == 0) {
                    const Frame Fo = opaque(F); kargs_t ka = kargs(); LAS float* scr = (LAS float*)(Fo.lds + Fo.wave * 16384);
                    for (;;) {
                        if (F.tid == 0) *slot = (int)__hip_atomic_fetch_add(ctl + CW_Q + 64 * (64 + l), 1u, __ATOMIC_RELAXED, __HIP_MEMORY_SCOPE_AGENT);
                        __syncthreads();
                        const int g8 = __builtin_amdgcn_readfirstlane(*slot);
                        __syncthreads();
                        if (g8 * 8 >= N_CONV_IN) break;
                        const int it = g8 * 8 + Fo.wave;
                        if (it < N_CONV_IN) convert_in_item(Fo, ka, l + 1, it, scr);
                    }
                }
            } else {
                if (rep == 0) { gdn::gdn_finalize(F, l); xcd_barrier(bar, opaque(F_).tid == 0); }
                VM_WAIT(); __syncthreads();
                if (F.G == 256) {
                    pg8::Gemm g{W_Y(ws), W_WOUT(ws), LDY, 1024, 1024}; pg8::StaticOrder S; S.init(M_TOK, 1024, F.G, F.bx);
                    kargs_t ka = kargs(); float* xo = ka->out; pg8::EpiRes E{(l == 0) ? IN_X(ka) : xo, xo, W_XB(ws), W_SSQ(ws)};
                    pg8::gemm_phase<pg8::EpiRes, pg8::StaticOrder>(F.lds, g, S, E, F.wave);
                }
            }
            }
        }
        if (ph + 1 < hi) xcd_barrier(bar, opaque(F_).tid == 0);
    }
}
extern "C" void kernel_launch(void* const* d_in, const int* in_sizes, int n_in, void* d_out, int out_size, void* d_ws, size_t ws_size, hipStream_t stream) {
    static int grid = 0;
    if (grid == 0) {
        int dev = 0, cus = 0;
        if (n_in != 14 || ws_size < WS_END || hipGetDevice(&dev) != hipSuccess || hipDeviceGetAttribute(&cus, hipDeviceAttributeMultiprocessorCount, dev) != hipSuccess) { grid = -1; return; }
        if (hipFuncSetAttribute((const void*)skel_fwd, hipFuncAttributeMaxDynamicSharedMemorySize, LDS_BYTES) != hipSuccess) { grid = -1; return; }
        grid = cus;
    }
    if (grid != 256) return;
    unsigned char* ws = (unsigned char*)d_ws;
    (void)hipMemsetAsync(ws + WS_CTL, 0, CTL_ZERO_BYTES, stream);
    Args a{};
    for (int i = 0; i < 14; ++i) a.in[i] = (const float*)d_in[i];
    a.out = (float*)d_out; a.ws = ws;
    auto fast = [&](int lo, int hi) { a.ph_lo = lo; a.ph_hi = hi; hipLaunchKernelGGL(skel_fwd, dim3(grid), dim3(NTHREADS), LDS_BYTES, stream, a); };
    fast(0, N_PHASES);
}
```

```cpp
#include <hip/hip_runtime.h>
#include <cstdint>
#include <cstddef>

constexpr int D_MODEL = 1024, BATCH = 2, SEQ = 8192, DEPTH = 4, M_TOK = BATCH * SEQ;
constexpr int IN_COLS = 3752, PROJ_LD = 3840;
constexpr int C_MCQ = 0, C_MCKV = 256, C_MKR = 384, C_MGATE = 416, C_GQ = 672, C_GK = 1184, C_GV = 1696, C_GZ = 2208, C_GB = 2720, C_GA = 2724,
              C_CQ = 2728, C_CK = 2984, C_CV = 3240, C_CGATE = 3496;
constexpr float RMS_EPS = 1e-6f;
constexpr int Q_LD = 384, K_LD = 384, V_LD = 256;

constexpr size_t MiB = 1u << 20;
constexpr size_t WS_CTL = 0;
constexpr size_t WS_TBL = 1 * MiB;
constexpr size_t WS_KMEAN = WS_TBL + 32768;
constexpr size_t WS_SSQ = WS_KMEAN + 65536;
constexpr size_t WS_RQ = WS_SSQ + 262144;
constexpr size_t WS_RKV = WS_RQ + 65536;
constexpr size_t WS_COS = WS_RKV + 65536;
constexpr size_t WS_SIN = WS_COS + 524288;
constexpr size_t WS_GEND = WS_SIN + 524288;
constexpr size_t WS_WIN = 3 * MiB;
constexpr size_t WS_WOUT = WS_WIN + 3840 * 1024 * 2;
constexpr size_t WS_WUQ = WS_WOUT + 2 * MiB;
constexpr size_t WS_WUKV = WS_WUQ + 262144;
constexpr size_t WS_Q = 13 * MiB;
constexpr size_t WS_K = 25 * MiB;
constexpr size_t WS_V = 37 * MiB;
constexpr size_t WS_PROJ = 45 * MiB;
constexpr size_t WS_XB = 165 * MiB;
constexpr size_t WS_GDN = 165 * MiB;
constexpr size_t WS_YN = 197 * MiB;
constexpr size_t WS_OUTG = 237 * MiB;
constexpr size_t WS_END = 256 * MiB;

typedef unsigned short bf16_t;
__device__ __forceinline__ unsigned f2bf(float f) { unsigned u = __builtin_bit_cast(unsigned, f); return (u + 0x7fffu + ((u >> 16) & 1u)) >> 16; }
__device__ __forceinline__ float bf2f(bf16_t b) { return __builtin_bit_cast(float, (unsigned)b << 16); }
__device__ __forceinline__ float siluf(float x) { return x / (1.f + __expf(-x)); }
__device__ __forceinline__ float wave_sum(float v) {
    v += __builtin_bit_cast(float, __builtin_amdgcn_update_dpp(0, __builtin_bit_cast(int, v), 0x111, 0xf, 0xf, true));
    v += __builtin_bit_cast(float, __builtin_amdgcn_update_dpp(0, __builtin_bit_cast(int, v), 0x112, 0xf, 0xf, true));
    v += __builtin_bit_cast(float, __builtin_amdgcn_update_dpp(0, __builtin_bit_cast(int, v), 0x114, 0xf, 0xf, true));
    v += __builtin_bit_cast(float, __builtin_amdgcn_update_dpp(0, __builtin_bit_cast(int, v), 0x118, 0xf, 0xf, true));
    const int b = __builtin_bit_cast(int, v);
    return (__builtin_bit_cast(float, __builtin_amdgcn_readlane(b, 15)) + __builtin_bit_cast(float, __builtin_amdgcn_readlane(b, 31))) + (__builtin_bit_cast(float, __builtin_amdgcn_readlane(b, 47)) + __builtin_bit_cast(float, __builtin_amdgcn_readlane(b, 63)));
}

#define LAS __attribute__((address_space(3)))
#define GAS __attribute__((address_space(1)))
typedef short bf16x8 __attribute__((ext_vector_type(8)));
typedef float f32x4 __attribute__((ext_vector_type(4)));
typedef float f32x2 __attribute__((ext_vector_type(2)));
typedef float f32x16 __attribute__((ext_vector_type(16)));
typedef unsigned u32x4 __attribute__((ext_vector_type(4)));
typedef unsigned u32x2 __attribute__((ext_vector_type(2)));
typedef __bf16 bf16x2_t __attribute__((ext_vector_type(2)));
__device__ __forceinline__ unsigned cvtpk(float lo, float hi) { f32x2 v = {lo, hi}; bf16x2_t b = __builtin_convertvector(v, bf16x2_t); return __builtin_bit_cast(unsigned, b); }
#define LDS_WAIT() asm volatile("s_waitcnt lgkmcnt(0)" ::: "memory")
#define VM_WAIT() asm volatile("s_waitcnt vmcnt(0)" ::: "memory")

constexpr int RING_BYTES = 131072;
constexpr int LDS_RS = 131072;
constexpr int LDS_MISC = 131072 + 24576;
constexpr int LDS_BYTES = 163840;

namespace pg8 {
constexpr int BM = 256, BK = 64, HALF = 128, HTB = HALF * BK * 2, NXCD = 8, WGM = 8;
__host__ __device__ __forceinline__ int lds_byte(int r, int c) { const int st = (r >> 4) * 2 + (c >> 5), rr = r & 15, cc = c & 31, ob = rr * 64 + cc * 2; return st * 1024 + (ob ^ (((ob >> 9) & 1) << 5)); }
__host__ __device__ __forceinline__ void stage_rc(int b, int& R, int& C) { const int st = b / 1024, sb = b % 1024, swz = sb ^ (((sb >> 9) & 1) << 5); R = (st >> 1) * 16 + swz / 64; C = (st & 1) * 32 + (swz % 64) / 2; }
__host__ __device__ __forceinline__ int perm32(int rho) { const int n = rho >> 4, i = rho & 15; return 8 * (i >> 2) + 4 * n + (i & 3); }
struct Unit { int pm, pn; };
struct Gemm { const bf16_t* A; const bf16_t* Bt; int lda, ldb, K; };
struct StaticOrder {
    int nM, nN, nwg, G, c;
    __device__ void init(int M, int N, int G_, int c_) { nM = M / BM; nN = N / BM; nwg = nM * nN; G = G_; c = c_; }
    __device__ bool next(int i, Unit& u) const {
        const long L = (long)i * G + c; if (L >= nwg) return false;
        int wgid = (int)L; { const int q = nwg / NXCD, r = nwg % NXCD, xcd = wgid % NXCD, off = wgid / NXCD; wgid = (xcd < r ? xcd * (q + 1) : r * (q + 1) + (xcd - r) * q) + off; }
        const int nig = WGM * nN, gid = wgid / nig, fm = gid * WGM, gsz = (nM - fm) < WGM ? (nM - fm) : WGM;
        u.pm = fm + ((wgid % nig) % gsz); u.pn = (wgid % nig) / gsz; return true;
    }
};
struct OneUnit {
    int pm, pn; bool have;
    __device__ bool next(int i, Unit& u) const { if (i > 0 || !have) return false; u.pm = pm; u.pn = pn; return true; }
};
template <class Epi, class Sched>
__device__ __forceinline__ void gemm_phase(LAS unsigned char* lds, const Gemm g, const Sched& S, const Epi& E, int wave_id) {
    unsigned m_ = ~0u; asm volatile("" : "+s"(m_));
    const int tid = wave_id * 64 + (int)__builtin_amdgcn_mbcnt_hi(m_, __builtin_amdgcn_mbcnt_lo(m_, 0u)), wid = wave_id, lane = tid & 63, wr = wid >> 2, wc = wid & 3, fr = lane & 15, fq = lane >> 4;
    int K_ = g.K; asm volatile("" : "+s"(K_));
    const int K = K_, nt = K / BK;
    unsigned voffA[2], voffB[2];
#pragma unroll
    for (int i = 0; i < 2; ++i) { int R, C; stage_rc(tid * 16 + i * 8192, R, C); const int Rb = Epi::PERM ? ((R & ~31) + perm32(R & 31)) : R;
        voffA[i] = (unsigned)(R * g.lda + C) * 2u; voffB[i] = (unsigned)(Rb * g.ldb + C) * 2u; }
    const size_t kstep = (size_t)(BK * 2);
    const size_t hstepA = (size_t)HALF * g.lda * 2, hstepB = (size_t)HALF * g.ldb * 2, tstepA = 2 * hstepA, tstepB = 2 * hstepB;
    const unsigned ldsw = (unsigned)wid * 1024u;
    const int aoff = lds_byte(wr * 64 + fr, fq * 8), boff = lds_byte(wc * 32 + fr, fq * 8);
#define PG8_SA(b, h) (((b) * 2 + (h)) * HTB)
#define PG8_SB(b, h) ((4 + (b) * 2 + (h)) * HTB)
#define PG8_STAGE(bufoff, gbase, voff) do { _Pragma("unroll") for (int _i = 0; _i < 2; ++_i) \
        __builtin_amdgcn_global_load_lds((const unsigned*)((const char*)(gbase) + (voff)[_i]), (LAS unsigned*)(lds + (bufoff) + ldsw + _i * 8192), 16, 0, 0); } while (0)
#define PG8_LDA(dst, b, h) do { _Pragma("unroll") for (int m = 0; m < 4; ++m) _Pragma("unroll") for (int k = 0; k < 2; ++k) dst[m][k] = *(const LAS bf16x8*)(lds + PG8_SA(b, h) + aoff + m * 2048 + k * 1024); } while (0)
#define PG8_LDB(dst, b, h) do { _Pragma("unroll") for (int n = 0; n < 2; ++n) _Pragma("unroll") for (int k = 0; k < 2; ++k) dst[n][k] = *(const LAS bf16x8*)(lds + PG8_SB(b, h) + boff + n * 2048 + k * 1024); } while (0)
#define PG8_MMA(ai, bj, At, Bt) do { __builtin_amdgcn_s_setprio(1); _Pragma("unroll") for (int m = 0; m < 4; ++m) _Pragma("unroll") for (int n = 0; n < 2; ++n) _Pragma("unroll") for (int k = 0; k < 2; ++k) \
        acc[ai][bj][m][n] = __builtin_amdgcn_mfma_f32_16x16x32_bf16(Bt[n][k], At[m][k], acc[ai][bj][m][n], 0, 0, 0); __builtin_amdgcn_s_setprio(0); } while (0)
#define PG8_WAIT_V(n) asm volatile("s_waitcnt vmcnt(" #n ")" ::: "memory")
#define PG8_WAIT_L(n) asm volatile("s_waitcnt lgkmcnt(" #n ")" ::: "memory")
#define PG8_BAR __builtin_amdgcn_s_barrier()
#define PG8_SCHED __builtin_amdgcn_sched_barrier(0)
    Unit cur, nxt; int ui = 0;
    if (!S.next(0, cur)) return;
    f32x4 acc[2][2][4][2];
#pragma unroll
    for (int a = 0; a < 2; ++a)
#pragma unroll
        for (int b = 0; b < 2; ++b)
#pragma unroll
            for (int m = 0; m < 4; ++m)
#pragma unroll
                for (int n = 0; n < 2; ++n) acc[a][b][m][n] = (f32x4){0.f, 0.f, 0.f, 0.f};
    bf16x8 At[4][2], B0[2][2], B1[2][2];
    const char* cA = (const char*)g.A + (size_t)cur.pm * tstepA; const char* cB = (const char*)g.Bt + (size_t)cur.pn * tstepB;
    PG8_STAGE(PG8_SB(0, 0), cB, voffB); PG8_STAGE(PG8_SB(0, 1), cB + hstepB, voffB); PG8_STAGE(PG8_SA(0, 0), cA, voffA); PG8_STAGE(PG8_SA(0, 1), cA + hstepA, voffA);
    if (wr == 1) PG8_BAR;
    PG8_WAIT_V(2); PG8_BAR;
    PG8_STAGE(PG8_SB(1, 0), cB + kstep, voffB); PG8_STAGE(PG8_SA(1, 0), cA + kstep, voffA); PG8_STAGE(PG8_SB(1, 1), cB + hstepB + kstep, voffB);
    PG8_WAIT_V(6); PG8_BAR;
    for (;;) {
        const bool has_next = S.next(ui + 1, nxt);
        const char* nA = has_next ? (const char*)g.A + (size_t)nxt.pm * tstepA : cA; const char* nB = has_next ? (const char*)g.Bt + (size_t)nxt.pn * tstepB : cB;
        for (int t = 0; t < nt; t += 2) {
            const bool last = (t == nt - 2);
            const char* a1 = cA + (size_t)(t + 1) * kstep;
            const char* a2 = last ? nA : cA + (size_t)(t + 2) * kstep; const char* b2 = last ? nB : cB + (size_t)(t + 2) * kstep;
            const char* a3 = a2 + kstep; const char* b3 = b2 + kstep;
            PG8_LDB(B0, 0, 0); PG8_LDB(B1, 0, 1); PG8_SCHED; PG8_LDA(At, 0, 0); PG8_STAGE(PG8_SA(1, 1), a1 + hstepA, voffA);
            PG8_WAIT_V(8); PG8_WAIT_L(0); PG8_BAR; PG8_MMA(0, 0, At, B0); PG8_MMA(0, 1, At, B1); PG8_BAR; PG8_SCHED;
            PG8_LDA(At, 0, 1); PG8_STAGE(PG8_SB(0, 0), b2, voffB); PG8_STAGE(PG8_SB(0, 1), b2 + hstepB, voffB); PG8_STAGE(PG8_SA(0, 0), a2, voffA);
            PG8_WAIT_V(8); PG8_WAIT_L(0); PG8_BAR; PG8_MMA(1, 0, At, B0); PG8_MMA(1, 1, At, B1); PG8_BAR; PG8_SCHED;
            PG8_LDB(B0, 1, 0); PG8_LDB(B1, 1, 1); PG8_SCHED; PG8_LDA(At, 1, 0); PG8_STAGE(PG8_SA(0, 1), a2 + hstepA, voffA);
            PG8_WAIT_V(8); PG8_WAIT_L(0); PG8_BAR; PG8_MMA(0, 0, At, B0); PG8_MMA(0, 1, At, B1); PG8_BAR; PG8_SCHED;
            PG8_LDA(At, 1, 1); PG8_STAGE(PG8_SB(1, 0), b3, voffB); PG8_STAGE(PG8_SB(1, 1), b3 + hstepB, voffB); PG8_STAGE(PG8_SA(1, 0), a3, voffA);
            PG8_WAIT_V(8); PG8_WAIT_L(0); PG8_BAR; PG8_MMA(1, 0, At, B0); PG8_MMA(1, 1, At, B1); PG8_BAR; PG8_SCHED;
        }
        if (wr == 0) PG8_BAR;
        if constexpr (!Epi::AFTER_DRAIN) { E(acc, cur, wr, wc, fr, fq); }
        if (!has_next) break;
#pragma unroll
        for (int a = 0; a < 2; ++a)
#pragma unroll
            for (int b = 0; b < 2; ++b)
#pragma unroll
                for (int m = 0; m < 4; ++m)
#pragma unroll
                    for (int n = 0; n < 2; ++n) acc[a][b][m][n] = (f32x4){0.f, 0.f, 0.f, 0.f};
        cur = nxt; cA = nA; cB = nB; ++ui;
        if (wr == 1) PG8_BAR;
    }
    PG8_WAIT_V(0);
    PG8_BAR;
    if constexpr (Epi::AFTER_DRAIN) { E.fused(acc, cur, wr, wc, fr, fq, lds, wid, lane); }
#undef PG8_SA
#undef PG8_SB
#undef PG8_STAGE
#undef PG8_LDA
#undef PG8_LDB
#undef PG8_MMA
#undef PG8_WAIT_V
#undef PG8_WAIT_L
#undef PG8_BAR
#undef PG8_SCHED
}

struct EpiProj {
    static constexpr bool PERM = true, AFTER_DRAIN = false;
    bf16_t* O; const float* ssq;
    __device__ __forceinline__ void operator()(const f32x4 (&acc)[2][2][4][2], const Unit& u, int wr, int wc, int fr, int fq) const {
        const int row0 = u.pm * BM + wr * 64 + fr, col0 = u.pn * BM + wc * 32 + 8 * fq;
        f32x4 qs[8];
#pragma unroll
        for (int g = 0; g < 8; ++g) qs[g] = *(const f32x4*)(ssq + (size_t)(row0 + (g >> 2) * HALF + (g & 3) * 16) * 4);
        asm volatile("" ::: "memory");
#pragma unroll
        for (int ai = 0; ai < 2; ++ai)
#pragma unroll
            for (int m = 0; m < 4; ++m) { const int row = row0 + ai * HALF + m * 16; const f32x4 q = qs[ai * 4 + m];
                const float rs = rsqrtf(((q[0] + q[1]) + (q[2] + q[3])) * (1.f / D_MODEL) + RMS_EPS); bf16_t* rowp = O + (size_t)row * PROJ_LD + col0;
#pragma unroll
                for (int bj = 0; bj < 2; ++bj) { if (col0 + bj * HALF < IN_COLS) { const f32x4 v0 = acc[ai][bj][m][0] * rs, v1 = acc[ai][bj][m][1] * rs;
                    u32x4 w; w.x = cvtpk(v0[0], v0[1]); w.y = cvtpk(v0[2], v0[3]); w.z = cvtpk(v1[0], v1[1]); w.w = cvtpk(v1[2], v1[3]);
                    asm volatile("global_store_dwordx4 %0, %1, off sc1\n\ts_nop 1" :: "v"(rowp + bj * HALF), "v"(w) : "memory"); } } }
    }
};
struct EpiRes {
    static constexpr bool PERM = false, AFTER_DRAIN = true;
    const float* xin; float* xf; bf16_t* xb; float* ssq;
    __device__ __forceinline__ void fused(f32x4 (&acc)[2][2][4][2], const Unit& u, int wr, int wc, int fr, int fq, LAS unsigned char* lds, int wid, int lane) const {
        LAS float* P = (LAS float*)lds;
        const int col0 = u.pn * BM + wc * 32 + 4 * fq;
#pragma unroll
        for (int ai = 0; ai < 2; ++ai)
#pragma unroll
            for (int m = 0; m < 4; ++m) { const int rl = ai * HALF + wr * 64 + m * 16 + fr; const size_t off = (size_t)(u.pm * BM + rl) * D_MODEL + col0; float s = 0.f;
#pragma unroll
                for (int bj = 0; bj < 2; ++bj)
#pragma unroll
                    for (int n = 0; n < 2; ++n) { const size_t o2 = off + bj * HALF + n * 16; const f32x4 o = *(const f32x4*)(xin + o2) + acc[ai][bj][m][n]; *(f32x4*)(xf + o2) = o;
                        u32x2 w; w.x = cvtpk(o[0], o[1]); w.y = cvtpk(o[2], o[3]); if (xb) *(u32x2*)(xb + o2) = w; s += (o[0] * o[0] + o[1] * o[1]) + (o[2] * o[2] + o[3] * o[3]); }
                s += __shfl_xor(s, 16); s += __shfl_xor(s, 32);
                if (fq == 0) P[rl * 4 + wc] = s; }
        LDS_WAIT(); __builtin_amdgcn_s_barrier(); asm volatile("" ::: "memory");
        const int t = wid * 64 + lane;
        if (t < 256) { const f32x4 p = *(const LAS f32x4*)(P + t * 4); ssq[(size_t)(u.pm * BM + t) * 4 + u.pn] = (p[0] + p[1]) + (p[2] + p[3]); }
        LDS_WAIT(); __builtin_amdgcn_s_barrier();
    }
};
struct EpiQ {
    static constexpr bool PERM = false, AFTER_DRAIN = false;
    bf16_t* Q; const LAS float* RS; const float* cs; const float* sn; float qscale;
    __device__ __forceinline__ void operator()(const f32x4 (&acc)[2][2][4][2], const Unit& u, int wr, int wc, int fr, int fq) const {
#pragma unroll
        for (int ai = 0; ai < 2; ++ai)
#pragma unroll
            for (int m = 0; m < 4; ++m) { const int rl = ai * HALF + wr * 64 + m * 16 + fr, row = u.pm * BM + rl, pos = row & (SEQ - 1); const float rs = RS[rl * 2] * qscale;
                const f32x4 c4 = *(const f32x4*)(cs + pos * 16 + 4 * fq), s4 = *(const f32x4*)(sn + pos * 16 + 4 * fq);
#pragma unroll
                for (int bj = 0; bj < 2; ++bj) { const int cb = u.pn * BM + bj * HALF + wc * 32; if (cb < 384) {
                    f32x4 v0 = acc[ai][bj][m][0], v1 = acc[ai][bj][m][1];
                    if (((cb >> 5) % 3) == 2) { const f32x4 a = v0 * c4 - v1 * s4, b = v0 * s4 + v1 * c4; v0 = a; v1 = b; }
                    v0 = v0 * rs; v1 = v1 * rs; bf16_t* p = Q + (size_t)row * Q_LD + cb + 4 * fq;
                    u32x2 w0, w1; w0.x = cvtpk(v0[0], v0[1]); w0.y = cvtpk(v0[2], v0[3]); w1.x = cvtpk(v1[0], v1[1]); w1.y = cvtpk(v1[2], v1[3]);
                    *(u32x2*)p = w0; *(u32x2*)(p + 16) = w1; } }
                asm volatile("" ::: "memory"); }
    }
};
struct EpiKV {
    static constexpr bool PERM = true, AFTER_DRAIN = false;
    bf16_t* Kb; bf16_t* Vb; const LAS float* RS;
    __device__ __forceinline__ void operator()(const f32x4 (&acc)[2][2][4][2], const Unit& u, int wr, int wc, int fr, int fq) const {
#pragma unroll
        for (int ai = 0; ai < 2; ++ai)
#pragma unroll
            for (int m = 0; m < 4; ++m) { const int rl = ai * HALF + wr * 64 + m * 16 + fr, row = u.pm * BM + rl; const float rs = RS[rl * 2 + 1];
#pragma unroll
                for (int bj = 0; bj < 2; ++bj) { const int c = bj * HALF + wc * 32 + 8 * fq; const f32x4 v0 = acc[ai][bj][m][0] * rs, v1 = acc[ai][bj][m][1] * rs;
                    u32x4 w; w.x = cvtpk(v0[0], v0[1]); w.y = cvtpk(v0[2], v0[3]); w.z = cvtpk(v1[0], v1[1]); w.w = cvtpk(v1[2], v1[3]);
                    bf16_t* p = (u.pn == 0) ? Kb + (size_t)row * K_LD + 96 * (c >> 6) + (c & 63) : Vb + (size_t)row * V_LD + c;
                    *(u32x4*)p = w; } }
    }
};
}

#define XB_TMO      128
#define XB_XCNT(j)  (256  + 64 * (j))
#define XB_XSUB(j)  (1280 + 64 * (j))
#define XB_XGEN(j)  (2304 + 64 * (j))
#define XB_TOP      3328
#define XB_TOPGEN   3392
#define XCD_BAR_WORDS 3456
#define XB_SPIN_CAP (1u << 20)
__device__ __forceinline__ unsigned xb_ld(unsigned* p)              { return __hip_atomic_load(p, __ATOMIC_RELAXED, __HIP_MEMORY_SCOPE_AGENT); }
__device__ __forceinline__ unsigned xb_add(unsigned* p, unsigned v) { return __hip_atomic_fetch_add(p, v, __ATOMIC_RELAXED, __HIP_MEMORY_SCOPE_AGENT); }
__device__ __forceinline__ unsigned xb_xcc_id() { return (unsigned)__builtin_amdgcn_s_getreg((3 << 11) | 20) & 0xFu; }
#define XB_SPIN(cond, bar) do { unsigned _sp = 0; while (cond) { __builtin_amdgcn_s_sleep(1); \
    if ((++_sp & 255u) == 0u) { if (xb_ld(&(bar)[XB_TMO])) break; if (_sp > XB_SPIN_CAP) { atomicAdd(&(bar)[XB_TMO], 1u); break; } } } } while (0)
struct XcdBarrier { unsigned* bar; unsigned x; volatile LAS unsigned* st; };
__device__ __forceinline__ XcdBarrier xcd_barrier_post(unsigned* bar, volatile LAS unsigned* st, bool thread0) {
    XcdBarrier b; b.bar = bar; b.x = xb_xcc_id(); b.st = st;
    if (thread0) (void)xb_add(&bar[XB_XCNT(b.x)], 1u);
    return b;
}
__device__ __forceinline__ void xcd_barrier_complete(unsigned* bar, unsigned x, unsigned& nloc, unsigned& nx) {
    const unsigned G = gridDim.x * gridDim.y * gridDim.z;
    unsigned sum, cnt, mine, sp = 0u;
    for (;;) {
        sum = 0u; cnt = 0u; mine = 0u;
#pragma unroll
        for (unsigned j = 0; j < 16; ++j) { const unsigned c = xb_ld(&bar[XB_XCNT(j)]); sum += c; cnt += (c > 0u) ? 1u : 0u; mine = (j == x) ? c : mine; }
        if (sum == G) break;
        __builtin_amdgcn_s_sleep(1);
        if ((++sp & 255u) == 0u) { if (xb_ld(&bar[XB_TMO])) break; if (sp > XB_SPIN_CAP) { atomicAdd(&bar[XB_TMO], 1u); break; } }
    }
    nloc = mine > 0u ? mine : 1u; nx = cnt > 0u ? cnt : 1u;
}
__device__ __forceinline__ void xcd_barrier(const XcdBarrier& b, bool thread0) {
    asm volatile("s_waitcnt vmcnt(0)" ::: "memory");
    __syncthreads();
    if (thread0) {
        unsigned* bar = b.bar;
        __builtin_amdgcn_s_waitcnt(0);
        unsigned nloc = b.st[0], nx = b.st[1];
        if (nloc == 0u) { xcd_barrier_complete(bar, b.x, nloc, nx); b.st[0] = nloc; b.st[1] = nx; }
        const unsigned old = xb_add(&bar[XB_XSUB(b.x)], 1u);
        const unsigned gen = old / nloc;
        if (old + 1u == (gen + 1u) * nloc) {
            __builtin_amdgcn_fence(__ATOMIC_RELEASE, "agent");
            asm volatile("s_waitcnt vmcnt(0)" ::: "memory");
            const unsigned og = xb_add(&bar[XB_TOP], 1u);
            const unsigned tg = og / nx;
            if (og + 1u == (tg + 1u) * nx) xb_add(&bar[XB_TOPGEN], 1u);
            else XB_SPIN(xb_ld(&bar[XB_TOPGEN]) == tg, bar);
            __builtin_amdgcn_fence(__ATOMIC_ACQUIRE, "agent");
            xb_add(&bar[XB_XGEN(b.x)], 1u);
            asm volatile("s_waitcnt vmcnt(0)" ::: "memory");
        } else {
            XB_SPIN(xb_ld(&bar[XB_XGEN(b.x)]) == gen, bar);
            __builtin_amdgcn_fence(__ATOMIC_ACQUIRE, "agent");
            asm volatile("s_waitcnt vmcnt(0)" ::: "memory");
        }
    }
    __syncthreads();
}

namespace pg8 {
struct EpiResFinal {
    static constexpr bool PERM = false, AFTER_DRAIN = true;
    const float* xin; float* out; float* ssq; const float* fw; XcdBarrier bar;
    __device__ __forceinline__ void fused(f32x4 (&acc)[2][2][4][2], const Unit& u, int wr, int wc, int fr, int fq, LAS unsigned char* lds, int wid, int lane) const {
        LAS float* P = (LAS float*)lds;
        const int col0 = u.pn * BM + wc * 32 + 4 * fq;
#pragma unroll
        for (int ai = 0; ai < 2; ++ai)
#pragma unroll
            for (int m = 0; m < 4; ++m) { const int rl = ai * HALF + wr * 64 + m * 16 + fr; const size_t off = (size_t)(u.pm * BM + rl) * D_MODEL + col0; float s = 0.f;
#pragma unroll
                for (int bj = 0; bj < 2; ++bj)
#pragma unroll
                    for (int n = 0; n < 2; ++n) { const f32x4 o = *(const f32x4*)(xin + off + bj * HALF + n * 16) + acc[ai][bj][m][n]; acc[ai][bj][m][n] = o;
                        s += (o[0] * o[0] + o[1] * o[1]) + (o[2] * o[2] + o[3] * o[3]); }
                s += __shfl_xor(s, 16); s += __shfl_xor(s, 32);
                if (fq == 0) P[rl * 4 + wc] = s; }
        LDS_WAIT(); __builtin_amdgcn_s_barrier(); asm volatile("" ::: "memory");
        const int t = wid * 64 + lane;
        if (t < 256) { const f32x4 p = *(const LAS f32x4*)(P + t * 4); ssq[(size_t)(u.pm * BM + t) * 4 + u.pn] = (p[0] + p[1]) + (p[2] + p[3]); }
        xcd_barrier(bar, t == 0);
        f32x4 w4[2][2];
#pragma unroll
        for (int bj = 0; bj < 2; ++bj)
#pragma unroll
            for (int n = 0; n < 2; ++n) w4[bj][n] = *(const f32x4*)(fw + col0 + bj * HALF + n * 16);
        f32x4 qs[8];
#pragma unroll
        for (int g = 0; g < 8; ++g) qs[g] = *(const f32x4*)(ssq + (size_t)(u.pm * BM + (g >> 2) * HALF + wr * 64 + (g & 3) * 16 + fr) * 4);
#pragma unroll
        for (int ai = 0; ai < 2; ++ai)
#pragma unroll
            for (int m = 0; m < 4; ++m) { const int rl = ai * HALF + wr * 64 + m * 16 + fr; const size_t off = (size_t)(u.pm * BM + rl) * D_MODEL + col0; const f32x4 q = qs[ai * 4 + m];
                const float rs = rsqrtf(((q[0] + q[1]) + (q[2] + q[3])) * (1.f / D_MODEL) + RMS_EPS);
#pragma unroll
                for (int bj = 0; bj < 2; ++bj)
#pragma unroll
                    for (int n = 0; n < 2; ++n) *(f32x4*)(out + off + bj * HALF + n * 16) = acc[ai][bj][m][n] * rs * w4[bj][n]; }
    }
};
}
constexpr int NWAVES = 8, NTHREADS = 512;
constexpr int CW_BAR = 4096, CW_Q = 131072;
constexpr size_t CTL_ZERO_BYTES = 1 * MiB;
constexpr int N_PHASES = 2 + 4 * DEPTH;
constexpr float QSCALE = 0.10206207261596577f * 1.4426950408889634f;

struct Args { const float* in[14]; float* out; unsigned char* ws; int ph_lo, ph_hi; int fastmask, pad; };
struct Frame { LAS unsigned char* lds; int tid, lane, wave, G, bx; unsigned char* ws; };
typedef const __attribute__((address_space(4))) Args* kargs_t;
__device__ __forceinline__ kargs_t kargs() { kargs_t p = (kargs_t)__builtin_amdgcn_kernarg_segment_ptr(); asm volatile("" : "+s"(p)); return p; }
#define IN_X(a) ((a)->in[0])
#define IN_NORMW(a) ((a)->in[1])
#define IN_WIN(a) ((a)->in[2])
#define IN_QNORM(a) ((a)->in[3])
#define IN_WUQ(a) ((a)->in[4])
#define IN_KVNORM(a) ((a)->in[5])
#define IN_WUKV(a) ((a)->in[6])
#define IN_CONVW(a) ((a)->in[7])
#define IN_ALOG(a) ((a)->in[8])
#define IN_DTB(a) ((a)->in[9])
#define IN_GNORM(a) ((a)->in[10])
#define IN_WOUT(a) ((a)->in[11])
#define IN_T5(a) ((a)->in[12])
#define IN_FNORM(a) ((a)->in[13])
#define W_TBL(ws) ((float*)((ws) + WS_TBL))
#define W_KM(ws) ((float*)((ws) + WS_KMEAN))
#define W_SSQ(ws) ((float*)((ws) + WS_SSQ))
#define W_COS(ws) ((float*)((ws) + WS_COS))
#define W_SIN(ws) ((float*)((ws) + WS_SIN))
#define W_WIN(ws) ((bf16_t*)((ws) + WS_WIN))
#define W_WOUT(ws) ((bf16_t*)((ws) + WS_WOUT))
#define W_WUQ(ws) ((bf16_t*)((ws) + WS_WUQ))
#define W_WUKV(ws) ((bf16_t*)((ws) + WS_WUKV))
#define W_Q(ws) ((bf16_t*)((ws) + WS_Q))
#define W_K(ws) ((bf16_t*)((ws) + WS_K))
#define W_V(ws) ((bf16_t*)((ws) + WS_V))
#define W_PROJ(ws) ((bf16_t*)((ws) + WS_PROJ))
#define W_XB(ws) ((bf16_t*)((ws) + WS_XB))
#define W_Y(ws) ((bf16_t*)((ws) + WS_PROJ) + C_GQ)
constexpr int LDY = PROJ_LD;

__device__ __forceinline__ Frame opaque(const Frame& F) { Frame G = F; asm volatile("" : "+s"(G.ws), "+s"(G.bx), "+s"(G.wave), "+s"(G.G));
    unsigned m_ = ~0u; asm volatile("" : "+s"(m_)); G.lane = (int)__builtin_amdgcn_mbcnt_hi(m_, __builtin_amdgcn_mbcnt_lo(m_, 0u)); G.tid = G.wave * 64 + G.lane; return G; }
__device__ __forceinline__ void tr_item(const float* W, int K, int N, int NP, const float* sc, bf16_t* WT, int mode, LAS float* scr, int item, int lane) {
    const int nblk = NP / 32, kb = item / nblk, nb = item % nblk, k0 = 64 * kb, n0 = 32 * nb;
    int n = n0 + (lane & 31); const bool valid = n < N;
    if (mode == 1) { const int nn = n & 255, hd = nn >> 6, c = nn & 63; n = hd * 128 + c + ((n >= 256) ? 64 : 0); }
    const float* wp = W + (size_t)(k0 + (lane >> 5)) * N + (valid ? n : N - 1);
    float v[32];
#pragma unroll
    for (int i = 0; i < 32; ++i) v[i] = wp[(size_t)(2 * i) * N];
    if (sc) { const float* sp = sc + k0 + (lane >> 5); float sv[32];
#pragma unroll
        for (int i = 0; i < 32; ++i) sv[i] = sp[2 * i];
#pragma unroll
        for (int i = 0; i < 32; ++i) v[i] *= sv[i]; }
#pragma unroll
    for (int i = 0; i < 32; ++i) scr[(2 * i + (lane >> 5)) * 33 + (lane & 31)] = valid ? v[i] : 0.f;
    LDS_WAIT(); asm volatile("" ::: "memory");
    const int c = lane & 7;
#pragma unroll
    for (int j = 0; j < 4; ++j) { const int nn = (lane >> 3) + 8 * j; const LAS float* s = scr + (8 * c) * 33 + nn;
        u32x4 o; o.x = cvtpk(s[0 * 33], s[1 * 33]); o.y = cvtpk(s[2 * 33], s[3 * 33]); o.z = cvtpk(s[4 * 33], s[5 * 33]); o.w = cvtpk(s[6 * 33], s[7 * 33]);
        *(u32x4*)(WT + (size_t)(n0 + nn) * K + k0 + 8 * c) = o; }
    LDS_WAIT(); asm volatile("" ::: "memory");
}
constexpr int I_IN = 16 * 120, I_UQ = 4 * 16, I_UKV = 2 * 16, I_OUT = 16 * 32, N_CONV_IN = I_IN + I_UQ + I_UKV;
__device__ __forceinline__ void convert_in_item(const Frame& F, kargs_t A, int l, int r, LAS float* scr) {
    if (r < I_IN) { tr_item(IN_WIN(A) + (size_t)l * 1024 * IN_COLS, 1024, IN_COLS, 3840, IN_NORMW(A) + l * 1024, W_WIN(F.ws), 0, scr, r, F.lane); return; } r -= I_IN;
    if (r < I_UQ) { tr_item(IN_WUQ(A) + (size_t)l * 256 * 384, 256, 384, 512, IN_QNORM(A) + l * 256, W_WUQ(F.ws), 0, scr, r, F.lane); return; } r -= I_UQ;
    tr_item(IN_WUKV(A) + (size_t)l * 128 * 512, 128, 512, 512, IN_KVNORM(A) + l * 128, W_WUKV(F.ws), 1, scr, r, F.lane);
}
__device__ __forceinline__ void convert_weights(const Frame& F0, kargs_t A, int l, int which) {
    const Frame F = opaque(F0);
    LAS float* scr = (LAS float*)(F.lds + F.wave * 16384);
    const int gw = F.bx * NWAVES + F.wave, NGW = F.G * NWAVES;
    if (which & 1) for (int it = gw; it < N_CONV_IN; it += NGW) convert_in_item(F, A, l, it, scr);
    if (which & 2) for (int it = ((F.bx + 64) & (F.G - 1)) * NWAVES + F.wave; it < I_OUT; it += NGW) tr_item(IN_WOUT(A) + (size_t)l * 1024 * 1024, 1024, 1024, 1024, nullptr, W_WOUT(F.ws), 0, scr, it, F.lane);
}
__device__ __forceinline__ float rope_inv(int j) {
    unsigned b = 0x3f800000u;
    b = (j == 1) ? 0x3f0ff59au : b;
    b = (j == 2) ? 0x3ea1e89bu : b;
    b = (j == 3) ? 0x3e361887u : b;
    b = (j == 4) ? 0x3dcccccdu : b;
    b = (j == 5) ? 0x3d6655c2u : b;
    b = (j == 6) ? 0x3d0186e3u : b;
    b = (j == 7) ? 0x3c91ad39u : b;
    b = (j == 8) ? 0x3c23d70au : b;
    b = (j == 9) ? 0x3bb8449cu : b;
    b = (j == 10) ? 0x3b4f3e38u : b;
    b = (j == 11) ? 0x3ae91528u : b;
    b = (j == 12) ? 0x3a83126fu : b;
    b = (j == 13) ? 0x3a136a16u : b;
    b = (j == 14) ? 0x39a5cb60u : b;
    b = (j == 15) ? 0x393a7753u : b;
    return __builtin_bit_cast(float, b);
}
__device__ __forceinline__ void p0_prologue(const Frame& F0, kargs_t A) {
    const Frame F = opaque(F0);
    const int gt = F.bx * NTHREADS + F.tid, NGT = F.G * NTHREADS;
    float* TBL = W_TBL(F.ws); float* COS = W_COS(F.ws); float* SIN = W_SIN(F.ws);
    for (int i = gt; i < SEQ * 16; i += NGT) {
        if (i < 4 * 2048) { const int h = i >> 11, rel = i & 2047; int b;
            if (rel < 16) b = rel; else { b = 16 + (int)(__logf((float)rel * 0.0625f) * (16.f / 4.852030263919617f)); if (b > 31) b = 31; }
            TBL[i] = IN_T5(A)[b * 4 + h]; }
        const int pos = i >> 4, j = i & 15;
        const float inv = rope_inv(j); const float ang = (float)pos * inv;
        const float k = __builtin_rintf(ang * 0.636619772f);
        float r = __builtin_fmaf(-k, 1.5703125f, ang); r = __builtin_fmaf(-k, 4.837512969970703125e-4f, r); r = __builtin_fmaf(-k, 7.54978995489188e-8f, r);
        const float r2 = r * r;
        float sp = 2.7557319e-06f; sp = __builtin_fmaf(sp, r2, -1.9841270e-04f); sp = __builtin_fmaf(sp, r2, 8.3333333e-03f); sp = __builtin_fmaf(sp, r2, -1.6666667e-01f); sp = __builtin_fmaf(sp * r2, r, r);
        float cp = 2.4801587e-05f; cp = __builtin_fmaf(cp, r2, -1.3888889e-03f); cp = __builtin_fmaf(cp, r2, 4.1666667e-02f); cp = __builtin_fmaf(cp, r2, -0.5f); cp = __builtin_fmaf(cp, r2, 1.0f);
        const int q = (int)k & 3; const float sf = sp, cf = cp;
        COS[i] = (q == 0) ? cf : (q == 1) ? -sf : (q == 2) ? -cf : sf;
        SIN[i] = (q == 0) ? sf : (q == 1) ? cf : (q == 2) ? -sf : -cf;
    }
    convert_weights(F0, A, 0, 3);
    const int gw = F.bx * NWAVES + F.wave, NGW = F.G * NWAVES;
    bf16_t* XB = W_XB(F.ws); float* SSQ = W_SSQ(F.ws);
    for (int row0 = gw * 4; row0 < M_TOK; row0 += NGW * 4) {
        f32x4 v[4][4];
#pragma unroll
        for (int r = 0; r < 4; ++r)
#pragma unroll
            for (int j = 0; j < 4; ++j) v[r][j] = *((const f32x4*)(IN_X(A) + (size_t)(row0 + r) * D_MODEL) + F.lane + 64 * j);
#pragma unroll
        for (int r = 0; r < 4; ++r) { float s = 0.f;
#pragma unroll
            for (int j = 0; j < 4; ++j) { const f32x4 w4 = v[r][j]; s += (w4[0] * w4[0] + w4[1] * w4[1]) + (w4[2] * w4[2] + w4[3] * w4[3]);
                u32x2 w; w.x = cvtpk(w4[0], w4[1]); w.y = cvtpk(w4[2], w4[3]); *((u32x2*)(XB + (size_t)(row0 + r) * D_MODEL) + F.lane + 64 * j) = w; }
            s = wave_sum(s); if (F.lane == 0) *(f32x4*)(SSQ + (size_t)(row0 + r) * 4) = (f32x4){s, 0.f, 0.f, 0.f}; }
    }
}
__device__ __forceinline__ void pb_prepass(const Frame& F0, int pm, bool do_kpe) {
    const Frame F = opaque(F0);
    const bf16_t* PROJ = W_PROJ(F.ws); bf16_t* Kb = W_K(F.ws); const float* COS = W_COS(F.ws); const float* SIN = W_SIN(F.ws);
    LAS float* RS = (LAS float*)(F.lds + LDS_RS);
    { const int rl = F.tid >> 1, hf = F.tid & 1; const bf16_t* p = PROJ + (size_t)(pm * 256 + rl) * PROJ_LD;
      float s1 = 0.f, s2 = 0.f;
#pragma unroll
      for (int hb = 0; hb < 2; ++hb) {
          bf16x8 a[8], b[4];
#pragma unroll
          for (int i = 0; i < 8; ++i) a[i] = *(const bf16x8*)(p + C_MCQ + hf * 128 + 64 * hb + 8 * i);
#pragma unroll
          for (int i = 0; i < 4; ++i) b[i] = *(const bf16x8*)(p + C_MCKV + hf * 64 + 32 * hb + 8 * i);
          asm volatile("" ::: "memory");
#pragma unroll
          for (int i = 0; i < 8; ++i)
#pragma unroll
              for (int j = 0; j < 8; ++j) { const float v = bf2f((bf16_t)a[i][j]); s1 += v * v; }
#pragma unroll
          for (int i = 0; i < 4; ++i)
#pragma unroll
              for (int j = 0; j < 8; ++j) { const float v = bf2f((bf16_t)b[i][j]); s2 += v * v; }
          asm volatile("" ::: "memory"); }
      s1 += __shfl_xor(s1, 1); s2 += __shfl_xor(s2, 1);
      if (hf == 0) { RS[rl * 2] = rsqrtf(s1 * (1.f / 256.f) + RMS_EPS); RS[rl * 2 + 1] = rsqrtf(s2 * (1.f / 128.f) + RMS_EPS); } }
    if (do_kpe) {
        float x1[8], x2[8], c[8], sg[8];
#pragma unroll
        for (int i = 0; i < 8; ++i) { const int it = i * 512 + F.tid, rl = it >> 4, j = it & 15, row = pm * 256 + rl, pos = row & (SEQ - 1); const bf16_t* p = PROJ + (size_t)row * PROJ_LD + C_MKR;
            x1[i] = bf2f(p[j]); x2[i] = bf2f(p[16 + j]); c[i] = COS[pos * 16 + j]; sg[i] = SIN[pos * 16 + j]; }
#pragma unroll
        for (int i = 0; i < 8; ++i) { const int it = i * 512 + F.tid, rl = it >> 4, j = it & 15, row = pm * 256 + rl;
            const bf16_t r1 = (bf16_t)f2bf(x1[i] * c[i] - x2[i] * sg[i]), r2 = (bf16_t)f2bf(x1[i] * sg[i] + x2[i] * c[i]);
#pragma unroll
            for (int h = 0; h < 4; ++h) { Kb[(size_t)row * K_LD + 96 * h + 64 + j] = r1; Kb[(size_t)row * K_LD + 96 * h + 80 + j] = r2; } }
    }
}
__device__ __forceinline__ void final_norm(const Frame& F0, float* out, const float* fnorm) {
    const Frame F = opaque(F0);
    const int gw = F.bx * NWAVES + F.wave, NGW = F.G * NWAVES;
    f32x4 w[4];
#pragma unroll
    for (int j = 0; j < 4; ++j) w[j] = *((const f32x4*)fnorm + F.lane + 64 * j);
    for (int row0 = gw * 4; row0 < M_TOK; row0 += NGW * 4) {
        f32x4 v[4][4];
#pragma unroll
        for (int r = 0; r < 4; ++r)
#pragma unroll
            for (int j = 0; j < 4; ++j) v[r][j] = *((const f32x4*)(out + (size_t)(row0 + r) * D_MODEL) + F.lane + 64 * j);
#pragma unroll
        for (int r = 0; r < 4; ++r) { float s = 0.f;
#pragma unroll
            for (int j = 0; j < 4; ++j) s += (v[r][j][0] * v[r][j][0] + v[r][j][1] * v[r][j][1]) + (v[r][j][2] * v[r][j][2] + v[r][j][3] * v[r][j][3]);
            const float rs = rsqrtf(wave_sum(s) * (1.f / D_MODEL) + RMS_EPS);
#pragma unroll
            for (int j = 0; j < 4; ++j) *((f32x4*)(out + (size_t)(row0 + r) * D_MODEL) + F.lane + 64 * j) = v[r][j] * rs * w[j]; }
    }
}

namespace att {
typedef short v4i16_t __attribute__((ext_vector_type(4)));
constexpr int NSLOT = 6, A_SLOT = 20480  , A_K = 0, A_V = 12288, A_WS = NSLOT * A_SLOT, A_KM = A_WS + 2048, A_TB = A_KM + 8192  , A_OST = 0  , A_OSTW = 8704  ;
static_assert(8 * A_OSTW <= NSLOT * A_SLOT && A_TB + 9216 <= LDS_MISC, "attention LDS map");
__device__ __forceinline__ int crow(int r, int hi) { return (r & 3) + 8 * (r >> 2) + 4 * hi; }
__device__ __forceinline__ void glds16(const void* gsrc, unsigned lds_dst) { unsigned keep;
    asm volatile("s_mov_b32 %0, m0\n\ts_mov_b32 m0, %2\n\ts_nop 0\n\tglobal_load_lds_dwordx4 %1, off\n\ts_mov_b32 m0, %0" : "=&s"(keep) : "v"(gsrc), "s"(lds_dst) : "memory"); }
__device__ __forceinline__ void glds4(const void* gsrc, unsigned lds_dst) { unsigned keep;
    asm volatile("s_mov_b32 %0, m0\n\ts_mov_b32 m0, %2\n\ts_nop 0\n\tglobal_load_lds_dword %1, off\n\ts_mov_b32 m0, %0" : "=&s"(keep) : "v"(gsrc), "s"(lds_dst) : "memory"); }
__device__ __forceinline__ float max3f(float a, float b, float c) { float r; asm("v_max3_f32 %0, %1, %2, %3" : "=v"(r) : "v"(a), "v"(b), "v"(c)); return r; }
__device__ __forceinline__ float max_halves(float m) { auto rr = __builtin_amdgcn_permlane32_swap(__float_as_uint(m), __float_as_uint(m), false, false); return max3f(__uint_as_float(rr[0]), __uint_as_float(rr[1]), __uint_as_float(rr[1])); }
__device__ __forceinline__ float other_half(float v) { return __shfl_xor(v, 32); }
__device__ __forceinline__ int other_half_i(int v) { return __shfl_xor(v, 32); }

template <int MODE>
__device__ __forceinline__ void attn_unit(const Frame& F0, int b, int h, int qb, int var = 0) {
    constexpr int DQ = MODE == 0 ? 96 : 64, ND0 = DQ / 16, NCH = DQ / 8;
    const Frame F = opaque(F0);
    const int lane = F.lane, wid = F.wave, r32 = lane & 31, hi = lane >> 5;
    unsigned char* ws = F.ws; LAS unsigned char* lds = F.lds;
    const bf16_t* PROJ = W_PROJ(ws);
    const int ldq = MODE == 0 ? Q_LD : PROJ_LD, ldk = MODE == 0 ? K_LD : PROJ_LD, ldv = MODE == 0 ? V_LD : PROJ_LD;
    const size_t rowbase = (size_t)b * SEQ; const int q0 = qb * 256;
    const bf16_t* Qh = (MODE == 0 ? W_Q(ws) + 96 * h : PROJ + C_CQ + 64 * h) + rowbase * ldq;
    const bf16_t* Kh = (MODE == 0 ? W_K(ws) + 96 * h : PROJ + C_CK + 64 * h) + rowbase * ldk;
    const bf16_t* Vh = (MODE == 0 ? W_V(ws) + 64 * h : PROJ + C_CV + 64 * h) + rowbase * ldv;
    const int qpos = q0 + wid * 32 + r32;
    LAS float* wsf = (LAS float*)(lds + A_WS) + wid * 64;
    bf16x8 qr[ND0];
#pragma unroll
    for (int d0 = 0; d0 < ND0; ++d0) { qr[d0] = *(const bf16x8*)(Qh + (size_t)qpos * ldq + d0 * 16 + hi * 8);
        if (MODE == 1) { const float SC = 0.125f * 1.4426950408889634f; u32x4 w;
#pragma unroll
            for (int j = 0; j < 4; ++j) w[j] = cvtpk(bf2f((bf16_t)qr[d0][2 * j]) * SC, bf2f((bf16_t)qr[d0][2 * j + 1]) * SC);
            qr[d0] = __builtin_bit_cast(bf16x8, w); } }
    unsigned selmask = 0xffffffffu, umask = 0u; const int own = qb;
    if (MODE == 1) {
        LAS float* kml = (LAS float*)(lds + A_KM); LAS float* tbl = (LAS float*)(lds + A_TB); LAS unsigned* um = (LAS unsigned*)(lds + LDS_MISC + 64);
        const float* km = W_KM(ws) + (size_t)(b * 4 + h) * 32 * 64; const float* tb = W_TBL(ws) + h * 2048;
        { const f32x4 a = *(const f32x4*)(km + F.tid * 4);
          const float b31 = tb[2047]; float tv[5];
#pragma unroll
          for (int j = 0; j < 5; ++j) { int rel = F.tid + 512 * j - 64; rel = rel < 0 ? 0 : (rel > 2046 ? 2046 : rel); tv[j] = tb[rel]; }
          *(LAS f32x4*)(kml + F.tid * 4) = a;
#pragma unroll
          for (int j = 0; j < 5; ++j) { const int i = F.tid + 512 * j; const int rel = i - 64; const float e = rel < 0 ? -1e30f : (rel >= 2047 ? 0.f : (tv[j] - b31) * 1.4426950408889634f); if (i < 2240) tbl[i] = e; } }
        if (F.tid == 0) *um = 0u;
        float qf[64];
#pragma unroll
        for (int c = 0; c < 8; ++c) { const bf16x8 v = *(const bf16x8*)(Qh + (size_t)qpos * ldq + c * 8);
#pragma unroll
            for (int j = 0; j < 8; ++j) qf[c * 8 + j] = bf2f((bf16_t)v[j]); }
        LDS_WAIT(); __syncthreads();
        float g0 = -INFINITY, g1 = -INFINITY, g2 = -INFINITY; int s0 = 64, s1 = 64, s2 = 64;
        for (int n = hi; n < own; n += 2) { const LAS f32x4* kp = (const LAS f32x4*)(kml + n * 64); float g = 0.f;
#pragma unroll
            for (int c = 0; c < 16; ++c) { const f32x4 k4 = kp[c]; g += qf[4 * c] * k4[0]; g += qf[4 * c + 1] * k4[1]; g += qf[4 * c + 2] * k4[2]; g += qf[4 * c + 3] * k4[3]; }
            if (g > g0) { g2 = g1; s2 = s1; g1 = g0; s1 = s0; g0 = g; s0 = n; } else if (g > g1) { g2 = g1; s2 = s1; g1 = g; s1 = n; } else if (g > g2) { g2 = g; s2 = n; } }
        const float h0 = other_half(g0), h1 = other_half(g1), h2 = other_half(g2); const int t0 = other_half_i(s0), t1 = other_half_i(s1), t2 = other_half_i(s2);
#define ATT_INS(gg, ss) do { const float g_ = (gg); const int s_ = (ss); \
            if (g_ > g0 || (g_ == g0 && s_ < s0)) { g2 = g1; s2 = s1; g1 = g0; s1 = s0; g0 = g_; s0 = s_; } \
            else if (g_ > g1 || (g_ == g1 && s_ < s1)) { g2 = g1; s2 = s1; g1 = g_; s1 = s_; } \
            else if (g_ > g2 || (g_ == g2 && s_ < s2)) { g2 = g_; s2 = s_; } } while (0)
        ATT_INS(h0, t0); ATT_INS(h1, t1); ATT_INS(h2, t2);
#undef ATT_INS
        selmask = 1u << own; if (s0 < 32) selmask |= 1u << s0; if (s1 < 32) selmask |= 1u << s1; if (s2 < 32) selmask |= 1u << s2;
        (void)__hip_atomic_fetch_or(um, selmask, __ATOMIC_RELAXED, __HIP_MEMORY_SCOPE_WORKGROUP);
        LDS_WAIT(); __syncthreads();
        umask = __builtin_amdgcn_readfirstlane(*um);
    }
    const int NT = MODE == 0 ? 4 * (qb + 1) : 4 * __builtin_popcount(umask);
    const unsigned lds0 = (unsigned)(__UINTPTR_TYPE__)lds;
    auto dma = [&](int key0, int s) {
        if (var & 1) return;
        const bf16_t* ks = Kh + (size_t)(key0 + lane) * ldk + wid * 8;
        glds16(ks, (unsigned)__builtin_amdgcn_readfirstlane(lds0 + s * A_SLOT + A_K + wid * 1024));
        if (NCH > 8) { const int c2 = (wid < NCH - 8) ? 8 + wid : wid;
            glds16(ks + (c2 - wid) * 8, (unsigned)__builtin_amdgcn_readfirstlane(lds0 + s * A_SLOT + A_K + c2 * 1024)); }
        const bf16_t* vs = Vh + (size_t)(key0 + 16 * (wid & 3) + (lane >> 2)) * ldv + (wid >> 2) * 32 + (lane & 3) * 8;
        glds16(vs, (unsigned)__builtin_amdgcn_readfirstlane(lds0 + s * A_SLOT + A_V + wid * 1024));
    };
#define ATT_WAITV(n) asm volatile("s_waitcnt vmcnt(" #n ")" ::: "memory")
#define ATT_WAIT_PREV() do { if (MODE == 0) ATT_WAITV(3); else ATT_WAITV(2); } while (0)
#define ATT_BAR() do { ATT_WAIT_PREV(); LDS_WAIT(); __builtin_amdgcn_s_barrier(); } while (0)
    unsigned rem_i = umask, rem_c = umask; int blk_i = 0, sub_i = 0, blk_c = 0, sub_c = 0;
    auto key_issue = [&](int t) -> int { if (MODE == 0) return 64 * t; if (sub_i == 0) { blk_i = __builtin_ctz(rem_i); rem_i &= rem_i - 1; } const int k0 = blk_i * 256 + sub_i * 64; sub_i = (sub_i + 1) & 3; return k0; };
    auto key_comp = [&](int t) -> int { if (MODE == 0) return 64 * t; if (sub_c == 0) { blk_c = __builtin_ctz(rem_c); rem_c &= rem_c - 1; } const int k0 = blk_c * 256 + sub_c * 64; sub_c = (sub_c + 1) & 3; return k0; };
    int key_last = 0;
    { const int k0 = key_issue(0); dma(k0, 0); const int k1 = key_issue(1); dma(k1, 1); const int k2 = key_issue(2); dma(k2, 2); const int k3 = key_issue(3); dma(k3, 3); key_last = k3; }
    int sl_c = 0, sl_n = 1, sl_d = 4;
    constexpr float THR = 8.0f;
    float mref = 0.f; bool started = false; f32x16 o[2]; o[0] = f32x16{}; o[1] = f32x16{}; float lsum = 0.f;
    bool mine = true;
    f32x16 negm = f32x16{}; asm volatile("" : "+v"(negm));
    auto set_negm = [&]() { const float c = mine ? -mref : -1e30f;
#pragma unroll
        for (int r = 0; r < 16; ++r) negm[r] = c; asm volatile("" : "+v"(negm)); };
    auto tile_active = [&](int key0) -> bool { bool a;
        if (MODE == 0) a = key0 <= q0 + wid * 32 + 31;
        else { const int n = key0 >> 8; a = __builtin_amdgcn_readfirstlane(__any((selmask >> n) & 1u)) != 0; if (n == own) a = a && (key0 <= q0 + wid * 32 + 31); }
        return a && !(var & 2); };
    auto new_block = [&](int key0) {
        if (MODE == 1 && (key0 & 255) == 0) { const bool mn_ = (selmask >> (key0 >> 8)) & 1u;
            if (__any(mn_ != mine)) { mine = mn_; set_negm(); } } };
    auto maskbias = [&](f32x16& P0, f32x16& P1, int key0, int g) {
        if (MODE == 0) {
            if (key0 + 63 > q0 + wid * 32) {
#pragma unroll
                for (int j = 0; j < 4; ++j) { const int r = 4 * g + j, kv = key0 + crow(r, hi); if (kv > qpos) P0[r] = -1e30f; if (kv + 32 > qpos) P1[r] = -1e30f; }
            }
        } else if (q0 + wid * 32 - key0 - 63 < 2047) {
            const int relb = qpos - key0 - 4 * hi; const LAS float* tb2 = (const LAS float*)(lds + A_TB) + (relb + 5);
#pragma unroll
            for (int j = 0; j < 4; ++j) { const int r = 4 * g + j, k = (r & 3) + 8 * (r >> 2); P0[r] += tb2[59 - k]; P1[r] += tb2[27 - k]; }
        } };
    auto decide = [&](f32x16& P0, f32x16& P1, float& alpha, bool& resc) {
        float rm = max3f(P0[0], P1[0], P0[1]), rm2 = max3f(P1[1], P0[2], P1[2]);
#pragma unroll
        for (int r = 3; r < 15; r += 2) { rm = max3f(rm, P0[r], P1[r]); rm2 = max3f(rm2, P0[r + 1], P1[r + 1]); }
        rm = max3f(rm, P0[15], P1[15]); rm = max3f(rm, rm2, rm2);
        rm = max_halves(rm);
        const bool live = rm > -1e29f; const bool need = live && (!started || rm > THR);
        alpha = 1.0f; resc = false;
        if (__any(need)) { const float delta = need ? rm : 0.f;
#pragma unroll
            for (int r = 0; r < 16; ++r) { P0[r] -= delta; P1[r] -= delta; }
            alpha = (need && started) ? __builtin_amdgcn_exp2f(-delta) : 1.0f; mref += delta; resc = true; set_negm(); }
        started = started || live; };
    ATT_BAR();
    f32x16 pa0 = f32x16{}, pa1 = f32x16{}, pb0 = f32x16{}, pb1 = f32x16{};
    int key_c = key_comp(0); bool act_c = tile_active(key_c); float alpha_c = 1.0f; bool resc_c = false;
    if (act_c) { new_block(key_c);
        const LAS unsigned char* kb = lds + 0 * A_SLOT + A_K + hi * 1024 + r32 * 16; bf16x8 kf[2 * ND0];
#pragma unroll
        for (int d0 = 0; d0 < ND0; ++d0) { kf[2 * d0] = *(const LAS bf16x8*)(kb + d0 * 2048); kf[2 * d0 + 1] = *(const LAS bf16x8*)(kb + d0 * 2048 + 512); }
        pa0 = __builtin_amdgcn_mfma_f32_32x32x16_bf16(kf[0], qr[0], negm, 0, 0, 0); pa1 = __builtin_amdgcn_mfma_f32_32x32x16_bf16(kf[1], qr[0], negm, 0, 0, 0);
#pragma unroll
        for (int d0 = 1; d0 < ND0; ++d0) { pa0 = __builtin_amdgcn_mfma_f32_32x32x16_bf16(kf[2 * d0], qr[d0], pa0, 0, 0, 0); pa1 = __builtin_amdgcn_mfma_f32_32x32x16_bf16(kf[2 * d0 + 1], qr[d0], pa1, 0, 0, 0); }
#pragma unroll
        for (int g = 0; g < 4; ++g) maskbias(pa0, pa1, key_c, g);
        decide(pa0, pa1, alpha_c, resc_c); }
#define ATT_BODY(PC0, PC1, PN0, PN1, AC, AN) do { \
          \
        float rs_ = 0.f; \
        bf16x8 kf[2][2];                        \
        const LAS unsigned char* kb = lds + sl_n * A_SLOT + A_K + hi * 1024 + r32 * 16; \
        if (AN) { new_block(key_n); kf[0][0] = *(const LAS bf16x8*)(kb); kf[0][1] = *(const LAS bf16x8*)(kb + 512); } \
        __builtin_amdgcn_sched_barrier(0); \
        _Pragma("unroll") for (int d0 = 0; d0 < ND0; ++d0) { \
            if (AN) { if (d0 + 1 < ND0) { kf[(d0 + 1) & 1][0] = *(const LAS bf16x8*)(kb + (d0 + 1) * 2048); kf[(d0 + 1) & 1][1] = *(const LAS bf16x8*)(kb + (d0 + 1) * 2048 + 512); } \
                if (d0 == 0) { PN0 = __builtin_amdgcn_mfma_f32_32x32x16_bf16(kf[0][0], qr[0], negm, 0, 0, 0); PN1 = __builtin_amdgcn_mfma_f32_32x32x16_bf16(kf[0][1], qr[0], negm, 0, 0, 0); } \
                else { PN0 = __builtin_amdgcn_mfma_f32_32x32x16_bf16(kf[d0 & 1][0], qr[d0], PN0, 0, 0, 0); PN1 = __builtin_amdgcn_mfma_f32_32x32x16_bf16(kf[d0 & 1][1], qr[d0], PN1, 0, 0, 0); } } \
            if (AC) { _Pragma("unroll") for (int e = (32 * d0) / ND0; e < (32 * (d0 + 1)) / ND0; ++e) { if (e < 16) { PC0[e] = __builtin_amdgcn_exp2f(PC0[e]); rs_ += PC0[e]; } else { PC1[e - 16] = __builtin_amdgcn_exp2f(PC1[e - 16]); rs_ += PC1[e - 16]; } } } \
            __builtin_amdgcn_sched_barrier(0); } \
        u32x4 pw[4]; v4i16_t vf[2][4];          \
        const LAS unsigned char* vp = lds + sl_c * A_SLOT + A_V + ((lane >> 4) & 1) * 32 + (lane & 3) * 8 + (4 * hi + ((lane & 15) >> 2)) * 64; \
        if (AC) { \
            lsum = lsum * alpha_c + rs_; \
            if (resc_c) { if (hi == 0) wsf[r32] = alpha_c; LDS_WAIT(); asm volatile("" ::: "memory"); \
                _Pragma("unroll") for (int g = 0; g < 4; ++g) { const f32x4 a4 = *(const LAS f32x4*)(wsf + 8 * g + 4 * hi); \
                    _Pragma("unroll") for (int j = 0; j < 4; ++j) { o[0][4 * g + j] *= a4[j]; o[1][4 * g + j] *= a4[j]; } } } \
            _Pragma("unroll") for (int d0 = 0; d0 < 2; ++d0) { vf[0][2 * d0] = __builtin_amdgcn_ds_read_tr16_b64_v4i16((LAS v4i16_t*)(vp + d0 * 4096)); vf[0][2 * d0 + 1] = __builtin_amdgcn_ds_read_tr16_b64_v4i16((LAS v4i16_t*)(vp + d0 * 4096 + 512)); } \
            _Pragma("unroll") for (int j = 0; j < 4; ++j) { pw[0][j] = cvtpk(PC0[2 * j], PC0[2 * j + 1]); pw[1][j] = cvtpk(PC0[8 + 2 * j], PC0[9 + 2 * j]); pw[2][j] = cvtpk(PC1[2 * j], PC1[2 * j + 1]); pw[3][j] = cvtpk(PC1[8 + 2 * j], PC1[9 + 2 * j]); } } \
        __builtin_amdgcn_sched_barrier(0); \
          \
        _Pragma("unroll") for (int ks = 0; ks < 4; ++ks) { \
            if (AC) { \
                if (ks + 1 < 4) { _Pragma("unroll") for (int d0 = 0; d0 < 2; ++d0) { vf[(ks + 1) & 1][2 * d0] = __builtin_amdgcn_ds_read_tr16_b64_v4i16((LAS v4i16_t*)(vp + d0 * 4096 + (ks + 1) * 1024)); vf[(ks + 1) & 1][2 * d0 + 1] = __builtin_amdgcn_ds_read_tr16_b64_v4i16((LAS v4i16_t*)(vp + d0 * 4096 + (ks + 1) * 1024 + 512)); } } \
                _Pragma("unroll") for (int d0 = 0; d0 < 2; ++d0) { const v4i16_t lo = vf[ks & 1][2 * d0], hv = vf[ks & 1][2 * d0 + 1]; \
                    const bf16x8 vfr = (bf16x8){lo[0], lo[1], lo[2], lo[3], hv[0], hv[1], hv[2], hv[3]}; \
                    o[d0] = __builtin_amdgcn_mfma_f32_32x32x16_bf16(__builtin_bit_cast(bf16x8, pw[ks]), vfr, o[d0], 0, 0, 0); } \
                } \
            if (AN) maskbias(PN0, PN1, key_n, ks); \
            __builtin_amdgcn_sched_barrier(0); } \
        alpha_c = 1.0f; resc_c = false; \
        if (AN) decide(PN0, PN1, alpha_c, resc_c); \
        } while (0)
#define ATT_STEP(PC0, PC1, PN0, PN1) do { \
        { int kn = key_last; if (t + 4 < NT) { kn = key_issue(t + 4); key_last = kn; } dma(kn, sl_d); } \
        const bool has_n = t + 1 < NT; const int key_n = has_n ? key_comp(t + 1) : 0; const bool act_n = has_n && tile_active(key_n); \
          \
        if (act_c && act_n) ATT_BODY(PC0, PC1, PN0, PN1, 1, 1); else if (act_c) ATT_BODY(PC0, PC1, PN0, PN1, 1, 0); else if (act_n) ATT_BODY(PC0, PC1, PN0, PN1, 0, 1); \
        if (!act_n) { alpha_c = 1.0f; resc_c = false; } \
        act_c = act_n; key_c = key_n; \
        sl_c = sl_n; sl_n = (sl_n == NSLOT - 1) ? 0 : sl_n + 1; sl_d = (sl_d == NSLOT - 1) ? 0 : sl_d + 1; \
        if (t & 1) ATT_BAR(); } while (0)
    for (int t = 0; t < NT; ++t) {
        ATT_STEP(pa0, pa1, pb0, pb1);
        pa0 = pb0; pa1 = pb1;
    }
#undef ATT_STEP
#undef ATT_BODY
    VM_WAIT(); LDS_WAIT(); __builtin_amdgcn_s_barrier();
#undef ATT_WAITV
#undef ATT_WAIT_PREV
#undef ATT_BAR
    bf16x8 gtv[4];
#pragma unroll
    for (int i = 0; i < 4; ++i) gtv[i] = *(const bf16x8*)(PROJ + (rowbase + q0 + wid * 32 + i * 8 + (lane >> 3)) * PROJ_LD + (MODE == 0 ? C_MGATE : C_CGATE) + 64 * h + (lane & 7) * 8);
    asm volatile("" ::: "memory");
    lsum += other_half(lsum);
    if (hi == 0) wsf[r32] = __builtin_amdgcn_rcpf(lsum);
    LDS_WAIT(); asm volatile("" ::: "memory");
    LAS float* stg = (LAS float*)(lds + A_OST + wid * A_OSTW);
#pragma unroll
    for (int g = 0; g < 4; ++g) { const f32x4 a4 = *(const LAS f32x4*)(wsf + 8 * g + 4 * hi);
#pragma unroll
        for (int j = 0; j < 4; ++j) { const int r = 4 * g + j, orow = crow(r, hi); stg[orow * 68 + r32] = o[0][r] * a4[j]; stg[orow * 68 + 32 + r32] = o[1][r] * a4[j]; } }
    LDS_WAIT(); asm volatile("" ::: "memory");
    bf16_t* Y = W_Y(ws); const int ycol = (MODE == 0 ? 0 : 768) + 64 * h, gcol = (MODE == 0 ? C_MGATE : C_CGATE) + 64 * h;
#pragma unroll
    for (int i = 0; i < 4; ++i) { const int row = i * 8 + (lane >> 3), c8 = (lane & 7) * 8; const size_t grow = rowbase + q0 + wid * 32 + row;
        const f32x4 a = *(const LAS f32x4*)(stg + row * 68 + c8), c = *(const LAS f32x4*)(stg + row * 68 + c8 + 4);
        const bf16x8 gt = gtv[i];
        u32x4 w; w.x = cvtpk(a[0] * siluf(bf2f((bf16_t)gt[0])), a[1] * siluf(bf2f((bf16_t)gt[1]))); w.y = cvtpk(a[2] * siluf(bf2f((bf16_t)gt[2])), a[3] * siluf(bf2f((bf16_t)gt[3])));
        w.z = cvtpk(c[0] * siluf(bf2f((bf16_t)gt[4])), c[1] * siluf(bf2f((bf16_t)gt[5]))); w.w = cvtpk(c[2] * siluf(bf2f((bf16_t)gt[6])), c[3] * siluf(bf2f((bf16_t)gt[7])));
        if (!(var & 4)) *(u32x4*)(Y + grow * LDY + ycol + c8) = w; }
    LDS_WAIT(); __syncthreads();
}
}
namespace gdn {
constexpr int CH_BYTES = 73728, O_WN = 0, O_QG = 16384, O_KE = 32768, O_AQK = 49152, O_U0 = 57344;
constexpr int P_Q = 0, P_K = 17408, P_V = 34816, P_L = 52224, P_AQ = 69632, P_XS = 78848  , XS_LD = 260, P_SC = 145408, P_DV = 146432  , DV_LD = 20, P_S1 = P_L  ;
static_assert(P_XS + 64 * XS_LD * 4 <= P_SC && P_SC + 1024 <= P_DV && P_DV + 4 * 16 * DV_LD * 4 <= LDS_MISC && P_S1 + 8 * 8448 <= P_SC, "prep LDS map");
__device__ __forceinline__ float silu_fast(float x) { return x * __builtin_amdgcn_rcpf(1.f + __expf(-x)); }
constexpr int QKV_LD = 136;
__device__ __forceinline__ int crow(int r, int hi) { return (r & 3) + 8 * (r >> 2) + 4 * hi; }

__device__ __forceinline__ void prep_load_raw(unsigned (&raw)[33], const bf16_t* PROJ, int b, int h, int n, int wid, int lane) {
#pragma unroll
    for (int rr = 0; rr < 11; ++rr) { const int t = n * 64 + 8 * wid - 3 + rr; const bf16_t* p = PROJ + ((size_t)b * SEQ + (t < 0 ? 0 : t)) * PROJ_LD + h * 128 + 2 * lane;
#pragma unroll
        for (int a = 0; a < 3; ++a) raw[rr * 3 + a] = *(const unsigned*)(p + (a == 0 ? C_GQ : a == 1 ? C_GK : C_GV)); }
}
__device__ __forceinline__ void prep_chunk(const Frame& F0, int l, int b, int h, int n, unsigned (&rawreg)[33], bool has_next, int nb, int nh, int nn, int var = 0) {
    const Frame F = opaque(F0);
    const int lane = F.lane, wid = F.wave, tid = F.tid, r32 = lane & 31, hi = lane >> 5;
    LAS unsigned char* lds = F.lds; unsigned char* ws = F.ws;
    const bf16_t* PROJ = W_PROJ(ws);
    const int t0 = n * 64; const size_t rowb = (size_t)b * SEQ;
    unsigned char* G = ws + WS_GDN + (size_t)((b * 4 + h) * 128 + n) * CH_BYTES;
    LAS float* SC = (LAS float*)(lds + P_SC);
    kargs_t ka = kargs();
    const bf16_t* pba = PROJ + (rowb + t0 + lane) * PROJ_LD; const bf16_t bb_raw = pba[C_GB + h], aa_raw = pba[C_GA + h]; const float dtb_ = IN_DTB(ka)[l * 4 + h], alog_ = IN_ALOG(ka)[l * 4 + h];
#ifdef PROBE_STAMP
    unsigned long long tsp[8]; int tsi = 0; unsigned long long ts_mid = 0;
#define PST() do { asm volatile("s_waitcnt vmcnt(0) lgkmcnt(0)" ::: "memory"); tsp[tsi++] = __builtin_amdgcn_s_memtime(); } while (0)
    PST();
#else
#define PST() do {} while (0)
#endif
    if (!(var & 1)) {
        const float* cw = IN_CONVW(ka) + (size_t)l * 4 * 1536 + h * 128 + 2 * lane;
        float w[3][4][2];
#pragma unroll
        for (int a = 0; a < 3; ++a)
#pragma unroll
            for (int j = 0; j < 4; ++j) { const f32x2 v = *(const f32x2*)(cw + j * 1536 + a * 512); w[a][j][0] = v[0]; w[a][j][1] = v[1]; }
        LAS unsigned* raw = (LAS unsigned*)(lds + P_S1 + wid * 8448) + lane;
        {
#pragma unroll
          for (int q = 0; q < 33; ++q) raw[q * 64] = rawreg[q];
          if (n == 0 && wid == 0) {
#pragma unroll
              for (int q = 0; q < 9; ++q) raw[q * 64] = 0u; } }
        if (has_next) prep_load_raw(rawreg, PROJ, nb, nh, nn, wid, lane);
        LDS_WAIT();
#ifdef PROBE_STAMP
        asm volatile("s_waitcnt vmcnt(0) lgkmcnt(0)" ::: "memory"); ts_mid = __builtin_amdgcn_s_memtime();
#endif
#pragma unroll 1
        for (int i = 0; i < 8; ++i) { float r0[3], r1[3];
#pragma unroll
            for (int a = 0; a < 3; ++a) { float s0 = 0.f, s1 = 0.f;
#pragma unroll
                for (int j = 0; j < 4; ++j) { const unsigned v = raw[((i + j) * 3 + a) * 64]; s0 += w[a][j][0] * bf2f((bf16_t)(v & 0xffff)); s1 += w[a][j][1] * bf2f((bf16_t)(v >> 16)); }
                r0[a] = silu_fast(s0); r1[a] = silu_fast(s1); }
            const float nq = rsqrtf(wave_sum(r0[0] * r0[0] + r1[0] * r1[0]) + 1e-6f) * 0.08838834764831845f, nk = rsqrtf(wave_sum(r0[1] * r0[1] + r1[1] * r1[1]) + 1e-6f);
            const int row = 8 * wid + i;
            *(LAS unsigned*)(lds + P_Q + row * 272 + 4 * lane) = cvtpk(r0[0] * nq, r1[0] * nq);
            *(LAS unsigned*)(lds + P_K + row * 272 + 4 * lane) = cvtpk(r0[1] * nk, r1[1] * nk);
            *(LAS unsigned*)(lds + P_V + row * 272 + 4 * lane) = cvtpk(r0[2], r1[2]); }
    }
    PST();
    if (wid == 0) {
        const float bb = bf2f(bb_raw), aa = bf2f(aa_raw) + dtb_;
        const float beta = 1.f / (1.f + __expf(-bb)), sp = (aa > 20.f) ? aa : __logf(1.f + __expf(aa));
        float g = -__expf(alog_) * sp;
#pragma unroll
        for (int o = 1; o < 64; o <<= 1) { const float v = __shfl_up(g, o); if (lane >= o) g += v; }
        const float gl = __shfl(g, 63);
        SC[lane] = g; SC[64 + lane] = beta; SC[128 + lane] = __expf(g); SC[192 + lane] = __expf(gl - g);
        if (lane == 63 && !(var & 32)) ((float*)(ws + WS_GEND))[(b * 4 + h) * 128 + n] = __expf(gl);
    }
    LDS_WAIT(); __builtin_amdgcn_s_barrier(); asm volatile("" ::: "memory");
    PST();
    if (!(var & 2)) {
        const int which = wid >> 2, ti = (wid >> 1) & 1, tj = wid & 1;
        f32x16 acc = f32x16{};
        if (ti >= tj) {
            const LAS unsigned char* ap = lds + (which ? P_Q : P_K) + (32 * ti + r32) * 272 + hi * 16; const LAS unsigned char* bp = lds + P_K + (32 * tj + r32) * 272 + hi * 16;
#pragma unroll
            for (int ks = 0; ks < 8; ++ks) acc = __builtin_amdgcn_mfma_f32_32x32x16_bf16(*(const LAS bf16x8*)(ap + ks * 32), *(const LAS bf16x8*)(bp + ks * 32), acc, 0, 0, 0);
        }
        const int j = 32 * tj + r32; const float gj = SC[j];
#pragma unroll
        for (int r = 0; r < 16; ++r) { const int i = 32 * ti + crow(r, hi); const float d = __expf(i >= j ? SC[i] - gj : 0.f);
            if (which == 0) *(LAS float*)(lds + P_L + (i * 68 + j) * 4) = (i > j) ? SC[64 + i] * acc[r] * d : 0.f;
            else *(LAS bf16_t*)(lds + P_AQ + (i * 72 + j) * 2) = (bf16_t)f2bf((i >= j) ? acc[r] * d : 0.f); }
    }
    LDS_WAIT(); __builtin_amdgcn_s_barrier(); asm volatile("" ::: "memory");
    PST();
    if (wid < 4 && !(var & 8)) { const int ib = wid, c = lane & 15;
        float m[16]; f32x4 Ld[2][4];
#pragma unroll
        for (int jc = 0; jc < 4; ++jc) { Ld[0][jc] = (f32x4){0.f, 0.f, 0.f, 0.f}; Ld[1][jc] = (f32x4){0.f, 0.f, 0.f, 0.f}; }
#pragma unroll
        for (int r = 0; r < 16; ++r) {
            if (r + 1 < 16) { const LAS f32x4* Lr = (const LAS f32x4*)(lds + P_L + (16 * ib + r + 1) * 272 + 64 * ib);
#pragma unroll
                for (int jc = 0; jc < (r + 1 + 3) / 4; ++jc) Ld[(r + 1) & 1][jc] = Lr[jc]; }
            float a = (r == c) ? 1.f : 0.f, a1 = 0.f;
#pragma unroll
            for (int jc = 0; jc < (r + 3) / 4; ++jc)
#pragma unroll
                for (int jj = 0; jj < 4; ++jj) if (4 * jc + jj < r) { if (jj & 1) a1 -= Ld[r & 1][jc][jj] * m[4 * jc + jj]; else a -= Ld[r & 1][jc][jj] * m[4 * jc + jj]; }
            m[r] = a + a1; asm volatile("" ::: "memory"); }
        if (lane < 16) { LAS float* dv = (LAS float*)(lds + P_DV) + ib * 16 * DV_LD + c;
#pragma unroll
            for (int r = 0; r < 16; ++r) dv[r * DV_LD] = m[r]; }
    }
    if (!(var & 4)) {
        const int t4 = tid;
#pragma unroll
        for (int it = 0; it < 2; ++it) {
            const int p = it * 512 + t4, f = p >> 6, ln = p & 63, mt = f & 1, s = (f >> 1) & 1, kt = f >> 2, hh = ln >> 5, r = ln & 31, row = 32 * mt + r, k0 = 32 * kt + 16 * s + 4 * hh;
            const u32x2 a = *(const LAS u32x2*)(lds + P_Q + row * 272 + k0 * 2), c2 = *(const LAS u32x2*)(lds + P_Q + row * 272 + k0 * 2 + 16); const float e = SC[128 + row];
            u32x4 o; o.x = cvtpk(bf2f((bf16_t)(a.x & 0xffff)) * e, bf2f((bf16_t)(a.x >> 16)) * e); o.y = cvtpk(bf2f((bf16_t)(a.y & 0xffff)) * e, bf2f((bf16_t)(a.y >> 16)) * e);
            o.z = cvtpk(bf2f((bf16_t)(c2.x & 0xffff)) * e, bf2f((bf16_t)(c2.x >> 16)) * e); o.w = cvtpk(bf2f((bf16_t)(c2.y & 0xffff)) * e, bf2f((bf16_t)(c2.y >> 16)) * e);
            if (!(var & 32)) *(u32x4*)(G + O_QG + p * 16) = o; }
#pragma unroll
        for (int it = 0; it < 2; ++it) {
            const int p = it * 512 + t4, f = p >> 6, ln = p & 63, mt = f & 3, s = (f >> 2) & 1, kt = f >> 3, hh = ln >> 5, r = ln & 31, dk = 32 * mt + r, p0 = 32 * kt + 16 * s + 4 * hh;
            float v[8];
#pragma unroll
            for (int j = 0; j < 8; ++j) { const int pos = p0 + 8 * (j >> 2) + (j & 3); v[j] = bf2f(*(const LAS bf16_t*)(lds + P_K + pos * 272 + dk * 2)) * SC[192 + pos]; }
            u32x4 o; o.x = cvtpk(v[0], v[1]); o.y = cvtpk(v[2], v[3]); o.z = cvtpk(v[4], v[5]); o.w = cvtpk(v[6], v[7]);
            if (!(var & 32)) *(u32x4*)(G + O_KE + p * 16) = o; }
    }
    LDS_WAIT(); __builtin_amdgcn_s_barrier(); asm volatile("" ::: "memory");
    if (!(var & 8)) {
        LAS float* XSb = (LAS float*)(lds + P_XS);
        const int nq = lane & 15, kq = lane >> 4;
        float avL[6][4], mv[4][4]; f32x4 rhs[4][2];
#pragma unroll
        for (int ib = 1; ib < 4; ++ib)
#pragma unroll
            for (int jb = 0; jb < ib; ++jb)
#pragma unroll
                for (int ks = 0; ks < 4; ++ks) avL[ib * (ib - 1) / 2 + jb][ks] = -*(const LAS float*)(lds + P_L + ((16 * ib + nq) * 68 + 16 * jb + 4 * ks + kq) * 4);
#pragma unroll
        for (int ib = 0; ib < 4; ++ib)
#pragma unroll
            for (int ks = 0; ks < 4; ++ks) mv[ib][ks] = *(const LAS float*)(lds + P_DV + ((ib * 16 + nq) * DV_LD + 4 * ks + kq) * 4);
#pragma unroll
        for (int ib = 0; ib < 4; ++ib)
#pragma unroll
            for (int r = 0; r < 4; ++r) { const int i = 16 * ib + 4 * kq + r; const float be = SC[64 + i], eg = SC[128 + i];
#pragma unroll
                for (int nt = 0; nt < 2; ++nt) { const int ncol0 = 32 * wid + 16 * nt; const bool isw = ncol0 < 128;
                    const float kv = bf2f(*(const LAS bf16_t*)(lds + (isw ? P_K + 2 * (ncol0 + nq) : P_V + 2 * (ncol0 - 128 + nq)) + i * 272));
                    rhs[ib][nt][r] = kv * be * (isw ? eg : 1.f); } }
        float xB[3][2][4];
#pragma unroll
        for (int ib = 0; ib < 4; ++ib) {
            f32x4 acc0 = rhs[ib][0], acc1 = rhs[ib][1];
#pragma unroll
            for (int jb = 0; jb < ib; ++jb)
#pragma unroll
                for (int ks = 0; ks < 4; ++ks) { acc0 = __builtin_amdgcn_mfma_f32_16x16x4f32(avL[ib * (ib - 1) / 2 + jb][ks], xB[jb][0][ks], acc0, 0, 0, 0); acc1 = __builtin_amdgcn_mfma_f32_16x16x4f32(avL[ib * (ib - 1) / 2 + jb][ks], xB[jb][1][ks], acc1, 0, 0, 0); }
#pragma unroll
            for (int r = 0; r < 4; ++r) { XSb[(16 * ib + 4 * kq + r) * XS_LD + 32 * wid + nq] = acc0[r]; XSb[(16 * ib + 4 * kq + r) * XS_LD + 32 * wid + 16 + nq] = acc1[r]; }
            asm volatile("" ::: "memory");
            float rv[2][4];
#pragma unroll
            for (int ks = 0; ks < 4; ++ks) { rv[0][ks] = XSb[(16 * ib + 4 * ks + kq) * XS_LD + 32 * wid + nq]; rv[1][ks] = XSb[(16 * ib + 4 * ks + kq) * XS_LD + 32 * wid + 16 + nq]; }
            f32x4 x0 = (f32x4){0.f, 0.f, 0.f, 0.f}, x1 = (f32x4){0.f, 0.f, 0.f, 0.f};
#pragma unroll
            for (int ks = 0; ks < 4; ++ks) { x0 = __builtin_amdgcn_mfma_f32_16x16x4f32(mv[ib][ks], rv[0][ks], x0, 0, 0, 0); x1 = __builtin_amdgcn_mfma_f32_16x16x4f32(mv[ib][ks], rv[1][ks], x1, 0, 0, 0); }
            asm volatile("" ::: "memory");
#pragma unroll
            for (int r = 0; r < 4; ++r) { XSb[(16 * ib + 4 * kq + r) * XS_LD + 32 * wid + nq] = x0[r]; XSb[(16 * ib + 4 * kq + r) * XS_LD + 32 * wid + 16 + nq] = x1[r]; }
            asm volatile("" ::: "memory");
            if (ib < 3) {
#pragma unroll
                for (int ks = 0; ks < 4; ++ks) { xB[ib][0][ks] = XSb[(16 * ib + 4 * ks + kq) * XS_LD + 32 * wid + nq]; xB[ib][1][ks] = XSb[(16 * ib + 4 * ks + kq) * XS_LD + 32 * wid + 16 + nq]; } }
        }
    }
    LDS_WAIT(); __builtin_amdgcn_s_barrier(); asm volatile("" ::: "memory");
    PST();
    if (!(var & 16)) {
#pragma unroll
    for (int it = 0; it < 2; ++it) {
        const int p = it * 512 + tid, f = p >> 6, ln = p & 63, mt = f & 1, s = (f >> 1) & 1, kt = f >> 2, hh = ln >> 5, r = ln & 31, row = 32 * mt + r, k0 = 32 * kt + 16 * s + 4 * hh;
        const f32x4 a = *(const LAS f32x4*)(lds + P_XS + (row * XS_LD + k0) * 4), c2 = *(const LAS f32x4*)(lds + P_XS + (row * XS_LD + k0 + 8) * 4);
        u32x4 o; o.x = cvtpk(-a[0], -a[1]); o.y = cvtpk(-a[2], -a[3]); o.z = cvtpk(-c2[0], -c2[1]); o.w = cvtpk(-c2[2], -c2[3]);
        if (!(var & 32)) *(u32x4*)(G + O_WN + p * 16) = o; }
    {
        const int p = tid, f = p >> 6, ln = p & 63, mt = f & 1, s = (f >> 1) & 1, kt = f >> 2, hh = ln >> 5, r = ln & 31, row = 32 * mt + r, k0 = 32 * kt + 16 * s + 4 * hh;
        const u32x2 a = *(const LAS u32x2*)(lds + P_AQ + row * 144 + k0 * 2), c2 = *(const LAS u32x2*)(lds + P_AQ + row * 144 + k0 * 2 + 16);
        if (!(var & 32)) *(u32x4*)(G + O_AQK + p * 16) = (u32x4){a.x, a.y, c2.x, c2.y}; }
#pragma unroll
    for (int it = 0; it < 2; ++it) {
        const int p = it * 512 + tid, part = p & 1, q = p >> 1, l2 = q & 63, wm = q >> 6, w = wm >> 1, mt = wm & 1, hh = l2 >> 5, cc = l2 & 31;
        const LAS float* xs = (const LAS float*)(lds + P_XS) + 128 + 32 * w + cc; float v[8];
#pragma unroll
        for (int e = 0; e < 8; ++e) v[e] = xs[(32 * mt + crow(8 * part + e, hh)) * XS_LD];
        u32x4 o; o.x = cvtpk(v[0], v[1]); o.y = cvtpk(v[2], v[3]); o.z = cvtpk(v[4], v[5]); o.w = cvtpk(v[6], v[7]);
        if (!(var & 32)) *(u32x4*)(G + O_U0 + p * 16) = o; }
    }
    LDS_WAIT(); __builtin_amdgcn_s_barrier(); asm volatile("" ::: "memory");
    PST();
#ifdef PROBE_STAMP
    if (b == 0 && h == 0 && n == 5 && wid == PROBE_STAMP_WAVE && lane == 0) { float* st = (float*)(ws + WS_CTL + 800000) + 16;
        for (int i = 0; i < 5; ++i) st[i] = (float)(tsp[i + 1] - tsp[i]); st[5] = (float)(tsp[5] - tsp[0]); st[6] = (float)(ts_mid - tsp[0]); }
#endif
#undef PST
}

__device__ __forceinline__ void gdn_finalize(const Frame& F0, int l) {
    const Frame F = opaque(F0);
    const int lane = F.lane, hd = lane >> 4, gw = F.bx * NWAVES + F.wave, NGW = F.G * NWAVES;
    const bf16_t* PROJ = W_PROJ(F.ws); bf16_t* Y = W_Y(F.ws); const bf16_t* OUTG = (const bf16_t*)(F.ws + WS_OUTG);
    kargs_t ka = kargs(); const f32x4 n0 = *(const f32x4*)(IN_GNORM(ka) + l * 128 + 8 * (lane & 15)), n1 = *(const f32x4*)(IN_GNORM(ka) + l * 128 + 8 * (lane & 15) + 4);
    for (int row0 = gw * 4; row0 < M_TOK; row0 += NGW * 4) {
        bf16x8 ovr[4], zvr[4];
#pragma unroll
        for (int r = 0; r < 4; ++r) { ovr[r] = *(const bf16x8*)(OUTG + (size_t)(row0 + r) * 512 + 8 * lane); zvr[r] = *(const bf16x8*)(PROJ + (size_t)(row0 + r) * PROJ_LD + C_GZ + 8 * lane); }
#pragma unroll
        for (int r = 0; r < 4; ++r) { const int row = row0 + r; const bf16x8 ov = ovr[r], zv = zvr[r];
        float o[8]; float ss = 0.f;
#pragma unroll
        for (int j = 0; j < 8; ++j) { o[j] = bf2f((bf16_t)ov[j]); ss += o[j] * o[j]; }
        ss += __builtin_bit_cast(float, __builtin_amdgcn_update_dpp(0, __builtin_bit_cast(int, ss), 0x111, 0xf, 0xf, true));
        ss += __builtin_bit_cast(float, __builtin_amdgcn_update_dpp(0, __builtin_bit_cast(int, ss), 0x112, 0xf, 0xf, true));
        ss += __builtin_bit_cast(float, __builtin_amdgcn_update_dpp(0, __builtin_bit_cast(int, ss), 0x114, 0xf, 0xf, true));
        ss += __builtin_bit_cast(float, __builtin_amdgcn_update_dpp(0, __builtin_bit_cast(int, ss), 0x118, 0xf, 0xf, true));
        const int sb = __builtin_bit_cast(int, ss);
        const float t0 = __builtin_bit_cast(float, __builtin_amdgcn_readlane(sb, 15)), t1 = __builtin_bit_cast(float, __builtin_amdgcn_readlane(sb, 31)), t2 = __builtin_bit_cast(float, __builtin_amdgcn_readlane(sb, 47)), t3 = __builtin_bit_cast(float, __builtin_amdgcn_readlane(sb, 63));
        const float tot = hd == 0 ? t0 : hd == 1 ? t1 : hd == 2 ? t2 : t3, rs = rsqrtf(tot * (1.f / 128.f) + RMS_EPS);
        u32x4 w; w.x = cvtpk(o[0] * rs * n0[0] * silu_fast(bf2f((bf16_t)zv[0])), o[1] * rs * n0[1] * silu_fast(bf2f((bf16_t)zv[1]))); w.y = cvtpk(o[2] * rs * n0[2] * silu_fast(bf2f((bf16_t)zv[2])), o[3] * rs * n0[3] * silu_fast(bf2f((bf16_t)zv[3])));
        w.z = cvtpk(o[4] * rs * n1[0] * silu_fast(bf2f((bf16_t)zv[4])), o[5] * rs * n1[1] * silu_fast(bf2f((bf16_t)zv[5]))); w.w = cvtpk(o[6] * rs * n1[2] * silu_fast(bf2f((bf16_t)zv[6])), o[7] * rs * n1[3] * silu_fast(bf2f((bf16_t)zv[7])));
        *(u32x4*)(Y + (size_t)row * LDY + 256 + 8 * lane) = w; }
    }
}
__device__ __forceinline__ void kmean_item(const Frame& F0, int item) {
    const Frame F = opaque(F0);
    const int tid = F.tid, n = item & 31, h = (item >> 5) & 3, b = item >> 7, rg = tid >> 3, c8 = (tid & 7) * 8;
    const bf16_t* p = W_PROJ(F.ws) + ((size_t)b * SEQ + n * 256 + rg * 4) * PROJ_LD + C_CK + 64 * h + c8;
    float s[8] = {0.f, 0.f, 0.f, 0.f, 0.f, 0.f, 0.f, 0.f};
#pragma unroll
    for (int i = 0; i < 4; ++i) { const bf16x8 v = *(const bf16x8*)(p + (size_t)i * PROJ_LD);
#pragma unroll
        for (int j = 0; j < 8; ++j) s[j] += bf2f((bf16_t)v[j]); }
    LAS float* part = (LAS float*)F.lds;
#pragma unroll
    for (int j = 0; j < 8; ++j) part[rg * 64 + c8 + j] = s[j];
    LDS_WAIT(); __syncthreads();
    if (tid < 64) { float a = 0.f;
#pragma unroll 8
        for (int g = 0; g < 64; ++g) a += part[g * 64 + tid];
        W_KM(F.ws)[(size_t)item * 64 + tid] = a * (1.f / 256.f); }
    LDS_WAIT(); __syncthreads();
}
}
namespace gdn {
constexpr int S_BUFSZ = 57344, S_OST = 2 * S_BUFSZ, S_OSTSZ = 17408;
static_assert(S_OST + 2 * S_OSTSZ <= LDS_MISC, "scan LDS map");
__device__ __forceinline__ bf16x8 pack8(const f32x16& v, int s) {
    u32x4 w; w.x = cvtpk(v[8 * s], v[8 * s + 1]); w.y = cvtpk(v[8 * s + 2], v[8 * s + 3]); w.z = cvtpk(v[8 * s + 4], v[8 * s + 5]); w.w = cvtpk(v[8 * s + 6], v[8 * s + 7]);
    return __builtin_bit_cast(bf16x8, w);
}
__device__ __forceinline__ void scan_chain(const Frame& F0, int l, int bh, int var = 0) {
    const Frame F = opaque(F0);
    const int lane = F.lane, wid = F.wave, r32 = lane & 31, hi = lane >> 5, b = bh >> 2, h = bh & 3;
    LAS unsigned char* lds = F.lds; unsigned char* ws = F.ws;
    const unsigned char* Gb = ws + WS_GDN + (size_t)(bh * 128) * CH_BYTES;
    if (wid >= 4) {
        const int hw = wid - 4; const size_t rb = (size_t)b * SEQ;
        const unsigned lds0 = (unsigned)(__UINTPTR_TYPE__)lds, dummy = lds0 + LDS_MISC + 512 + hw * 256;
        auto touch = [&](int c) { const unsigned char* Gc = Gb + (size_t)(c > 127 ? 127 : c) * CH_BYTES;
#pragma unroll
            for (int j = 0; j < 5; ++j) { int line = (j * 4 + hw) * 64 + lane; line = line > 1151 ? 1151 : line; att::glds4(Gc + (size_t)line * 64, (unsigned)__builtin_amdgcn_readfirstlane(dummy)); } };
        auto dma = [&](int c, unsigned dst) { const unsigned char* Gc = Gb + (size_t)c * CH_BYTES;
#pragma unroll
            for (int j = 0; j < 14; ++j) { const int pc = hw + 4 * j; att::glds16(Gc + pc * 1024 + lane * 16, (unsigned)__builtin_amdgcn_readfirstlane(dst + pc * 1024)); } };
        bf16_t* OUTG = (bf16_t*)(ws + WS_OUTG) + 128 * h + 32 * (lane & 3);
        auto copy_out = [&](int c) {
            const LAS u32x4* o4 = (const LAS u32x4*)(lds + S_OST + (c & 1) * S_OSTSZ + (16 * hw + (lane >> 2)) * 272 + 64 * (lane & 3));
            u32x4* g = (u32x4*)(OUTG + (rb + c * 64 + 16 * hw + (lane >> 2)) * 512);
            const u32x4 v0 = o4[0], v1 = o4[1], v2 = o4[2], v3 = o4[3]; g[0] = v0; g[1] = v1; g[2] = v2; g[3] = v3; };
        touch(1); touch(2); dma(0, lds0);
        VM_WAIT(); __builtin_amdgcn_s_barrier();
        for (int n = 0; n < 128; ++n) {
            if (n + 1 < 128 && !(var & 1)) dma(n + 1, lds0 + ((n + 1) & 1) * S_BUFSZ);
            touch(n + 3);
            asm volatile("s_waitcnt vmcnt(5)" ::: "memory");
            if (n >= 1 && !(var & 34)) copy_out(n - 1);
            LDS_WAIT(); __builtin_amdgcn_s_barrier();
        }
        if (!(var & 34)) copy_out(127);
    } else {
        const int w = wid; const float* GE = (const float*)(ws + WS_GEND) + bh * 128; const float ge_lo = GE[lane], ge_hi = GE[64 + lane];
        f32x16 S[4]; S[0] = f32x16{}; S[1] = f32x16{}; S[2] = f32x16{}; S[3] = f32x16{};
        u32x4 u0n[4];
#pragma unroll
        for (int mt = 0; mt < 2; ++mt) { const u32x4* p = (const u32x4*)(Gb + O_U0 + ((w * 2 + mt) * 64 + lane) * 32); u0n[2 * mt] = p[0]; u0n[2 * mt + 1] = p[1]; }
        VM_WAIT(); __builtin_amdgcn_s_barrier();
        for (int n = 0; n < 128; ++n) {
            LAS unsigned char* ost = lds + S_OST + (n & 1) * S_OSTSZ;
            const LAS unsigned char* B = lds + (n & 1) * S_BUFSZ + lane * 16;
            const float ge = __builtin_bit_cast(float, __builtin_amdgcn_readlane(__builtin_bit_cast(int, (n < 64) ? ge_lo : ge_hi), n & 63));
            f32x16 U[2], O[2];
#pragma unroll
            for (int mt = 0; mt < 2; ++mt)
#pragma unroll
                for (int q = 0; q < 4; ++q) { const unsigned v0 = u0n[2 * mt][q], v1 = u0n[2 * mt + 1][q];
                    U[mt][2 * q] = bf2f((bf16_t)(v0 & 0xffff)); U[mt][2 * q + 1] = bf2f((bf16_t)(v0 >> 16)); U[mt][8 + 2 * q] = bf2f((bf16_t)(v1 & 0xffff)); U[mt][9 + 2 * q] = bf2f((bf16_t)(v1 >> 16)); }
            if (n + 1 < 128 && !(var & 16)) {
#pragma unroll
                for (int mt = 0; mt < 2; ++mt) { const u32x4* p = (const u32x4*)(Gb + (size_t)(n + 1) * CH_BYTES + O_U0 + ((w * 2 + mt) * 64 + lane) * 32); u0n[2 * mt] = p[0]; u0n[2 * mt + 1] = p[1]; }
            }
            O[0] = f32x16{}; O[1] = f32x16{};
            if (!(var & 4)) {
#pragma unroll
            for (int kt = 0; kt < 4; ++kt)
#pragma unroll
                for (int s = 0; s < 2; ++s) { const bf16x8 sb = pack8(S[kt], s);
#pragma unroll
                    for (int mt = 0; mt < 2; ++mt) { const int f = (kt * 2 + s) * 2 + mt;
                        U[mt] = __builtin_amdgcn_mfma_f32_32x32x16_bf16(*(const LAS bf16x8*)(B + O_WN + f * 1024), sb, U[mt], 0, 0, 0);
                        O[mt] = __builtin_amdgcn_mfma_f32_32x32x16_bf16(*(const LAS bf16x8*)(B + O_QG + f * 1024), sb, O[mt], 0, 0, 0); }
                    asm volatile("" ::: "memory"); }
#pragma unroll
            for (int mt = 0; mt < 4; ++mt) S[mt] = S[mt] * ge;
#pragma unroll
            for (int kt = 0; kt < 2; ++kt)
#pragma unroll
                for (int s = 0; s < 2; ++s) { const bf16x8 ub = pack8(U[kt], s);
#pragma unroll
                    for (int mt = 0; mt < 2; ++mt) O[mt] = __builtin_amdgcn_mfma_f32_32x32x16_bf16(*(const LAS bf16x8*)(B + O_AQK + ((kt * 2 + s) * 2 + mt) * 1024), ub, O[mt], 0, 0, 0);
#pragma unroll
                    for (int mt = 0; mt < 4; ++mt) S[mt] = __builtin_amdgcn_mfma_f32_32x32x16_bf16(*(const LAS bf16x8*)(B + O_KE + ((kt * 2 + s) * 4 + mt) * 1024), ub, S[mt], 0, 0, 0);
                    asm volatile("" ::: "memory"); }
            }
            if (!(var & 8))
#pragma unroll
            for (int mt = 0; mt < 2; ++mt)
#pragma unroll
                for (int r = 0; r < 16; ++r) *(LAS bf16_t*)(ost + (32 * mt + crow(r, hi)) * 272 + (32 * w + r32) * 2) = (bf16_t)f2bf(O[mt][r]);
            LDS_WAIT(); __builtin_amdgcn_s_barrier(); asm volatile("" ::: "memory");
        }
    }
    LDS_WAIT(); VM_WAIT(); __syncthreads();
}
}
#ifndef PROBE_XA
#define PROBE_XA 0
#endif
#ifndef PROBE_XB
#define PROBE_XB 0
#endif
#ifndef PROBE_XC
#define PROBE_XC 0
#endif
#ifndef PROBE_XD
#define PROBE_XD 0
#endif
#ifndef PROBE_PREP_VAR
#define PROBE_PREP_VAR 0
#endif
#ifndef PROBE_PB_PARTS
#define PROBE_PB_PARTS 7
#endif
#ifndef PROBE_ATT_VAR
#define PROBE_ATT_VAR 0
#endif
#ifndef PROBE_SCAN_VAR
#define PROBE_SCAN_VAR 0
#endif
#ifndef PROBE_PC_PARTS
#define PROBE_PC_PARTS 7
#endif
__global__ void __launch_bounds__(NTHREADS, 2) skel_fwd(Args args) {
    extern __shared__ __attribute__((aligned(16))) unsigned char lds_raw[];
    Frame F_;
    F_.lds = (LAS unsigned char*)lds_raw; F_.tid = threadIdx.x; F_.lane = F_.tid & 63; F_.wave = __builtin_amdgcn_readfirstlane(F_.tid >> 6); F_.G = gridDim.x; F_.bx = blockIdx.x; F_.ws = args.ws;
    unsigned char* ws0 = args.ws;
    unsigned* ctl = (unsigned*)(ws0 + WS_CTL);
    volatile LAS unsigned* MISC = (volatile LAS unsigned*)(F_.lds + LDS_MISC);
    for (int u = F_.tid; u < 64; u += NTHREADS) MISC[u] = 0u;
    __syncthreads();
    const int lo = args.ph_lo, hi = args.ph_hi;
    const bool multi = (hi - lo) > 1;
    XcdBarrier bar; bar.bar = ctl + CW_BAR + lo * XCD_BAR_WORDS; bar.x = 0; bar.st = nullptr;
    if (multi) bar = xcd_barrier_post(ctl + CW_BAR + lo * XCD_BAR_WORDS, MISC + 8, F_.tid == 0);
    for (int ph = lo; ph < hi; ++ph) {
        const Frame F = opaque(F_);
        if (ph == 0) {
            p0_prologue(F, kargs());
        } else if (ph == N_PHASES - 1) {
#ifdef PROBE_STAMP
            if (F.bx == 0) { VM_WAIT(); __syncthreads(); if (F.tid == 0) { kargs_t ka = kargs(); ka->out[0] = exp2f(__builtin_rintf(log2f(((const float*)(F.ws + WS_CTL + 800000))[PROBE_STAMP] + 1.0f) * 2.0f) * 0.5f); } }
#endif
        } else {
            const int l = (ph - 1) >> 2, sub = (ph - 1) & 3;
            unsigned char* ws = F.ws; asm volatile("" : "+s"(ws));
            const int nrep = 1 + (sub == 0 ? PROBE_XA : sub == 1 ? PROBE_XB : sub == 2 ? PROBE_XC : (l == 0 ? PROBE_XD : 0));
            for (int rep = 0; rep < nrep; ++rep) {
            if (rep) xcd_barrier(bar, opaque(F_).tid == 0);
            if (sub == 0) {
                if (l > 0) { convert_weights(F, kargs(), l, 2); }
                VM_WAIT(); __syncthreads();
                pg8::Gemm g{W_XB(ws), W_WIN(ws), 1024, 1024, 1024}; pg8::StaticOrder S; S.init(M_TOK, 3840, F.G, F.bx);
                pg8::EpiProj E{W_PROJ(ws), W_SSQ(ws)};
                pg8::gemm_phase<pg8::EpiProj, pg8::StaticOrder>(F.lds, g, S, E, F.wave);
            } else if (sub == 1) {
                const int parts = rep ? PROBE_PB_PARTS : 7;
                if (F.G == 256 && (parts & 1)) {
                    const bool isq = F.bx < 128; const int ui = isq ? F.bx : F.bx - 128, pm = ui >> 1, pn = ui & 1;
                    pb_prepass(F, pm, (!isq) && pn == 0);
                    LDS_WAIT(); VM_WAIT(); __syncthreads();
                    const LAS float* RS = (const LAS float*)(F.lds + LDS_RS);
                    { pg8::Gemm g{W_PROJ(ws) + C_MCQ, W_WUQ(ws), PROJ_LD, 256, 256}; pg8::OneUnit S{pm, pn, isq}; pg8::EpiQ E{W_Q(ws), RS, W_COS(ws), W_SIN(ws), QSCALE};
                      pg8::gemm_phase<pg8::EpiQ, pg8::OneUnit>(F.lds, g, S, E, F.wave); }
                    { pg8::Gemm g{W_PROJ(ws) + C_MCKV, W_WUKV(ws), PROJ_LD, 128, 128}; pg8::OneUnit S{pm, pn, !isq}; pg8::EpiKV E{W_K(ws), W_V(ws), RS};
                      pg8::gemm_phase<pg8::EpiKV, pg8::OneUnit>(F.lds, g, S, E, F.wave); }
                }
                if (parts & 2) { unsigned rawreg[33]; { const Frame Fp = opaque(F); const int c = Fp.bx; gdn::prep_load_raw(rawreg, W_PROJ(Fp.ws), c >> 9, (c >> 7) & 3, c & 127, Fp.wave, Fp.lane); }
                    for (int c = F.bx; c < 1024; c += F.G) { const int cn = c + F.G; gdn::prep_chunk(F, l, c >> 9, (c >> 7) & 3, c & 127, rawreg, cn < 1024, cn >> 9, (cn >> 7) & 3, cn & 127, rep ? PROBE_PREP_VAR : 0); } }
                if (parts & 4) for (int it = F.bx; it < 256; it += F.G) gdn::kmean_item(F, it);
            } else if (sub == 2) {
                volatile LAS int* slot = (volatile LAS int*)(F.lds + LDS_MISC + 128);
                const int parts = rep ? PROBE_PC_PARTS : 7;
                const int my_slot = (int)(xb_xcc_id() & 7u);
                for (int k8 = 0; k8 < 8; ++k8) { const int qs = (my_slot + k8) & 7;
                    if (k8 == 1) {
                        const Frame Fq = opaque(F); volatile LAS int* slot2 = (volatile LAS int*)(Fq.lds + LDS_MISC + 136);
                        if (Fq.tid < 9) { unsigned* qa = (unsigned*)(Fq.ws + WS_CTL) + CW_Q + ((Fq.tid < 8) ? 64 * ((l * 2 + rep) * 8 + Fq.tid) : 64 * (64 + l));
                            const unsigned c = __hip_atomic_load(qa, __ATOMIC_RELAXED, __HIP_MEMORY_SCOPE_AGENT); const bool live = (Fq.tid < 8) ? (c < 65u) : (c * 8u < (unsigned)N_CONV_IN);
                            const unsigned long long bm = __ballot(live); if (Fq.tid == 0) *slot2 = (int)(bm & 0x1ffull); }
                        __syncthreads();
                    }
                    if (k8 >= 1 && !((__builtin_amdgcn_readfirstlane(*(volatile LAS int*)(opaque(F).lds + LDS_MISC + 136)) >> qs) & 1)) continue;
                    for (;;) {
                        if (F.tid == 0) *slot = (int)__hip_atomic_fetch_add(ctl + CW_Q + 64 * ((l * 2 + rep) * 8 + qs), 1u, __ATOMIC_RELAXED, __HIP_MEMORY_SCOPE_AGENT);
                        __syncthreads();
                        const int u = __builtin_amdgcn_readfirstlane(*slot);
                        __syncthreads();
                        if (u >= 65) break;
                        if (u == 0) { if (parts & 1) gdn::scan_chain(F, l, qs, rep ? PROBE_SCAN_VAR : 0); continue; }
                        const int v = u - 1, qb = 31 - (v >> 1), kind = v & 1, bh = qs;
                        if (!((parts >> (1 + kind)) & 1)) continue;
                        if (kind == 0) att::attn_unit<0>(F, bh >> 2, bh & 3, qb, rep ? PROBE_ATT_VAR : 0); else att::attn_unit<1>(F, bh >> 2, bh & 3, qb, rep ? PROBE_ATT_VAR : 0);
                    }
                }
                if (l + 1 < DEPTH && rep == 0 && ((__builtin_amdgcn_readfirstlane(*(volatile LAS int*)(opaque(F).lds + LDS_MISC + 136)) >> 8) & 1)) {
                    const Frame Fo = opaque(F); kargs_t ka = kargs(); LAS float* scr = (LAS float*)(Fo.lds + Fo.wave * 16384);
                    for (;;) {
                        if (F.tid == 0) *slot = (int)__hip_atomic_fetch_add(ctl + CW_Q + 64 * (64 + l), 1u, __ATOMIC_RELAXED, __HIP_MEMORY_SCOPE_AGENT);
                        __syncthreads();
                        const int g8 = __builtin_amdgcn_readfirstlane(*slot);
                        __syncthreads();
                        if (g8 * 8 >= N_CONV_IN) break;
                        const int it = g8 * 8 + Fo.wave;
                        if (it < N_CONV_IN) convert_in_item(Fo, ka, l + 1, it, scr);
                    }
                }
            } else {
                if (rep == 0) { gdn::gdn_finalize(F, l); xcd_barrier(bar, opaque(F_).tid == 0); }
                VM_WAIT(); __syncthreads();
                if (F.G == 256) {
                    pg8::Gemm g{W_Y(ws), W_WOUT(ws), LDY, 1024, 1024}; pg8::StaticOrder S; S.init(M_TOK, 1024, F.G, F.bx);
                    kargs_t ka = kargs(); float* xo = ka->out;
                    if (l == DEPTH - 1 && rep == 0) { pg8::EpiResFinal E{xo, xo, W_SSQ(ws), IN_FNORM(ka), bar}; pg8::gemm_phase<pg8::EpiResFinal, pg8::StaticOrder>(F.lds, g, S, E, F.wave); }
                    else { pg8::EpiRes E{(l == 0) ? IN_X(ka) : xo, xo, (l == DEPTH - 1) ? (bf16_t*)nullptr : W_XB(ws), W_SSQ(ws)};
                           pg8::gemm_phase<pg8::EpiRes, pg8::StaticOrder>(F.lds, g, S, E, F.wave); }
                }
            }
            }
        }
        if (ph + 1 < hi && ph != N_PHASES - 2) xcd_barrier(bar, opaque(F_).tid == 0);
    }
}
extern "C" void kernel_launch(void* const* d_in, const int* in_sizes, int n_in, void* d_out, int out_size, void* d_ws, size_t ws_size, hipStream_t stream) {
    static int grid = 0;
    if (grid == 0) {
        int dev = 0, cus = 0;
        if (n_in != 14 || ws_size < WS_END || hipGetDevice(&dev) != hipSuccess || hipDeviceGetAttribute(&cus, hipDeviceAttributeMultiprocessorCount, dev) != hipSuccess) { grid = -1; return; }
        if (hipFuncSetAttribute((const void*)skel_fwd, hipFuncAttributeMaxDynamicSharedMemorySize, LDS_BYTES) != hipSuccess) { grid = -1; return; }
        grid = cus;
    }
    if (grid != 256) return;
    unsigned char* ws = (unsigned char*)d_ws;
    (void)hipMemsetAsync(ws + WS_CTL, 0, CTL_ZERO_BYTES, stream);
    Args a{};
    for (int i = 0; i < 14; ++i) a.in[i] = (const float*)d_in[i];
    a.out = (float*)d_out; a.ws = ws;
    auto fast = [&](int lo, int hi) { a.ph_lo = lo; a.ph_hi = hi; hipLaunchKernelGGL(skel_fwd, dim3(grid), dim3(NTHREADS), LDS_BYTES, stream, a); };
    fast(0, N_PHASES);
}
```
